# Optimizing an MI355X kernel written in HIP

```python
import math
import jax
import jax.numpy as jnp
from jax import lax
import numpy as np

D_MODEL = 2048
BATCH = 2
SEQ = 8192
DEPTH = 4

N_MIXERS = 3
N_RET_LAYERS = (DEPTH + 2) // 3
N_SWA_LAYERS = (DEPTH + 1) // 3
N_RWKV_LAYERS = DEPTH // 3

RET_HEADS = 8
RET_QK_DIM = D_MODEL // RET_HEADS
RET_V_DIM = 2 * D_MODEL // RET_HEADS
RET_CHUNK = 128
RET_GN_EPS = 1e-5
ROPE_BASE = 10000.0

SWA_HEAD_DIM = 64
SWA_Q_HEADS = D_MODEL // SWA_HEAD_DIM
SWA_KV_HEADS = SWA_Q_HEADS // 8
SWA_WINDOW = 128
SWA_BLOCK = SWA_WINDOW
REL_BUCKETS = 32
REL_MAX_DIST = SWA_WINDOW
NEG_INF = -1e30

RWKV_HEAD_DIM = 64
RWKV_HEADS = D_MODEL // RWKV_HEAD_DIM
RWKV_DECAY_LORA = 96
RWKV_AAA_LORA = 96
RWKV_GATE_LORA = 256
RWKV_GN_EPS = 64e-5

D_FF = 5504
CONV_WIDTH = 3

PLE_DIM = 256

LN_EPS = 1e-5
DEEPNORM_ALPHA = (2.0 * DEPTH) ** 0.25
DEEPNORM_BETA = (8.0 * DEPTH) ** -0.25

kernel_name = 'hybrid_retnet_swa_rwkv7_deepnorm_trunk'


def _layer_norm(x, gain, bias):
    xf = x.astype(jnp.float32)
    mu = jnp.mean(xf, axis=-1, keepdims=True)
    var = jnp.mean(jnp.square(xf - mu), axis=-1, keepdims=True)
    return ((xf - mu) * lax.rsqrt(var + LN_EPS)).astype(x.dtype) * gain + bias


def _head_norm(x, gain, bias, eps):
    xf = x.astype(jnp.float32)
    mu = jnp.mean(xf, axis=-1, keepdims=True)
    var = jnp.mean(jnp.square(xf - mu), axis=-1, keepdims=True)
    y = (xf - mu) * lax.rsqrt(var + eps) * gain.astype(jnp.float32)
    if bias is not None:
        y = y + bias.astype(jnp.float32)
    return y


def _rotary(x, pos):
    d = x.shape[-1]
    inv = 1.0 / (ROPE_BASE ** (jnp.arange(0, d, 2, dtype=jnp.float32) / d))
    ang = pos.astype(jnp.float32)[:, None] * inv[None, :]
    cos = jnp.cos(ang)[None, :, None, :].astype(x.dtype)
    sin = jnp.sin(ang)[None, :, None, :].astype(x.dtype)
    x1, x2 = x[..., : d // 2], x[..., d // 2:]
    return jnp.concatenate([x1 * cos - x2 * sin, x1 * sin + x2 * cos], axis=-1)


def _retention(x, w_in, gn_gain, w_out):
    B, S, _ = x.shape
    H, dk, dv, C = RET_HEADS, RET_QK_DIM, RET_V_DIM, RET_CHUNK
    N = S // C
    proj = x @ w_in
    q, k, v, g = jnp.split(proj, [H * dk, 2 * H * dk, 2 * H * dk + H * dv], axis=-1)
    pos = jnp.arange(S)
    q = _rotary(q.reshape(B, S, H, dk), pos)
    k = _rotary(k.reshape(B, S, H, dk), pos) * (dk ** -0.5)
    v = v.reshape(B, S, H, dv)

    log_gamma = jnp.log(1.0 - 2.0 ** (-5.0 - jnp.arange(H, dtype=jnp.float32)))
    idx = jnp.arange(C, dtype=jnp.float32)
    diff = idx[:, None] - idx[None, :]
    decay_mask = jnp.where(diff >= 0, jnp.exp(log_gamma[:, None, None] * jnp.maximum(diff, 0.0)), 0.0)
    q_decay = jnp.exp(log_gamma[None, :] * (idx[:, None] + 1.0))
    k_decay = jnp.exp(log_gamma[None, :] * (C - 1.0 - idx[:, None]))
    chunk_decay = jnp.exp(log_gamma * C)

    qc = q.reshape(B, N, C, H, dk)
    kc = k.reshape(B, N, C, H, dk)
    vc = v.reshape(B, N, C, H, dv)
    scores = jnp.einsum('bnihd,bnjhd->bnhij', qc, kc) * decay_mask.astype(x.dtype)
    inner = jnp.einsum('bnhij,bnjhe->bnihe', scores, vc)

    def step(R, inp):
        q_n, k_n, v_n = inp
        cross = jnp.einsum('bihd,bhde->bihe', q_n, R) * q_decay[None, :, :, None]
        R = R * chunk_decay[None, :, None, None] + jnp.einsum(
            'bjhd,bjhe->bhde', k_n * k_decay[None, :, :, None], v_n)
        return R, cross

    R0 = jnp.zeros((B, H, dk, dv), jnp.float32)
    to_chunks = lambda t: jnp.transpose(t, (1, 0, 2, 3, 4))
    _, cross = lax.scan(step, R0, (to_chunks(qc), to_chunks(kc), to_chunks(vc)))
    cross = jnp.transpose(cross, (1, 0, 2, 3, 4))

    o = (inner + cross).reshape(B, S, H, dv)
    o = _head_norm(o, gn_gain.reshape(H, dv), None, RET_GN_EPS).astype(x.dtype)
    o = jax.nn.silu(g) * o.reshape(B, S, H * dv)
    return o @ w_out


def _t5_buckets(dist):
    n = np.maximum(dist, 0)
    max_exact = REL_BUCKETS // 2
    large = max_exact + (np.log(np.maximum(n, 1) / max_exact) / np.log(REL_MAX_DIST / max_exact)
                         * (REL_BUCKETS - max_exact)).astype(np.int32)
    large = np.minimum(large, REL_BUCKETS - 1)
    return np.where(n < max_exact, n, large).astype(np.int32)


def _swa_attention(x, w_qkv, sinks, w_out, rel_bias):
    B, S, _ = x.shape
    Hq, Hkv, hd, C = SWA_Q_HEADS, SWA_KV_HEADS, SWA_HEAD_DIM, SWA_BLOCK
    G = Hq // Hkv
    N = S // C
    qkv = x @ w_qkv
    q, k, v = jnp.split(qkv, [Hq * hd, (Hq + Hkv) * hd], axis=-1)
    q = q.reshape(B, N, C, Hkv, G, hd) * (hd ** -0.5)
    k = k.reshape(B, N, C, Hkv, hd)
    v = v.reshape(B, N, C, Hkv, hd)

    def with_prev(t):
        prev = jnp.pad(t, ((0, 0), (1, 0), (0, 0), (0, 0), (0, 0)))[:, :-1]
        return jnp.concatenate([prev, t], axis=2)

    kb, vb = with_prev(k), with_prev(v)

    qi = np.arange(C)[:, None]
    kj = np.arange(2 * C)[None, :]
    dist = qi + C - kj
    in_window = jnp.asarray((dist >= 0) & (dist < SWA_WINDOW))
    not_pad = (jnp.arange(N)[:, None, None] > 0) | jnp.asarray(kj >= C)[None]
    valid = in_window[None] & not_pad
    bias = rel_bias[_t5_buckets(dist)]
    bias = jnp.transpose(bias, (2, 0, 1)).reshape(Hkv, G, C, 2 * C).astype(jnp.float32)

    scores = jnp.einsum('bnihgd,bnjhd->bnhgij', q, kb).astype(jnp.float32) + bias[None, None]
    scores = jnp.where(valid[None, :, None, None], scores, NEG_INF)
    sink = sinks.reshape(Hkv, G).astype(jnp.float32)[None, None, :, :, None, None]
    m = jnp.maximum(jnp.max(scores, axis=-1, keepdims=True), sink)
    pexp = jnp.exp(scores - m)
    denom = jnp.sum(pexp, axis=-1, keepdims=True) + jnp.exp(sink - m)
    probs = (pexp / denom).astype(x.dtype)
    o = jnp.einsum('bnhgij,bnjhd->bnihgd', probs, vb).reshape(B, S, Hq * hd)
    return o @ w_out


def _rwkv7_time_mix(x, mix, w_rkv, w0, w1, w2, a0, a1, a2, g1, g2, k_k, k_a, r_k,
                    gn_gain, gn_bias, w_out):
    B, S, D = x.shape
    H, hd = RWKV_HEADS, RWKV_HEAD_DIM
    x_prev = jnp.pad(x, ((0, 0), (1, 0), (0, 0)))[:, :-1]
    xx = x_prev - x
    xr, xw, xk, xv, xa, xg = [x + xx * mix[i] for i in range(6)]
    r, k, v = jnp.einsum('tbsd,tde->tbse', jnp.stack([xr, xk, xv]), w_rkv)
    log_w = -jax.nn.softplus(-(w0 + jnp.tanh(xw @ w1) @ w2)) - 0.5
    decay = jnp.exp(-jnp.exp(log_w.astype(jnp.float32)))
    a = jax.nn.sigmoid(a0 + (xa @ a1) @ a2)
    g = jax.nn.sigmoid(xg @ g1) @ g2
    kk = (k * k_k).reshape(B, S, H, hd).astype(jnp.float32)
    kk = kk / jnp.maximum(jnp.sqrt(jnp.sum(kk * kk, axis=-1, keepdims=True)), 1e-12)
    k = k * (1.0 + (a - 1.0) * k_a)

    heads = lambda t: t.reshape(B, S, H, hd).astype(jnp.float32)
    r_h, k_h, v_h, a_h, w_h = heads(r), heads(k), heads(v), heads(a), heads(decay)
    a_vec = -kk
    b_vec = kk * a_h

    def step(state, inp):
        r_t, w_t, k_t, v_t, av_t, bv_t = inp
        sa = jnp.einsum('bhvk,bhk->bhv', state, av_t)
        state = (state * w_t[:, :, None, :] + sa[..., None] * bv_t[:, :, None, :]
                 + v_t[..., None] * k_t[:, :, None, :])
        y_t = jnp.einsum('bhvk,bhk->bhv', state, r_t)
        return state, y_t

    to_time = lambda t: jnp.transpose(t, (1, 0, 2, 3))
    S0 = jnp.zeros((B, H, hd, hd), jnp.float32)
    _, y = lax.scan(step, S0, (to_time(r_h), to_time(w_h), to_time(k_h), to_time(v_h),
                               to_time(a_vec), to_time(b_vec)))
    y = jnp.transpose(y, (1, 0, 2, 3))
    y = _head_norm(y, gn_gain.reshape(H, hd), gn_bias.reshape(H, hd), RWKV_GN_EPS)
    bonus = jnp.sum(r_h * k_h * r_k.astype(jnp.float32), axis=-1, keepdims=True) * v_h
    y = (y + bonus).reshape(B, S, D).astype(x.dtype) * g
    return y @ w_out


def _conv_ffn(x, w_up, conv_w, conv_b, w_down):
    S = x.shape[1]
    h = x @ w_up
    hp = jnp.pad(h, ((0, 0), (CONV_WIDTH - 1, 0), (0, 0)))
    hc = conv_b + hp[:, CONV_WIDTH - 1:] * conv_w[CONV_WIDTH - 1]
    for tap in range(CONV_WIDTH - 1):
        hc = hc + hp[:, tap:tap + S] * conv_w[tap]
    u, gate = jnp.split(hc, 2, axis=-1)
    return (jax.nn.silu(gate) * u) @ w_down


def setup_inputs(seed: int = 0) -> dict:
    key = jax.random.key(seed)
    ks = iter(jax.random.split(key, 48))
    nrm = lambda shape: jax.random.normal(next(ks), shape, jnp.float32)
    dense = lambda shape, fan_in, scale=1.0: nrm(shape) * (fan_in ** -0.5) * scale
    D, F = D_MODEL, D_FF
    ret_in_cols = 2 * RET_HEADS * RET_QK_DIM + 2 * RET_HEADS * RET_V_DIM
    swa_in_cols = (SWA_Q_HEADS + 2 * SWA_KV_HEADS) * SWA_HEAD_DIM
    nr, ns, nw = N_RET_LAYERS, N_SWA_LAYERS, N_RWKV_LAYERS
    return {
        'x': nrm((BATCH, SEQ, D)),
        'p': nrm((DEPTH, BATCH, SEQ, PLE_DIM)),
        'ln_gain': 1.0 + 0.02 * nrm((DEPTH, 2, D)),
        'ln_bias': 0.02 * nrm((DEPTH, 2, D)),
        'ret_w_in': dense((nr, D, ret_in_cols), D),
        'ret_gn_gain': 1.0 + 0.02 * nrm((nr, RET_HEADS * RET_V_DIM)),
        'ret_w_out': dense((nr, RET_HEADS * RET_V_DIM, D), RET_HEADS * RET_V_DIM, DEEPNORM_BETA),
        'swa_w_qkv': dense((ns, D, swa_in_cols), D),
        'swa_sinks': nrm((ns, SWA_Q_HEADS)),
        'swa_w_out': dense((ns, SWA_Q_HEADS * SWA_HEAD_DIM, D), SWA_Q_HEADS * SWA_HEAD_DIM, DEEPNORM_BETA),
        'rel_bias': 0.5 * nrm((REL_BUCKETS, SWA_Q_HEADS)),
        'rwkv_mix': jax.random.uniform(next(ks), (nw, 6, D), jnp.float32),
        'rwkv_w_rkv': dense((nw, 3, D, D), D),
        'rwkv_w0': 0.5 * nrm((nw, D)) - 0.5,
        'rwkv_w1': dense((nw, D, RWKV_DECAY_LORA), D),
        'rwkv_w2': dense((nw, RWKV_DECAY_LORA, D), RWKV_DECAY_LORA, 0.5),
        'rwkv_a0': 0.1 * nrm((nw, D)),
        'rwkv_a1': dense((nw, D, RWKV_AAA_LORA), D),
        'rwkv_a2': dense((nw, RWKV_AAA_LORA, D), RWKV_AAA_LORA, 0.5),
        'rwkv_g1': dense((nw, D, RWKV_GATE_LORA), D),
        'rwkv_g2': dense((nw, RWKV_GATE_LORA, D), RWKV_GATE_LORA),
        'rwkv_k_k': 0.85 + 0.05 * nrm((nw, D)),
        'rwkv_k_a': 1.0 + 0.05 * nrm((nw, D)),
        'rwkv_r_k': 0.1 * nrm((nw, RWKV_HEADS, RWKV_HEAD_DIM)),
        'rwkv_gn_gain': 1.0 + 0.02 * nrm((nw, D)),
        'rwkv_gn_bias': 0.02 * nrm((nw, D)),
        'rwkv_w_out': dense((nw, D, D), D, DEEPNORM_BETA),
        'ffn_w_up': dense((DEPTH, D, 2 * F), D),
        'ffn_conv_w': 0.5 * nrm((DEPTH, CONV_WIDTH, 2 * F)),
        'ffn_conv_b': 0.02 * nrm((DEPTH, 2 * F)),
        'ffn_w_down': dense((DEPTH, F, D), F, DEEPNORM_BETA),
        'ple_w_proj': dense((DEPTH, PLE_DIM, D), PLE_DIM, 0.5),
        'ple_w_gate': dense((DEPTH, D, D), D),
    }


def reference(x, p, ln_gain, ln_bias, ret_w_in, ret_gn_gain, ret_w_out,
              swa_w_qkv, swa_sinks, swa_w_out, rel_bias,
              rwkv_mix, rwkv_w_rkv, rwkv_w0, rwkv_w1, rwkv_w2, rwkv_a0, rwkv_a1, rwkv_a2,
              rwkv_g1, rwkv_g2, rwkv_k_k, rwkv_k_a, rwkv_r_k, rwkv_gn_gain, rwkv_gn_bias, rwkv_w_out,
              ffn_w_up, ffn_conv_w, ffn_conv_b, ffn_w_down, ple_w_proj, ple_w_gate):
    for i in range(DEPTH):
        kind, j = i % N_MIXERS, i // N_MIXERS
        if kind == 0:
            mixed = _retention(x, ret_w_in[j], ret_gn_gain[j], ret_w_out[j])
        elif kind == 1:
            mixed = _swa_attention(x, swa_w_qkv[j], swa_sinks[j], swa_w_out[j], rel_bias)
        else:
            mixed = _rwkv7_time_mix(x, rwkv_mix[j], rwkv_w_rkv[j], rwkv_w0[j], rwkv_w1[j], rwkv_w2[j],
                                    rwkv_a0[j], rwkv_a1[j], rwkv_a2[j], rwkv_g1[j], rwkv_g2[j],
                                    rwkv_k_k[j], rwkv_k_a[j], rwkv_r_k[j], rwkv_gn_gain[j],
                                    rwkv_gn_bias[j], rwkv_w_out[j])
        x = _layer_norm(DEEPNORM_ALPHA * x + mixed, ln_gain[i, 0], ln_bias[i, 0])
        ffn = _conv_ffn(x, ffn_w_up[i], ffn_conv_w[i], ffn_conv_b[i], ffn_w_down[i])
        x = _layer_norm(DEEPNORM_ALPHA * x + ffn, ln_gain[i, 1], ln_bias[i, 1])
        x = x + (p[i] @ ple_w_proj[i]) * jax.nn.sigmoid(x @ ple_w_gate[i])
    return x
```

```cpp
#include <hip/hip_runtime.h>
#include <cstdio>
#include <cstdint>
#include <cstddef>

#define LAS __attribute__((address_space(3)))
#define GAS __attribute__((address_space(1)))
#define DI __device__ __forceinline__
typedef _Float16 h16;
typedef _Float16 h16x8 __attribute__((ext_vector_type(8)));
typedef _Float16 h16x4 __attribute__((ext_vector_type(4)));
typedef _Float16 h16x2 __attribute__((ext_vector_type(2)));
typedef float f32x4 __attribute__((ext_vector_type(4)));
typedef float f32x2 __attribute__((ext_vector_type(2)));
typedef unsigned u32x4 __attribute__((ext_vector_type(4)));
typedef unsigned u32x2 __attribute__((ext_vector_type(2)));

#ifndef SKIPMASK
#define SKIPMASK 0
#endif
#ifndef ONE_LAUNCH
#define ONE_LAUNCH 0
#endif

constexpr int SEQ = 8192, M = 16384, D = 2048, DFF = 5504, DFF2 = 11008, NWAVES = 8, NTHR = 512;
constexpr float ALPHA = 1.681792830507429f;
constexpr float LN_EPS = 1e-5f;

constexpr size_t MiB = 1u << 20;
constexpr size_t WS_CTL = 0, CTL_ZERO_BYTES = 1 * MiB;
constexpr size_t WS_COS = 1 * MiB, WS_SIN = 5 * MiB, WS_COST = 9 * MiB, WS_SINT = 13 * MiB;
constexpr size_t WS_PH = 17 * MiB;
constexpr size_t WS_WMIX = 25 * MiB;
constexpr size_t WS_WCOM = 97 * MiB;
constexpr size_t WS_XF = 171 * MiB;
constexpr size_t WS_YF = 299 * MiB;
constexpr size_t WS_XH0 = 427 * MiB, WS_XH1 = 491 * MiB;
constexpr size_t WS_OV = 555 * MiB;
constexpr size_t WS_END = 1376 * MiB;
constexpr size_t W_RETA = 0, W_RETB = 32 * MiB, W_OUT = 56 * MiB;
constexpr size_t W_SWAQKV = 0;
constexpr size_t W_RW1 = 0, W_RW2 = 27 * MiB;
constexpr size_t W_UP = 0, W_DOWN = 43 * MiB, W_PP = 65 * MiB, W_GATE = 66 * MiB;
constexpr size_t OV_Q = 0, OV_K = 64 * MiB, OV_SG = 128 * MiB, OV_KT = 256 * MiB, OV_VT = 320 * MiB, OV_RALL = 448 * MiB;
constexpr size_t OV_QKV = 0, OV_SWAO = 128 * MiB;
constexpr size_t OV_LX = 0  , OV_RKV = 384 * MiB  , OV_MID = 576 * MiB  , OV_WAG = 600 * MiB  ;
constexpr size_t OV_H = 0  , OV_ACT = 344 * MiB  , OV_PP = 0;
static_assert(OV_WAG + 192 * MiB <= WS_END - WS_OV && OV_RALL + 256 * MiB <= WS_END - WS_OV && OV_ACT + 172 * MiB <= WS_END - WS_OV, "overlay");

constexpr int LDS_BYTES = 155648;
constexpr int MISC_OFF = 151552;

DI unsigned pkh(float a, float b) { f32x2 v = {a, b}; h16x2 h = __builtin_convertvector(v, h16x2); return __builtin_bit_cast(unsigned, h); }
DI u32x2 pk4(f32x4 v) { u32x2 r; r.x = pkh(v[0], v[1]); r.y = pkh(v[2], v[3]); return r; }
DI u32x4 pk8(f32x4 a, f32x4 b) { u32x4 r; r.x = pkh(a[0], a[1]); r.y = pkh(a[2], a[3]); r.z = pkh(b[0], b[1]); r.w = pkh(b[2], b[3]); return r; }
DI int lane_id() { unsigned m = ~0u; asm volatile("" : "+s"(m)); int l = (int)__builtin_amdgcn_mbcnt_hi(m, __builtin_amdgcn_mbcnt_lo(m, 0u)); asm volatile("" : "+v"(l)); return l; }
DI float shfl_idx(float v, int src) { return __builtin_bit_cast(float, __builtin_amdgcn_ds_bpermute(src << 2, __builtin_bit_cast(int, v))); }
DI float shfl_xor_(float v, int o, int lane) { return shfl_idx(v, lane ^ o); }
DI float wave_sum(float v, int lane) {
#pragma unroll
    for (int o = 1; o < 64; o <<= 1) v += shfl_xor_(v, o, lane);
    return v;
}
DI float wave_max(float v, int lane) {
#pragma unroll
    for (int o = 1; o < 64; o <<= 1) v = fmaxf(v, shfl_xor_(v, o, lane));
    return v;
}
DI float sigmoidf_(float x) { return 1.0f / (1.0f + __expf(-x)); }
__constant__ float L2GAMMA[8] = {-0.04580368961312479f, -0.02272007650008353f, -0.011315313227834146f, -0.005646563141142063f, -0.0028205190623786626f, -0.0014095702546713536f, -0.0007046129765893727f, -0.0003522634716290214f};
DI float log2gamma(int h) { return L2GAMMA[h]; }
DI float zero_f() { float z = 0.f; asm volatile("" : "+v"(z)); return z; }

namespace pg8 {
constexpr int BM = 256, BK = 64, HALF = 128, HTB = HALF * BK * 2, STAGE_BYTES = 8 * HTB, NXCD = 8, WGM = 8;
__host__ __device__ __forceinline__ int lds_byte(int r, int c) { const int st = (r >> 4) * 2 + (c >> 5), rr = r & 15, cc = c & 31, ob = rr * 64 + cc * 2; return st * 1024 + (ob ^ (((ob >> 9) & 1) << 5)); }
__host__ __device__ __forceinline__ void stage_rc(int b, int& R, int& C) { const int st = b / 1024, sb = b % 1024, swz = sb ^ (((sb >> 9) & 1) << 5); R = (st >> 1) * 16 + swz / 64; C = (st & 1) * 32 + (swz % 64) / 2; }
__host__ __device__ __forceinline__ int perm32(int rho) { const int n = rho >> 4, i = rho & 15; return 8 * (i >> 2) + 4 * n + (i & 3); }
struct Unit { int pm, pn; };
struct Gemm { const h16* A; const h16* Bt; int M, N, K, lda, ldb; };
struct StaticOrder {
    int nM, nN, nwg, G, c;
    __host__ __device__ void init(int M_, int N_, int G_, int c_) { nM = M_ / BM; nN = N_ / BM; nwg = nM * nN; G = G_; c = c_; }
    __host__ __device__ bool next(int i, Unit& u) const {
        const long L = (long)i * G + c; if (L >= nwg) return false;
        int wgid = (int)L; { const int q = nwg / NXCD, r = nwg % NXCD, xcd = wgid % NXCD, off = wgid / NXCD; wgid = (xcd < r ? xcd * (q + 1) : r * (q + 1) + (xcd - r) * q) + off; }
        const int nig = WGM * nN, gid = wgid / nig, fm = gid * WGM, gsz = (nM - fm) < WGM ? (nM - fm) : WGM;
        u.pm = fm + ((wgid % nig) % gsz); u.pn = (wgid % nig) / gsz; return true;
    }
};
template <class Epi, bool ALIGN_EPI = true>
__device__ __forceinline__ void gemm_phase(LAS unsigned char* lds, const Gemm g, const StaticOrder& S, const Epi& E, int wave0) {
    int wid = wave0; asm volatile("" : "+s"(wid));
    const int lane = lane_id();
    const int tid = wid * 64 + lane, wr = wid >> 2, wc = wid & 3, fr = lane & 15, fq = lane >> 4;
    int K = g.K; asm volatile("" : "+s"(K)); const int nt = K / BK;
    unsigned voffA[2], voffB[2];
#pragma unroll
    for (int i = 0; i < 2; ++i) { int R, C; stage_rc(tid * 16 + i * 8192, R, C); const int Rb = Epi::PERM ? ((R & ~31) + perm32(R & 31)) : R;
        voffA[i] = (unsigned)(R * g.lda + C) * 2u; voffB[i] = (unsigned)(Rb * g.ldb + C) * 2u; }
    const size_t kstep = (size_t)(BK * 2);
    const size_t hstepA = (size_t)HALF * g.lda * 2, hstepB = (size_t)HALF * g.ldb * 2;
    const size_t tstepA = 2 * hstepA, tstepB = 2 * hstepB;
    const unsigned ldsw = (unsigned)wid * 1024u;
    const int aoff = lds_byte(wr * 64 + fr, fq * 8), boff = lds_byte(wc * 32 + fr, fq * 8);
#define PG8_SA(b, h) (((b) * 2 + (h)) * HTB)
#define PG8_SB(b, h) ((4 + (b) * 2 + (h)) * HTB)
#define PG8_STAGE(bufoff, gbase, voff) do { _Pragma("unroll") for (int _i = 0; _i < 2; ++_i) \
        __builtin_amdgcn_global_load_lds((const unsigned*)((const char*)(gbase) + (voff)[_i]), (LAS unsigned*)(lds + (bufoff) + ldsw + _i * 8192), 16, 0, 0); } while (0)
#define PG8_LDA(dst, b, h) do { _Pragma("unroll") for (int m = 0; m < 4; ++m) _Pragma("unroll") for (int k = 0; k < 2; ++k) dst[m][k] = *(const LAS h16x8*)(lds + PG8_SA(b, h) + aoff + m * 2048 + k * 1024); } while (0)
#define PG8_LDB(dst, b, h) do { _Pragma("unroll") for (int n = 0; n < 2; ++n) _Pragma("unroll") for (int k = 0; k < 2; ++k) dst[n][k] = *(const LAS h16x8*)(lds + PG8_SB(b, h) + boff + n * 2048 + k * 1024); } while (0)
#define PG8_MMA(ai, bj, At, Bt) do { __builtin_amdgcn_s_setprio(1); _Pragma("unroll") for (int m = 0; m < 4; ++m) _Pragma("unroll") for (int n = 0; n < 2; ++n) _Pragma("unroll") for (int k = 0; k < 2; ++k) \
        acc[ai][bj][m][n] = __builtin_amdgcn_mfma_f32_16x16x32_f16(Bt[n][k], At[m][k], acc[ai][bj][m][n], 0, 0, 0); __builtin_amdgcn_s_setprio(0); } while (0)
#define PG8_WAIT_V(n) asm volatile("s_waitcnt vmcnt(" #n ")" ::: "memory")
#define PG8_WAIT_L(n) asm volatile("s_waitcnt lgkmcnt(" #n ")" ::: "memory")
#define PG8_BAR __builtin_amdgcn_s_barrier()
#define PG8_SCHED __builtin_amdgcn_sched_barrier(0)
    Unit cur, nxt; int ui = 0;
    if (!S.next(0, cur)) return;
    f32x4 acc[2][2][4][2];
#pragma unroll
    for (int a = 0; a < 2; ++a)
#pragma unroll
        for (int b = 0; b < 2; ++b)
#pragma unroll
            for (int m = 0; m < 4; ++m)
#pragma unroll
                for (int n = 0; n < 2; ++n) acc[a][b][m][n] = (f32x4){0.f, 0.f, 0.f, 0.f};
    h16x8 At[4][2], B0[2][2], B1[2][2];
    const char* cA = (const char*)g.A + E.a_off(cur) + (size_t)cur.pm * tstepA; const char* cB = (const char*)g.Bt + (size_t)cur.pn * tstepB;
    PG8_STAGE(PG8_SB(0, 0), cB, voffB); PG8_STAGE(PG8_SB(0, 1), cB + hstepB, voffB); PG8_STAGE(PG8_SA(0, 0), cA, voffA); PG8_STAGE(PG8_SA(0, 1), cA + hstepA, voffA);
    if (wr == 1) PG8_BAR;
    PG8_WAIT_V(2); PG8_BAR;
    PG8_STAGE(PG8_SB(1, 0), cB + kstep, voffB); PG8_STAGE(PG8_SA(1, 0), cA + kstep, voffA); PG8_STAGE(PG8_SB(1, 1), cB + hstepB + kstep, voffB);
    PG8_WAIT_V(6); PG8_BAR;
    for (;;) {
        const bool has_next = S.next(ui + 1, nxt);
        const char* nA = has_next ? (const char*)g.A + E.a_off(nxt) + (size_t)nxt.pm * tstepA : cA; const char* nB = has_next ? (const char*)g.Bt + (size_t)nxt.pn * tstepB : cB;
        for (int t = 0; t < nt; t += 2) {
            const bool last = (t == nt - 2);
            const char* a1 = cA + (size_t)(t + 1) * kstep;
            const char* a2 = last ? nA : cA + (size_t)(t + 2) * kstep; const char* b2 = last ? nB : cB + (size_t)(t + 2) * kstep;
            const char* a3 = a2 + kstep; const char* b3 = b2 + kstep;
            PG8_LDB(B0, 0, 0); PG8_LDB(B1, 0, 1); PG8_SCHED; PG8_LDA(At, 0, 0); PG8_STAGE(PG8_SA(1, 1), a1 + hstepA, voffA);
            PG8_WAIT_V(8); PG8_WAIT_L(0); PG8_BAR; PG8_MMA(0, 0, At, B0); PG8_MMA(0, 1, At, B1); PG8_BAR; PG8_SCHED;
            PG8_LDA(At, 0, 1); PG8_STAGE(PG8_SB(0, 0), b2, voffB); PG8_STAGE(PG8_SB(0, 1), b2 + hstepB, voffB); PG8_STAGE(PG8_SA(0, 0), a2, voffA);
            PG8_WAIT_V(8); PG8_WAIT_L(0); PG8_BAR; PG8_MMA(1, 0, At, B0); PG8_MMA(1, 1, At, B1); PG8_BAR; PG8_SCHED;
            PG8_LDB(B0, 1, 0); PG8_LDB(B1, 1, 1); PG8_SCHED; PG8_LDA(At, 1, 0); PG8_STAGE(PG8_SA(0, 1), a2 + hstepA, voffA);
            PG8_WAIT_V(8); PG8_WAIT_L(0); PG8_BAR; PG8_MMA(0, 0, At, B0); PG8_MMA(0, 1, At, B1); PG8_BAR; PG8_SCHED;
            PG8_LDA(At, 1, 1); PG8_STAGE(PG8_SB(1, 0), b3, voffB); PG8_STAGE(PG8_SB(1, 1), b3 + hstepB, voffB); PG8_STAGE(PG8_SA(1, 0), a3, voffA);
            PG8_WAIT_V(8); PG8_WAIT_L(0); PG8_BAR; PG8_MMA(1, 0, At, B0); PG8_MMA(1, 1, At, B1); PG8_BAR; PG8_SCHED;
        }
        if constexpr (ALIGN_EPI) { if (wr == 0) PG8_BAR; }
        { int fr_ = fr, fq_ = fq, wr_ = wr, wc_ = wc; asm volatile("" : "+v"(fr_), "+v"(fq_), "+s"(wr_), "+s"(wc_)); E(acc, cur, wr_, wc_, fr_, fq_); }
        if (!has_next) break;
#pragma unroll
        for (int a = 0; a < 2; ++a)
#pragma unroll
            for (int b = 0; b < 2; ++b)
#pragma unroll
                for (int m = 0; m < 4; ++m)
#pragma unroll
                    for (int n = 0; n < 2; ++n) acc[a][b][m][n] = (f32x4){0.f, 0.f, 0.f, 0.f};
        cur = nxt; cA = nA; cB = nB; ++ui;
        if constexpr (ALIGN_EPI) { if (wr == 1) PG8_BAR; }
    }
    PG8_WAIT_V(0);
    if constexpr (!ALIGN_EPI) { if (wr == 0) PG8_BAR; }
    PG8_BAR;
#undef PG8_SA
#undef PG8_SB
#undef PG8_STAGE
#undef PG8_LDA
#undef PG8_LDB
#undef PG8_MMA
#undef PG8_WAIT_V
#undef PG8_WAIT_L
#undef PG8_BAR
#undef PG8_SCHED
}
}
using pg8::Unit; using pg8::Gemm; using pg8::StaticOrder; using pg8::gemm_phase;
typedef const f32x4 (&AccRef)[2][2][4][2];

struct EpiRes {
    static constexpr bool PERM = false;
    const float* res; float* out;
    DI size_t a_off(const Unit&) const { return 0; }
    DI void operator()(AccRef acc, const Unit& u, int wr, int wc, int fr, int fq) const {
        const int row0 = u.pm * 256 + wr * 64 + fr, col0 = u.pn * 256 + wc * 32 + 4 * fq;
#pragma unroll
        for (int ai = 0; ai < 2; ++ai)
#pragma unroll
            for (int m = 0; m < 4; ++m) { const size_t ro = (size_t)(row0 + ai * 128 + m * 16) * D + col0;
#pragma unroll
                for (int bj = 0; bj < 2; ++bj)
#pragma unroll
                    for (int n = 0; n < 2; ++n) { const f32x4 r = *(const f32x4*)(res + ro + bj * 128 + n * 16); *(f32x4*)(out + ro + bj * 128 + n * 16) = r * ALPHA + acc[ai][bj][m][n]; } }
    }
};
struct EpiH16 {
    static constexpr bool PERM = true;
    h16* O; int ldc; int scale_cols; float scale;
    DI size_t a_off(const Unit&) const { return 0; }
    DI void operator()(AccRef acc, const Unit& u, int wr, int wc, int fr, int fq) const {
        const int row0 = u.pm * 256 + wr * 64 + fr, col0 = u.pn * 256 + wc * 32 + 8 * fq;
        const float s = (u.pn * 256 < scale_cols) ? scale : 1.0f;
#pragma unroll
        for (int ai = 0; ai < 2; ++ai)
#pragma unroll
            for (int m = 0; m < 4; ++m) { h16* rowp = O + (size_t)(row0 + ai * 128 + m * 16) * ldc + col0;
#pragma unroll
                for (int bj = 0; bj < 2; ++bj) *(u32x4*)(rowp + bj * 128) = pk8(acc[ai][bj][m][0] * s, acc[ai][bj][m][1] * s); }
    }
};
struct EpiRetA {
    static constexpr bool PERM = true;
    h16 *Q, *Kb, *SG; const float *cosT, *sinT;
    DI size_t a_off(const Unit&) const { return 0; }
    DI void operator()(AccRef acc, const Unit& u, int wr, int wc, int fr, int fq) const {
        const int row0 = u.pm * 256 + wr * 64 + fr, cb = wc * 32 + 8 * fq;
        if (u.pn < 16) {
            h16* dst = (u.pn < 8 ? Q : Kb) + (u.pn & 7) * 256 + cb; const float sc = u.pn < 8 ? 1.0f : 0.0625f;
#pragma unroll
            for (int ai = 0; ai < 2; ++ai)
#pragma unroll
                for (int m = 0; m < 4; ++m) { const int row = row0 + ai * 128 + m * 16, pos = row & (SEQ - 1);
                    const f32x4 c0 = *(const f32x4*)(cosT + pos * 128 + cb), c1 = *(const f32x4*)(cosT + pos * 128 + cb + 4);
                    const f32x4 s0 = *(const f32x4*)(sinT + pos * 128 + cb), s1 = *(const f32x4*)(sinT + pos * 128 + cb + 4);
                    const f32x4 x1a = acc[ai][0][m][0], x1b = acc[ai][0][m][1], x2a = acc[ai][1][m][0], x2b = acc[ai][1][m][1];
                    *(u32x4*)(dst + (size_t)row * D) = pk8((x1a * c0 - x2a * s0) * sc, (x1b * c1 - x2b * s1) * sc);
                    *(u32x4*)(dst + (size_t)row * D + 128) = pk8((x1a * s0 + x2a * c0) * sc, (x1b * s1 + x2b * c1) * sc); }
        } else {
            h16* dst = SG + (u.pn - 16) * 256 + cb;
#pragma unroll
            for (int ai = 0; ai < 2; ++ai)
#pragma unroll
                for (int m = 0; m < 4; ++m) { const int row = row0 + ai * 128 + m * 16;
#pragma unroll
                    for (int bj = 0; bj < 2; ++bj) { f32x4 a = acc[ai][bj][m][0], b = acc[ai][bj][m][1];
#pragma unroll
                        for (int j = 0; j < 4; ++j) { a[j] = a[j] * sigmoidf_(a[j]); b[j] = b[j] * sigmoidf_(b[j]); }
                        *(u32x4*)(dst + (size_t)row * 4096 + bj * 128) = pk8(a, b); } }
        }
    }
};
struct EpiRetB {
    static constexpr bool PERM = true;
    h16 *KT, *VT; const float *cosTT, *sinTT;
    DI size_t a_off(const Unit&) const { return 0; }
    DI void operator()(AccRef acc, const Unit& u, int wr, int wc, int fr, int fq) const {
        const int tokb = u.pn * 256 + wc * 32 + 8 * fq;
        if (u.pm < 8) {
            const float l2g = log2gamma(u.pm);
#pragma unroll
            for (int bj = 0; bj < 2; ++bj) { const int tok0 = tokb + bj * 128, pos0 = tok0 & (SEQ - 1), jb = pos0 & 127;
#pragma unroll
                for (int n = 0; n < 2; ++n) { f32x4 f;
#pragma unroll
                    for (int j = 0; j < 4; ++j) f[j] = 0.0625f * exp2f((float)(127 - (jb + 4 * n + j)) * l2g);
#pragma unroll
                    for (int m = 0; m < 4; ++m) { const int i = wr * 64 + m * 16 + fr;
                        const f32x4 c = *(const f32x4*)(cosTT + (size_t)i * SEQ + pos0 + 4 * n), sn = *(const f32x4*)(sinTT + (size_t)i * SEQ + pos0 + 4 * n);
                        const f32x4 x1 = acc[0][bj][m][n], x2 = acc[1][bj][m][n];
                        *(u32x2*)(KT + (size_t)(u.pm * 256 + i) * M + tok0 + 4 * n) = pk4((x1 * c - x2 * sn) * f);
                        *(u32x2*)(KT + (size_t)(u.pm * 256 + 128 + i) * M + tok0 + 4 * n) = pk4((x1 * sn + x2 * c) * f); } } }
        } else {
#pragma unroll
            for (int ai = 0; ai < 2; ++ai)
#pragma unroll
                for (int m = 0; m < 4; ++m) { const int f = (u.pm - 8) * 256 + ai * 128 + wr * 64 + m * 16 + fr;
#pragma unroll
                    for (int bj = 0; bj < 2; ++bj) *(u32x4*)(VT + (size_t)f * M + tokb + bj * 128) = pk8(acc[ai][bj][m][0], acc[ai][bj][m][1]); }
        }
    }
};
struct EpiRw1 {
    static constexpr bool PERM = true;
    h16 *RKV, *MID;
    DI size_t a_off(const Unit& u) const { return (size_t)(u.pn < 24 ? u.pn >> 3 : u.pn - 21) * ((size_t)M * D * 2); }
    DI void operator()(AccRef acc, const Unit& u, int wr, int wc, int fr, int fq) const {
        const int row0 = u.pm * 256 + wr * 64 + fr, cb = wc * 32 + 8 * fq;
        if (u.pn < 24) {
            h16* dst = RKV + (size_t)(u.pn >> 3) * ((size_t)M * D) + (u.pn & 7) * 256 + cb;
#pragma unroll
            for (int ai = 0; ai < 2; ++ai)
#pragma unroll
                for (int m = 0; m < 4; ++m)
#pragma unroll
                    for (int bj = 0; bj < 2; ++bj) *(u32x4*)(dst + (size_t)(row0 + ai * 128 + m * 16) * D + bj * 128) = pk8(acc[ai][bj][m][0], acc[ai][bj][m][1]);
        } else {
            const int t = u.pn - 24; h16* dst = MID + (size_t)t * ((size_t)M * 256) + cb;
#pragma unroll
            for (int ai = 0; ai < 2; ++ai)
#pragma unroll
                for (int m = 0; m < 4; ++m)
#pragma unroll
                    for (int bj = 0; bj < 2; ++bj) { f32x4 a = acc[ai][bj][m][0], b = acc[ai][bj][m][1];
#pragma unroll
                        for (int j = 0; j < 4; ++j) { if (t == 0) { a[j] = tanhf(a[j]); b[j] = tanhf(b[j]); } else if (t == 2) { a[j] = sigmoidf_(a[j]); b[j] = sigmoidf_(b[j]); } }
                        *(u32x4*)(dst + (size_t)(row0 + ai * 128 + m * 16) * 256 + bj * 128) = pk8(a, b); }
        }
    }
};
DI float decay_of(float z) { return __expf(-0.6065306597126334f * sigmoidf_(z)); }
struct EpiRw2 {
    static constexpr bool PERM = true;
    h16* WAG; const float *w0, *a0;
    DI size_t a_off(const Unit& u) const { return (size_t)(u.pn >> 3) * ((size_t)M * 256 * 2); }
    template <int T> DI void body(AccRef acc, h16* dst, const float* bias, int row0) const {
#pragma unroll
        for (int bj = 0; bj < 2; ++bj) { f32x4 ba = {0.f, 0.f, 0.f, 0.f}, bb = ba;
            if (T != 2) { ba = *(const f32x4*)(bias + bj * 128); bb = *(const f32x4*)(bias + bj * 128 + 4); }
#pragma unroll
            for (int ai = 0; ai < 2; ++ai)
#pragma unroll
                for (int m = 0; m < 4; ++m) { f32x4 a = acc[ai][bj][m][0] + ba, b = acc[ai][bj][m][1] + bb;
#pragma unroll
                    for (int j = 0; j < 4; ++j) { if (T == 0) { a[j] = decay_of(a[j]); b[j] = decay_of(b[j]); } else if (T == 1) { a[j] = sigmoidf_(a[j]); b[j] = sigmoidf_(b[j]); } }
                    *(u32x4*)(dst + (size_t)(row0 + ai * 128 + m * 16) * D + bj * 128) = pk8(a, b); } }
    }
    DI void operator()(AccRef acc, const Unit& u, int wr, int wc, int fr, int fq) const {
        const int row0 = u.pm * 256 + wr * 64 + fr, t = u.pn >> 3, colb = (u.pn & 7) * 256 + wc * 32 + 8 * fq;
        h16* dst = WAG + (size_t)t * ((size_t)M * D) + colb;
        if (t == 0) body<0>(acc, dst, w0 + colb, row0);
        else if (t == 1) body<1>(acc, dst, a0 + colb, row0);
        else body<2>(acc, dst, w0, row0);
    }
};
struct EpiPle {
    static constexpr bool PERM = false;
    const float* x2; const h16* pp; float* outf; h16* xh;
    DI size_t a_off(const Unit&) const { return 0; }
    DI void operator()(AccRef acc, const Unit& u, int wr, int wc, int fr, int fq) const {
        const int row0 = u.pm * 256 + wr * 64 + fr, col0 = u.pn * 256 + wc * 32 + 4 * fq;
#pragma unroll
        for (int ai = 0; ai < 2; ++ai)
#pragma unroll
            for (int m = 0; m < 4; ++m) { const size_t ro = (size_t)(row0 + ai * 128 + m * 16) * D + col0;
#pragma unroll
                for (int bj = 0; bj < 2; ++bj)
#pragma unroll
                    for (int n = 0; n < 2; ++n) { const size_t o = ro + bj * 128 + n * 16; const f32x4 xr = *(const f32x4*)(x2 + o); const h16x4 p4 = *(const h16x4*)(pp + o); const f32x4 a = acc[ai][bj][m][n]; f32x4 r;
#pragma unroll
                        for (int j = 0; j < 4; ++j) r[j] = xr[j] + (float)p4[j] * sigmoidf_(a[j]);
                        *(f32x4*)(outf + o) = r; if (xh) *(u32x2*)(xh + o) = pk4(r); } }
    }
};

#define XB_TMO      128
#define XB_XCNT(j)  (256  + 64 * (j))
#define XB_XSUB(j)  (1280 + 64 * (j))
#define XB_XGEN(j)  (2304 + 64 * (j))
#define XB_TOP      3328
#define XB_TOPGEN   3392
#define XCD_BAR_WORDS 3456
#define XB_SPIN_CAP (1u << 18)
__device__ __forceinline__ unsigned xb_ld(unsigned* p)              { return __hip_atomic_load(p, __ATOMIC_RELAXED, __HIP_MEMORY_SCOPE_AGENT); }
__device__ __forceinline__ unsigned xb_add(unsigned* p, unsigned v) { return __hip_atomic_fetch_add(p, v, __ATOMIC_RELAXED, __HIP_MEMORY_SCOPE_AGENT); }
__device__ __forceinline__ unsigned xb_xcc_id() { return (unsigned)__builtin_amdgcn_s_getreg((3 << 11) | 20) & 0xFu; }
#define XB_SPIN(cond, bar) do { unsigned _sp = 0; while (cond) { __builtin_amdgcn_s_sleep(1); \
    if ((++_sp & 255u) == 0u) { if (xb_ld(&(bar)[XB_TMO])) break; if (_sp > XB_SPIN_CAP) { atomicAdd(&(bar)[XB_TMO], 1u); break; } } } } while (0)
struct XcdBarrier { unsigned* bar; unsigned x; volatile LAS unsigned* st; };
__device__ __forceinline__ XcdBarrier xcd_barrier_post(unsigned* bar, volatile LAS unsigned* st) {
    XcdBarrier b; b.bar = bar; b.x = xb_xcc_id(); b.st = st;
    if (threadIdx.x == 0) (void)xb_add(&bar[XB_XCNT(b.x)], 1u);
    return b;
}
__device__ __forceinline__ void xcd_barrier_complete(unsigned* bar, unsigned x, unsigned& nloc, unsigned& nx) {
    const unsigned G = gridDim.x * gridDim.y * gridDim.z;
    unsigned sum, cnt, mine, sp = 0u;
    for (;;) {
        sum = 0u; cnt = 0u; mine = 0u;
#pragma unroll
        for (unsigned j = 0; j < 16; ++j) { const unsigned c = xb_ld(&bar[XB_XCNT(j)]); sum += c; cnt += (c > 0u) ? 1u : 0u; mine = (j == x) ? c : mine; }
        if (sum == G) break;
        __builtin_amdgcn_s_sleep(1);
        if ((++sp & 255u) == 0u) { if (xb_ld(&bar[XB_TMO])) break; if (sp > XB_SPIN_CAP) { atomicAdd(&bar[XB_TMO], 1u); break; } }
    }
    nloc = mine > 0u ? mine : 1u; nx = cnt > 0u ? cnt : 1u;
}
__device__ __forceinline__ void xcd_barrier(const XcdBarrier& b, int wave0) {
    asm volatile("s_waitcnt vmcnt(0)" ::: "memory");
    __syncthreads();
    if (wave0 == 0 && lane_id() == 0) {
        unsigned* bar = b.bar;
        __builtin_amdgcn_s_waitcnt(0);
        unsigned nloc = b.st[0], nx = b.st[1];
        if (nloc == 0u) { xcd_barrier_complete(bar, b.x, nloc, nx); b.st[0] = nloc; b.st[1] = nx; }
        const unsigned old = xb_add(&bar[XB_XSUB(b.x)], 1u);
        const unsigned gen = old / nloc;
        if (old + 1u == (gen + 1u) * nloc) {
            __builtin_amdgcn_fence(__ATOMIC_RELEASE, "agent");
            asm volatile("s_waitcnt vmcnt(0)" ::: "memory");
            const unsigned og = xb_add(&bar[XB_TOP], 1u);
            const unsigned tg = og / nx;
            if (og + 1u == (tg + 1u) * nx) xb_add(&bar[XB_TOPGEN], 1u);
            else XB_SPIN(xb_ld(&bar[XB_TOPGEN]) == tg, bar);
            __builtin_amdgcn_fence(__ATOMIC_ACQUIRE, "agent");
            xb_add(&bar[XB_XGEN(b.x)], 1u);
            asm volatile("s_waitcnt vmcnt(0)" ::: "memory");
        } else {
            XB_SPIN(xb_ld(&bar[XB_XGEN(b.x)]) == gen, bar);
            __builtin_amdgcn_fence(__ATOMIC_ACQUIRE, "agent");
            asm volatile("s_waitcnt vmcnt(0)" ::: "memory");
        }
    }
    __syncthreads();
}

__constant__ unsigned char T5_BUCKET[128] = {0, 1, 2, 3, 4, 5, 6, 7, 8, 9, 10, 11, 12, 13, 14, 15, 16, 16, 16, 17, 17, 18, 18, 18, 19, 19, 19, 20, 20, 20, 20, 21, 21, 21, 21, 22, 22, 22, 22, 22, 23, 23, 23, 23, 23, 23, 24, 24, 24, 24, 24, 24, 25, 25, 25, 25, 25, 25, 25, 26, 26, 26, 26, 26, 26, 26, 26, 27, 27, 27, 27, 27, 27, 27, 27, 27, 27, 28, 28, 28, 28, 28, 28, 28, 28, 28, 28, 29, 29, 29, 29, 29, 29, 29, 29, 29, 29, 29, 29, 30, 30, 30, 30, 30, 30, 30, 30, 30, 30, 30, 30, 30, 30, 31, 31, 31, 31, 31, 31, 31, 31, 31, 31, 31, 31, 31, 31, 31};

DI void cvt_job(const float* W, int ldw, int K, int ncols, int col0, h16* WT, int ldt, int row0, LAS float* scr, int gw, int NGW, int lane) {
    const int nblk = ncols / 32, nitems = (K / 64) * nblk;
    for (int item = gw; item < nitems; item += NGW) {
        const int kb = item / nblk, nb = item % nblk, k0 = 64 * kb, n0 = 32 * nb;
#pragma unroll 8
        for (int i = 0; i < 32; ++i) { const int kk = 2 * i + (lane >> 5); scr[kk * 33 + (lane & 31)] = W[(size_t)(k0 + kk) * ldw + col0 + n0 + (lane & 31)]; }
        asm volatile("s_waitcnt lgkmcnt(0)" ::: "memory");
        const int c = lane & 7;
#pragma unroll
        for (int j = 0; j < 4; ++j) { const int n = (lane >> 3) + 8 * j; const LAS float* s = scr + (8 * c) * 33 + n;
            u32x4 o; o.x = pkh(s[0 * 33], s[1 * 33]); o.y = pkh(s[2 * 33], s[3 * 33]); o.z = pkh(s[4 * 33], s[5 * 33]); o.w = pkh(s[6 * 33], s[7 * 33]);
            *(u32x4*)(WT + (size_t)(row0 + n0 + n) * ldt + k0 + 8 * c) = o; }
        asm volatile("s_waitcnt lgkmcnt(0)" ::: "memory");
    }
}
DI void cvt_small(const float* W, int ldw, int Ksrc, int nrows, h16* WT, int ldt, int row0, int gtid, int NT) {
    for (int i = gtid; i < nrows * ldt; i += NT) { const int n = i / ldt, k = i % ldt; WT[(size_t)(row0 + n) * ldt + k] = (h16)(k < Ksrc ? W[(size_t)k * ldw + n] : 0.f); }
}
DI void zero_rows(h16* WT, int ldt, int row0, int nrows, int gtid, int NT) {
    for (int i = gtid; i < nrows * ldt / 8; i += NT) *(u32x4*)(WT + (size_t)row0 * ldt + (size_t)i * 8) = (u32x4){0u, 0u, 0u, 0u};
}
DI void cvt_flat(const float* src, h16* dst, size_t n, int gtid, int NT) {
    for (size_t i = (size_t)gtid * 8; i < n; i += (size_t)NT * 8) { const f32x4 a = *(const f32x4*)(src + i), b = *(const f32x4*)(src + i + 4); *(u32x4*)(dst + i) = pk8(a, b); }
}
DI void ln_rows(const float* src, const float* gain, const float* bias, float* dstf, h16* dsth, int gw, int NGW, int lane) {
    for (int m = gw; m < M; m += NGW) {
        const f32x4* xr = (const f32x4*)(src + (size_t)m * D) + lane;
        f32x4 v[8]; float s = 0.f;
#pragma unroll
        for (int j = 0; j < 8; ++j) { v[j] = xr[64 * j]; s += (v[j][0] + v[j][1]) + (v[j][2] + v[j][3]); }
        const float mean = wave_sum(s, lane) * (1.f / D); float s2 = 0.f;
#pragma unroll
        for (int j = 0; j < 8; ++j) { v[j] = v[j] - mean; s2 += (v[j][0] * v[j][0] + v[j][1] * v[j][1]) + (v[j][2] * v[j][2] + v[j][3] * v[j][3]); }
        const float rstd = 1.0f / sqrtf(wave_sum(s2, lane) * (1.f / D) + LN_EPS);
#pragma unroll
        for (int j = 0; j < 8; ++j) { const int c = 4 * lane + 256 * j; const f32x4 gg = *(const f32x4*)(gain + c), bb = *(const f32x4*)(bias + c);
            const f32x4 o = v[j] * rstd * gg + bb; *(f32x4*)(dstf + (size_t)m * D + c) = o; *(u32x2*)(dsth + (size_t)m * D + c) = pk4(o); }
    }
}

DI void ret_scan(const h16* KT, const h16* VT, h16* RALL, int bid, int G, int wave, int lane) {
    for (int task = bid; task < 256; task += G) {
        const int bh = task >> 4, dvs = task & 15, h = bh & 7, b = bh >> 3, r16 = lane & 15, q4 = lane >> 4;
        const h16* kbase = KT + (size_t)(h * 256 + wave * 32 + r16) * M + (size_t)b * SEQ + q4 * 8;
        const h16* vbase = VT + (size_t)(h * 512 + dvs * 32 + r16) * M + (size_t)b * SEQ + q4 * 8;
        const float cd = exp2f(128.0f * log2gamma(h));
        f32x4 acc[2][2];
#pragma unroll
        for (int a = 0; a < 2; ++a)
#pragma unroll
            for (int c = 0; c < 2; ++c) acc[a][c] = (f32x4){0.f, 0.f, 0.f, 0.f};
        h16x8 af[2][4], bf[2][4];
#pragma unroll
        for (int t = 0; t < 2; ++t)
#pragma unroll
            for (int ks = 0; ks < 4; ++ks) { af[t][ks] = *(const h16x8*)(kbase + (size_t)t * 16 * M + ks * 32); bf[t][ks] = *(const h16x8*)(vbase + (size_t)t * 16 * M + ks * 32); }
        for (int n = 0; n < 64; ++n) {
            h16x8 an[2][4], bn[2][4];
            const int nn = (n + 1 < 64) ? n + 1 : n;
#pragma unroll
            for (int t = 0; t < 2; ++t)
#pragma unroll
                for (int ks = 0; ks < 4; ++ks) { an[t][ks] = *(const h16x8*)(kbase + (size_t)t * 16 * M + nn * 128 + ks * 32); bn[t][ks] = *(const h16x8*)(vbase + (size_t)t * 16 * M + nn * 128 + ks * 32); }
            h16* rdst = RALL + (((size_t)bh * 64 + n) * 512 + dvs * 32) * 256;
#pragma unroll
            for (int mt = 0; mt < 2; ++mt)
#pragma unroll
                for (int nt = 0; nt < 2; ++nt) { *(u32x2*)(rdst + (size_t)(nt * 16 + r16) * 256 + wave * 32 + mt * 16 + q4 * 4) = pk4(acc[mt][nt]); acc[mt][nt] = acc[mt][nt] * cd; }
#pragma unroll
            for (int ks = 0; ks < 4; ++ks)
#pragma unroll
                for (int mt = 0; mt < 2; ++mt)
#pragma unroll
                    for (int nt = 0; nt < 2; ++nt) acc[mt][nt] = __builtin_amdgcn_mfma_f32_16x16x32_f16(af[mt][ks], bf[nt][ks], acc[mt][nt], 0, 0, 0);
#pragma unroll
            for (int t = 0; t < 2; ++t)
#pragma unroll
                for (int ks = 0; ks < 4; ++ks) { af[t][ks] = an[t][ks]; bf[t][ks] = bn[t][ks]; }
        }
    }
}

constexpr int R2_QP = 528, R2_PP = 272, R2_BP = 80, R2_REG2 = 67584, R2_BC = 102400, R2_ST = 143360;
DI void ret_core(LAS unsigned char* lds, const h16* Qg, const h16* Kg, const h16* VT, const h16* RALL, h16* SG, const float* gn, int bid, int G, int tid, int wave, int  ) {
    LAS float* ST1 = (LAS float*)(lds + R2_ST); LAS float* ST2 = ST1 + 512;
    for (int unit = bid; unit < 1024; unit += G) {
        int fr, fq, wr, wc;
#define R2_FRESH do { asm volatile("" : "+v"(tid), "+s"(wave)); fr = tid & 15; fq = (tid >> 4) & 3; wr = wave >> 2; wc = wave & 3; } while (0)
        R2_FRESH;
        const int bh = unit >> 6, n = unit & 63, b = bh >> 3, h = bh & 7, tok0 = b * SEQ + n * 128;
        const float l2g = log2gamma(h);
        __syncthreads();
#pragma unroll
        for (int it = 0; it < 8; ++it) { const int p = tid + 512 * it, row = p >> 5, c16 = p & 31;
            *(LAS u32x4*)(lds + row * R2_QP + c16 * 16) = *(const u32x4*)(Qg + (size_t)(tok0 + row) * D + h * 256 + c16 * 8); }
#pragma unroll
        for (int it = 0; it < 8; ++it) { const int p = tid + 512 * it, row = p >> 5, c16 = p & 31;
            *(LAS u32x4*)(lds + R2_REG2 + row * R2_QP + c16 * 16) = *(const u32x4*)(Kg + (size_t)(tok0 + row) * D + h * 256 + c16 * 8); }
        __syncthreads();
        R2_FRESH;
        {
            f32x4 sacc[4][2];
#pragma unroll
            for (int m = 0; m < 4; ++m) { sacc[m][0] = (f32x4){0.f, 0.f, 0.f, 0.f}; sacc[m][1] = sacc[m][0]; }
#pragma unroll
            for (int ks = 0; ks < 8; ++ks) {
                h16x8 af[4];
#pragma unroll
                for (int m = 0; m < 4; ++m) af[m] = *(const LAS h16x8*)(lds + (wr * 64 + m * 16 + fr) * R2_QP + (ks * 32 + fq * 8) * 2);
#pragma unroll
                for (int n2 = 0; n2 < 2; ++n2) { const h16x8 bfr = *(const LAS h16x8*)(lds + R2_REG2 + (wc * 32 + n2 * 16 + fr) * R2_QP + (ks * 32 + fq * 8) * 2);
#pragma unroll
                    for (int m = 0; m < 4; ++m) sacc[m][n2] = __builtin_amdgcn_mfma_f32_16x16x32_f16(bfr, af[m], sacc[m][n2], 0, 0, 0); }
            }
            __syncthreads();
            R2_FRESH;
#pragma unroll
            for (int m = 0; m < 4; ++m) { const int i = wr * 64 + m * 16 + fr;
#pragma unroll
                for (int n2 = 0; n2 < 2; ++n2) { const int j0 = wc * 32 + n2 * 16 + fq * 4; f32x4 pv;
#pragma unroll
                    for (int j = 0; j < 4; ++j) { const int dd = i - (j0 + j); pv[j] = dd >= 0 ? sacc[m][n2][j] * exp2f((float)dd * l2g) : 0.f; }
                    *(LAS u32x2*)(lds + R2_REG2 + i * R2_PP + j0 * 2) = pk4(pv); } }
        }
        f32x4 acc[4][8];
#pragma unroll
        for (int m = 0; m < 4; ++m)
#pragma unroll
            for (int e = 0; e < 8; ++e) acc[m][e] = (f32x4){0.f, 0.f, 0.f, 0.f};
        R2_FRESH;
        const h16* rsrc = RALL + ((size_t)bh * 64 + n) * 512 * 256;
        for (int dc = 0; dc < 8; ++dc) {
            __syncthreads();
#pragma unroll
            for (int it = 0; it < 4; ++it) { const int p = tid + 512 * it, e = p >> 2, c16 = p & 3;
                *(LAS u32x4*)(lds + R2_BC + e * R2_BP + c16 * 16) = *(const u32x4*)(rsrc + (size_t)e * 256 + dc * 32 + c16 * 8); }
            __syncthreads();
            h16x8 af[4];
#pragma unroll
            for (int m = 0; m < 4; ++m) af[m] = *(const LAS h16x8*)(lds + (wr * 64 + m * 16 + fr) * R2_QP + (dc * 32 + fq * 8) * 2);
#pragma unroll
            for (int e = 0; e < 8; ++e) { const h16x8 bfr = *(const LAS h16x8*)(lds + R2_BC + (wc * 128 + e * 16 + fr) * R2_BP + fq * 16);
#pragma unroll
                for (int m = 0; m < 4; ++m) acc[m][e] = __builtin_amdgcn_mfma_f32_16x16x32_f16(bfr, af[m], acc[m][e], 0, 0, 0); }
        }
        R2_FRESH;
#pragma unroll
        for (int m = 0; m < 4; ++m) { const float f = exp2f((float)(wr * 64 + m * 16 + fr + 1) * l2g);
#pragma unroll
            for (int e = 0; e < 8; ++e) acc[m][e] = acc[m][e] * f; }
        for (int jc = 0; jc < 4; ++jc) {
            __syncthreads();
#pragma unroll
            for (int it = 0; it < 4; ++it) { const int p = tid + 512 * it, e = p >> 2, c16 = p & 3;
                *(LAS u32x4*)(lds + R2_BC + e * R2_BP + c16 * 16) = *(const u32x4*)(VT + (size_t)(h * 512 + e) * M + tok0 + jc * 32 + c16 * 8); }
            __syncthreads();
            h16x8 af[4];
#pragma unroll
            for (int m = 0; m < 4; ++m) af[m] = *(const LAS h16x8*)(lds + R2_REG2 + (wr * 64 + m * 16 + fr) * R2_PP + (jc * 32 + fq * 8) * 2);
#pragma unroll
            for (int e = 0; e < 8; ++e) { const h16x8 bfr = *(const LAS h16x8*)(lds + R2_BC + (wc * 128 + e * 16 + fr) * R2_BP + fq * 16);
#pragma unroll
                for (int m = 0; m < 4; ++m) acc[m][e] = __builtin_amdgcn_mfma_f32_16x16x32_f16(bfr, af[m], acc[m][e], 0, 0, 0); }
        }
        R2_FRESH;
        float mean[4], rstd[4];
#pragma unroll
        for (int m = 0; m < 4; ++m) { float sm = 0.f;
#pragma unroll
            for (int e = 0; e < 8; ++e) sm += (acc[m][e][0] + acc[m][e][1]) + (acc[m][e][2] + acc[m][e][3]);
            sm += shfl_xor_(sm, 16, tid & 63); sm += shfl_xor_(sm, 32, tid & 63);
            if (fq == 0) ST1[(wr * 64 + m * 16 + fr) * 4 + wc] = sm; }
        __syncthreads();
#pragma unroll
        for (int m = 0; m < 4; ++m) { const f32x4 t = *(const LAS f32x4*)(ST1 + (wr * 64 + m * 16 + fr) * 4); mean[m] = ((t[0] + t[1]) + (t[2] + t[3])) * (1.0f / 512.0f); float q = 0.f;
#pragma unroll
            for (int e = 0; e < 8; ++e) { const f32x4 d = acc[m][e] - mean[m]; q += (d[0] * d[0] + d[1] * d[1]) + (d[2] * d[2] + d[3] * d[3]); }
            q += shfl_xor_(q, 16, tid & 63); q += shfl_xor_(q, 32, tid & 63);
            if (fq == 0) ST2[(wr * 64 + m * 16 + fr) * 4 + wc] = q; }
        __syncthreads();
        R2_FRESH;
#pragma unroll
        for (int m = 0; m < 4; ++m) { const f32x4 t = *(const LAS f32x4*)(ST2 + (wr * 64 + m * 16 + fr) * 4); rstd[m] = 1.0f / sqrtf(((t[0] + t[1]) + (t[2] + t[3])) * (1.0f / 512.0f) + 1e-5f); }
#pragma unroll
        for (int m = 0; m < 4; ++m) { const size_t ro = (size_t)(tok0 + wr * 64 + m * 16 + fr) * 4096 + h * 512;
#pragma unroll
            for (int e = 0; e < 8; ++e) { const int col = wc * 128 + e * 16 + fq * 4; const f32x4 gg = *(const f32x4*)(gn + h * 512 + col); const h16x4 s4 = *(const h16x4*)(SG + ro + col); f32x4 o;
#pragma unroll
                for (int j = 0; j < 4; ++j) o[j] = (acc[m][e][j] - mean[m]) * rstd[m] * gg[j] * (float)s4[j];
                *(u32x2*)(SG + ro + col) = pk4(o); } }
    }
#undef R2_FRESH
}

DI void swa_attn(const h16* QKV, const float* sinks, const float* relb, h16* O, int gw, int NGW, int lane) {
    for (int task = gw; task < M * 32; task += NGW) {
        const int m = task >> 5, hq = task & 31, hk = hq >> 3, t = m & (SEQ - 1);
        h16x8 q[8];
#pragma unroll
        for (int i = 0; i < 8; ++i) q[i] = *(const h16x8*)(QKV + (size_t)m * 2560 + hq * 64 + i * 8);
        float sc[2];
#pragma unroll
        for (int kk = 0; kk < 2; ++kk) { const int dist = lane + 64 * kk; const bool valid = dist <= t; const int mk = valid ? m - dist : m;
            const h16* kr = QKV + (size_t)mk * 2560 + 2048 + hk * 64; float d = 0.f;
#pragma unroll
            for (int i = 0; i < 8; ++i) { const h16x8 kv = *(const h16x8*)(kr + i * 8);
#pragma unroll
                for (int j = 0; j < 8; ++j) d += (float)q[i][j] * (float)kv[j]; }
            sc[kk] = valid ? d + relb[(int)T5_BUCKET[dist] * 32 + hq] : -1e30f; }
        const float sink = sinks[hq];
        const float mx = fmaxf(wave_max(fmaxf(sc[0], sc[1]), lane), sink);
        float p0 = __expf(sc[0] - mx), p1 = __expf(sc[1] - mx);
        const float den = wave_sum(p0 + p1, lane) + __expf(sink - mx);
        p0 /= den; p1 /= den;
        float o = 0.f;
        const h16* vb = QKV + 2304 + hk * 64 + lane;
        for (int dist = 0; dist < 128; ++dist) {
            const float p = shfl_idx(dist < 64 ? p0 : p1, dist & 63);
            const int mk = dist <= t ? m - dist : m;
            o += p * (float)vb[(size_t)mk * 2560];
        }
        O[(size_t)m * D + hq * 64 + lane] = (h16)o;
    }
}

DI void rwkv_prep(const float* X, const float* mix, h16* LX, int gtid, int NT) {
    for (int i = gtid; i < M * (D / 4); i += NT) { const int m = i >> 9, c = (i & 511) * 4; const f32x4 x = *(const f32x4*)(X + (size_t)m * D + c);
        f32x4 xp = {0.f, 0.f, 0.f, 0.f}; if ((m & (SEQ - 1)) != 0) xp = *(const f32x4*)(X + (size_t)(m - 1) * D + c);
        const f32x4 xx = xp - x;
#pragma unroll
        for (int s = 0; s < 6; ++s) { const int mr = (s == 0) ? 0 : (s == 1) ? 2 : (s == 2) ? 3 : (s == 3) ? 1 : s; const f32x4 mx = *(const f32x4*)(mix + mr * D + c); *(u32x2*)(LX + (size_t)s * M * D + (size_t)m * D + c) = pk4(x + xx * mx); } }
}
DI void rwkv_sprep(const h16* RKV, const h16* WAG, const float* k_k, const float* k_a, h16* REC, int gw, int NGW, int lane) {
    for (int task = gw; task < M * 32; task += NGW) { const int m = task >> 5, hd = task & 31, col = hd * 64 + lane; const size_t o = (size_t)m * D + col;
        const float r = (float)RKV[o], k = (float)RKV[(size_t)M * D + o], v = (float)RKV[(size_t)2 * M * D + o], w = (float)WAG[o], a = (float)WAG[(size_t)M * D + o];
        const float kkv = k * k_k[col]; const float nrm = sqrtf(wave_sum(kkv * kkv, lane)); const float kkn = kkv / fmaxf(nrm, 1e-12f);
        const float kp = k * (1.0f + (a - 1.0f) * k_a[col]);
        const int b = m >> 13, t = m & (SEQ - 1);
        h16* rec = REC + ((size_t)(b * 32 + hd) * SEQ + t) * 384 + lane;
        rec[0] = (h16)w; rec[64] = (h16)(-kkn); rec[128] = (h16)(kkn * a); rec[192] = (h16)kp; rec[256] = (h16)r; rec[320] = (h16)v; }
}
DI float dpp_allreduce16(float v) {
    v += __builtin_bit_cast(float, __builtin_amdgcn_update_dpp(0, __builtin_bit_cast(int, v), 0xB1, 0xF, 0xF, false));
    v += __builtin_bit_cast(float, __builtin_amdgcn_update_dpp(0, __builtin_bit_cast(int, v), 0x4E, 0xF, 0xF, false));
    v += __builtin_bit_cast(float, __builtin_amdgcn_update_dpp(0, __builtin_bit_cast(int, v), 0x141, 0xF, 0xF, false));
    v += __builtin_bit_cast(float, __builtin_amdgcn_update_dpp(0, __builtin_bit_cast(int, v), 0x140, 0xF, 0xF, false));
    return v;
}
DI void rwkv_scan(const h16* REC, float* YS, int bid, int G, int wave, int lane) {
    if (wave >= 4) return;
    for (int task = bid; task < 256; task += G) {
        const int bh = task >> 2, rg = task & 3, row = rg * 16 + wave * 4 + (lane >> 4), kq = lane & 15;
        const h16* rec = REC + (size_t)bh * SEQ * 384 + kq * 4;
        const h16* recv = REC + (size_t)bh * SEQ * 384 + 320 + row;
        float* ys = YS + (size_t)bh * SEQ * 64 + row;
        f32x4 s = {0.f, 0.f, 0.f, 0.f}; float ykeep = 0.f;
        h16x4 cw[8], ca[8], cb[8], ck[8], cr[8]; h16 cv[8];
#pragma unroll
        for (int i = 0; i < 8; ++i) { const h16* p = rec + (size_t)i * 384; cw[i] = *(const h16x4*)p; ca[i] = *(const h16x4*)(p + 64); cb[i] = *(const h16x4*)(p + 128); ck[i] = *(const h16x4*)(p + 192); cr[i] = *(const h16x4*)(p + 256); cv[i] = recv[(size_t)i * 384]; }
        for (int t0 = 0; t0 < SEQ; t0 += 8) {
            h16x4 nw[8], na[8], nb[8], nk[8], nr[8]; h16 nv[8];
            const int tn = (t0 + 8 < SEQ) ? t0 + 8 : t0;
#pragma unroll
            for (int i = 0; i < 8; ++i) { const h16* p = rec + (size_t)(tn + i) * 384; nw[i] = *(const h16x4*)p; na[i] = *(const h16x4*)(p + 64); nb[i] = *(const h16x4*)(p + 128); nk[i] = *(const h16x4*)(p + 192); nr[i] = *(const h16x4*)(p + 256); nv[i] = recv[(size_t)(tn + i) * 384]; }
#pragma unroll
            for (int i = 0; i < 8; ++i) {
                const f32x4 w = __builtin_convertvector(cw[i], f32x4), a = __builtin_convertvector(ca[i], f32x4), bb = __builtin_convertvector(cb[i], f32x4), k = __builtin_convertvector(ck[i], f32x4), r = __builtin_convertvector(cr[i], f32x4);
                const float v = (float)cv[i];
                float sa = (s[0] * a[0] + s[1] * a[1]) + (s[2] * a[2] + s[3] * a[3]);
                sa = dpp_allreduce16(sa);
                s = s * w + (bb * sa + k * v);
                float y = (s[0] * r[0] + s[1] * r[1]) + (s[2] * r[2] + s[3] * r[3]);
                y = dpp_allreduce16(y);
                if (kq == ((t0 + i) & 15)) ykeep = y;
            }
            if ((t0 & 15) == 8) ys[(size_t)(t0 - 8 + kq) * 64] = ykeep;
#pragma unroll
            for (int i = 0; i < 8; ++i) { cw[i] = nw[i]; ca[i] = na[i]; cb[i] = nb[i]; ck[i] = nk[i]; cr[i] = nr[i]; cv[i] = nv[i]; }
        }
    }
}
DI void rwkv_post(const float* YS, const h16* REC, const h16* Gt, const float* r_k, const float* gg, const float* gb, h16* O, int gw, int NGW, int lane) {
    for (int task = gw; task < M * 32; task += NGW) { const int m = task >> 5, hd = task & 31, col = hd * 64 + lane, b = m >> 13, t = m & (SEQ - 1);
        const size_t rb = (size_t)(b * 32 + hd) * SEQ + t;
        const float y = YS[rb * 64 + lane];
        const float mean = wave_sum(y, lane) * (1.0f / 64.0f); const float d = y - mean; const float var = wave_sum(d * d, lane) * (1.0f / 64.0f);
        const float yn = d * (1.0f / sqrtf(var + 64e-5f)) * gg[col] + gb[col];
        const h16* rec = REC + rb * 384 + lane;
        const float kp = (float)rec[192], r = (float)rec[256], v = (float)rec[320];
        const float bonus = wave_sum(r * kp * r_k[col], lane) * v;
        O[(size_t)m * D + col] = (h16)((yn + bonus) * (float)Gt[(size_t)m * D + col]); }
}

DI void conv8(const h16* H, const float* cw, const float* cb, int m, int t, int cc, f32x4& o0, f32x4& o1) {
    o0 = *(const f32x4*)(cb + cc); o1 = *(const f32x4*)(cb + cc + 4);
#pragma unroll
    for (int tap = 0; tap < 3; ++tap) { const int back = 2 - tap; if (t >= back) { const h16x8 hv = *(const h16x8*)(H + (size_t)(m - back) * DFF2 + cc);
            const f32x4 w0 = *(const f32x4*)(cw + tap * DFF2 + cc), w1 = *(const f32x4*)(cw + tap * DFF2 + cc + 4);
#pragma unroll
            for (int j = 0; j < 4; ++j) { o0[j] += (float)hv[j] * w0[j]; o1[j] += (float)hv[4 + j] * w1[j]; } } }
}
DI void conv_act(const h16* H, const float* cw, const float* cb, h16* ACT, int gtid, int NT) {
    for (int i = gtid; i < M * (DFF / 8); i += NT) { const int m = i / (DFF / 8), c = (i % (DFF / 8)) * 8, t = m & (SEQ - 1);
        f32x4 u0, u1, g0, g1;
        conv8(H, cw, cb, m, t, c, u0, u1); conv8(H, cw, cb, m, t, c + DFF, g0, g1);
#pragma unroll
        for (int j = 0; j < 4; ++j) { u0[j] = g0[j] * sigmoidf_(g0[j]) * u0[j]; u1[j] = g1[j] * sigmoidf_(g1[j]) * u1[j]; }
        *(u32x4*)(ACT + (size_t)m * DFF + c) = pk8(u0, u1); }
}

struct Args { const float* in[33]; float* out; unsigned char* ws; int ph_lo, ph_hi; };
constexpr int PH_PER_LAYER = 16, N_PHASES = 1 + 4 * PH_PER_LAYER;

#define CAS __attribute__((address_space(4)))
DI const CAS char* kargs() { const CAS char* kp = (const CAS char*)__builtin_amdgcn_kernarg_segment_ptr(); asm volatile("" : "+s"(kp)); return kp; }
DI const float* inp(int i) { return ((const float* const CAS*)kargs())[i]; }
DI unsigned char* wsp(size_t off) { return *(unsigned char* const CAS*)(kargs() + 272) + off; }
DI float* outp() { return *(float* const CAS*)(kargs() + 264); }
static_assert(offsetof(Args, out) == 264 && offsetof(Args, ws) == 272 && offsetof(Args, ph_lo) == 280, "Args layout");

__global__ void __launch_bounds__(NTHR, 2) mega(Args args) {
    extern __shared__ __attribute__((aligned(16))) unsigned char lds_raw[];
    LAS unsigned char* lds = (LAS unsigned char*)lds_raw;
    const int G = gridDim.x, bid = blockIdx.x;
    const int wave0 = __builtin_amdgcn_readfirstlane(threadIdx.x >> 6);
    {
        volatile LAS unsigned* MISC0 = (volatile LAS unsigned*)(lds + MISC_OFF);
        for (int u = threadIdx.x; u < (LDS_BYTES - MISC_OFF) / 4; u += NTHR) MISC0[u] = 0u;
        __syncthreads();
    }
    XcdBarrier bar = xcd_barrier_post((unsigned*)(args.ws + WS_CTL) + 4096, (volatile LAS unsigned*)(lds + MISC_OFF) + 8);
    const int lo = args.ph_lo, hi = args.ph_hi;
#define IN(k) (lo <= (k) && (k) < hi)
#define SEAM(k) do { if (IN(k) && IN((k) + 1)) xcd_barrier(bar, wave0); } while (0)
#define TCOORDS int wave = wave0; asm volatile("" : "+s"(wave)); int lane = lane_id(); int tid = wave * 64 + lane; \
    const int gw = bid * NWAVES + wave, NGW = G * NWAVES, gtid = bid * NTHR + tid, NT = G * NTHR; (void)lane; (void)gw; (void)NGW; (void)gtid; (void)NT;

    if (IN(0)) {
        TCOORDS
        cvt_flat(inp(0), (h16*)wsp(WS_XH0), (size_t)M * D, gtid, NT);
        float* cosT = (float*)wsp(WS_COS); float* sinT = (float*)wsp(WS_SIN); float* cosTT = (float*)wsp(WS_COST); float* sinTT = (float*)wsp(WS_SINT);
        for (int i = gtid; i < SEQ * 128; i += NT) { const int pos = i >> 7, f = i & 127;
            const float pf = (float)pow(10000.0, (double)f / 128.0); const float inv = 1.0f / pf; const float ang = (float)pos * inv;
            const float c = (float)cos((double)ang), sn = (float)sin((double)ang);
            cosT[i] = c; sinT[i] = sn; cosTT[(size_t)f * SEQ + pos] = c; sinTT[(size_t)f * SEQ + pos] = sn; }
    }
    SEAM(0);

    for (int L = 0; L < 4; ++L) {
        const int kind = L % 3, P0 = 1 + L * PH_PER_LAYER;
        const size_t xhc_off = (L & 1) ? WS_XH1 : WS_XH0, xho_off = (L & 1) ? WS_XH0 : WS_XH1;
        const size_t mixo_off = WS_OV + (kind == 0 ? OV_SG : kind == 1 ? OV_SWAO : OV_RKV);
        const int kout = (kind == 0) ? 4096 : 2048;

        if (IN(P0 + 0) && !(SKIPMASK & 1)) {
            TCOORDS
            LAS float* scr = (LAS float*)(lds + wave * 16384);
            unsigned char* WMIX = wsp(WS_WMIX); unsigned char* WCOM = wsp(WS_WCOM);
            if (kind == 0) {
                const float* w = inp(4) + (size_t)(L / 3) * D * 12288;
                cvt_job(w, 12288, D, 2048, 0, (h16*)(WMIX + W_RETA), D, 0, scr, gw, NGW, lane);
                cvt_job(w, 12288, D, 2048, 2048, (h16*)(WMIX + W_RETA), D, 2048, scr, gw, NGW, lane);
                cvt_job(w, 12288, D, 4096, 8192, (h16*)(WMIX + W_RETA), D, 4096, scr, gw, NGW, lane);
                cvt_job(w, 12288, D, 2048, 2048, (h16*)(WMIX + W_RETB), D, 0, scr, gw, NGW, lane);
                cvt_job(w, 12288, D, 4096, 4096, (h16*)(WMIX + W_RETB), D, 2048, scr, gw, NGW, lane);
                cvt_job(inp(6) + (size_t)(L / 3) * 4096 * D, D, 4096, D, 0, (h16*)(WMIX + W_OUT), 4096, 0, scr, gw, NGW, lane);
            } else if (kind == 1) {
                cvt_job(inp(7), 2560, D, 2560, 0, (h16*)(WMIX + W_SWAQKV), D, 0, scr, gw, NGW, lane);
                cvt_job(inp(9), D, D, D, 0, (h16*)(WMIX + W_OUT), D, 0, scr, gw, NGW, lane);
            } else {
                h16* w1 = (h16*)(WMIX + W_RW1); h16* w2 = (h16*)(WMIX + W_RW2);
                for (int j = 0; j < 3; ++j) cvt_job(inp(12) + (size_t)j * D * D, D, D, D, 0, w1, D, j * D, scr, gw, NGW, lane);
                cvt_job(inp(14), 96, D, 96, 0, w1, D, 6144, scr, gw, NGW, lane); zero_rows(w1, D, 6144 + 96, 160, gtid, NT);
                cvt_job(inp(17), 96, D, 96, 0, w1, D, 6400, scr, gw, NGW, lane); zero_rows(w1, D, 6400 + 96, 160, gtid, NT);
                cvt_job(inp(19), 256, D, 256, 0, w1, D, 6656, scr, gw, NGW, lane);
                cvt_small(inp(15), D, 96, D, w2, 256, 0, gtid, NT);
                cvt_small(inp(18), D, 96, D, w2, 256, 2048, gtid, NT);
                cvt_job(inp(20), D, 256, D, 0, w2, 256, 4096, scr, gw, NGW, lane);
                cvt_job(inp(26), D, D, D, 0, (h16*)(WMIX + W_OUT), D, 0, scr, gw, NGW, lane);
            }
            cvt_job(inp(27) + (size_t)L * D * DFF2, DFF2, D, DFF2, 0, (h16*)(WCOM + W_UP), D, 0, scr, gw, NGW, lane);
            cvt_job(inp(30) + (size_t)L * DFF * D, D, DFF, D, 0, (h16*)(WCOM + W_DOWN), DFF, 0, scr, gw, NGW, lane);
            cvt_job(inp(31) + (size_t)L * 256 * D, D, 256, D, 0, (h16*)(WCOM + W_PP), 256, 0, scr, gw, NGW, lane);
            cvt_job(inp(32) + (size_t)L * D * D, D, D, D, 0, (h16*)(WCOM + W_GATE), D, 0, scr, gw, NGW, lane);
            cvt_flat(inp(1) + (size_t)L * M * 256, (h16*)wsp(WS_PH), (size_t)M * 256, gtid, NT);
        }
        SEAM(P0 + 0);

        if (kind == 0) {
            if (IN(P0 + 1) && !(SKIPMASK & 2)) {
                { unsigned char* OV = wsp(WS_OV);
                  Gemm g{(const h16*)wsp(xhc_off), (const h16*)wsp(WS_WMIX + W_RETA), M, 8192, D, D, D}; StaticOrder S; S.init(M, 8192, G, bid);
                  EpiRetA E{(h16*)(OV + OV_Q), (h16*)(OV + OV_K), (h16*)(OV + OV_SG), (const float*)wsp(WS_COS), (const float*)wsp(WS_SIN)};
                  gemm_phase<EpiRetA>(lds, g, S, E, wave0); }
                { unsigned char* OV = wsp(WS_OV);
                  Gemm g{(const h16*)wsp(WS_WMIX + W_RETB), (const h16*)wsp(xhc_off), 6144, M, D, D, D}; StaticOrder S; S.init(6144, M, G, bid);
                  EpiRetB E{(h16*)(OV + OV_KT), (h16*)(OV + OV_VT), (const float*)wsp(WS_COST), (const float*)wsp(WS_SINT)};
                  gemm_phase<EpiRetB>(lds, g, S, E, wave0); }
            }
            SEAM(P0 + 1);
            if (IN(P0 + 2) && !(SKIPMASK & 4)) { TCOORDS unsigned char* OV = wsp(WS_OV);
                ret_scan((const h16*)(OV + OV_KT), (const h16*)(OV + OV_VT), (h16*)(OV + OV_RALL), bid, G, wave, lane); }
            SEAM(P0 + 2);
            if (IN(P0 + 3) && !(SKIPMASK & 8)) { TCOORDS unsigned char* OV = wsp(WS_OV);
                ret_core(lds, (const h16*)(OV + OV_Q), (const h16*)(OV + OV_K), (const h16*)(OV + OV_VT), (const h16*)(OV + OV_RALL), (h16*)(OV + OV_SG), inp(5) + (size_t)(L / 3) * 4096, bid, G, tid, wave, lane); }
            SEAM(P0 + 3);
        } else if (kind == 1) {
            if (IN(P0 + 1)) { Gemm g{(const h16*)wsp(xhc_off), (const h16*)wsp(WS_WMIX + W_SWAQKV), M, 2560, D, D, D}; StaticOrder S; S.init(M, 2560, G, bid);
                EpiH16 E{(h16*)wsp(WS_OV + OV_QKV), 2560, 2048, 0.125f}; gemm_phase<EpiH16>(lds, g, S, E, wave0); }
            SEAM(P0 + 1);
            if (IN(P0 + 2) && !(SKIPMASK & 16)) { TCOORDS swa_attn((const h16*)wsp(WS_OV + OV_QKV), inp(8), inp(10), (h16*)wsp(mixo_off), gw, NGW, lane); }
            SEAM(P0 + 2);
        } else {
            if (IN(P0 + 1) && !(SKIPMASK & 128)) { TCOORDS rwkv_prep((const float*)wsp(WS_XF), inp(11), (h16*)wsp(WS_OV + OV_LX), gtid, NT); }
            SEAM(P0 + 1);
            if (IN(P0 + 2)) { Gemm g{(const h16*)wsp(WS_OV + OV_LX), (const h16*)wsp(WS_WMIX + W_RW1), M, 6912, D, D, D}; StaticOrder S; S.init(M, 6912, G, bid);
                EpiRw1 E{(h16*)wsp(WS_OV + OV_RKV), (h16*)wsp(WS_OV + OV_MID)}; gemm_phase<EpiRw1>(lds, g, S, E, wave0); }
            SEAM(P0 + 2);
            if (IN(P0 + 3)) { Gemm g{(const h16*)wsp(WS_OV + OV_MID), (const h16*)wsp(WS_WMIX + W_RW2), M, 6144, 256, 256, 256}; StaticOrder S; S.init(M, 6144, G, bid);
                EpiRw2 E{(h16*)wsp(WS_OV + OV_WAG), inp(13), inp(16)}; gemm_phase<EpiRw2>(lds, g, S, E, wave0); }
            SEAM(P0 + 3);
            if (IN(P0 + 4)) { TCOORDS rwkv_sprep((const h16*)wsp(WS_OV + OV_RKV), (const h16*)wsp(WS_OV + OV_WAG), inp(21), inp(22), (h16*)wsp(WS_OV + OV_LX), gw, NGW, lane); }
            SEAM(P0 + 4);
            if (IN(P0 + 5) && !(SKIPMASK & 32)) { TCOORDS rwkv_scan((const h16*)wsp(WS_OV + OV_LX), (float*)wsp(WS_OV + OV_WAG), bid, G, wave, lane); }
            SEAM(P0 + 5);
            if (IN(P0 + 6)) { TCOORDS rwkv_post((const float*)wsp(WS_OV + OV_WAG), (const h16*)wsp(WS_OV + OV_LX), (const h16*)wsp(WS_OV + OV_WAG) + (size_t)2 * M * D, inp(23), inp(24), inp(25), (h16*)wsp(mixo_off), gw, NGW, lane); }
            SEAM(P0 + 6);
        }

        if (IN(P0 + 8)) { Gemm g{(const h16*)wsp(mixo_off), (const h16*)wsp(WS_WMIX + W_OUT), M, D, kout, kout, kout}; StaticOrder S; S.init(M, D, G, bid);
            EpiRes E{(L == 0) ? inp(0) : (const float*)wsp(WS_XF), (float*)wsp(WS_YF)}; gemm_phase<EpiRes>(lds, g, S, E, wave0); }
        SEAM(P0 + 8);
        if (IN(P0 + 9)) { TCOORDS ln_rows((const float*)wsp(WS_YF), inp(2) + (size_t)(L * 2 + 0) * D, inp(3) + (size_t)(L * 2 + 0) * D, (float*)wsp(WS_XF), (h16*)wsp(xho_off), gw, NGW, lane); }
        SEAM(P0 + 9);
        if (IN(P0 + 10)) { Gemm g{(const h16*)wsp(xho_off), (const h16*)wsp(WS_WCOM + W_UP), M, DFF2, D, D, D}; StaticOrder S; S.init(M, DFF2, G, bid);
            EpiH16 E{(h16*)wsp(WS_OV + OV_H), DFF2, 0, 1.0f}; gemm_phase<EpiH16>(lds, g, S, E, wave0); }
        SEAM(P0 + 10);
        if (IN(P0 + 11) && !(SKIPMASK & 64)) { TCOORDS conv_act((const h16*)wsp(WS_OV + OV_H), inp(28) + (size_t)L * 3 * DFF2, inp(29) + (size_t)L * DFF2, (h16*)wsp(WS_OV + OV_ACT), gtid, NT); }
        SEAM(P0 + 11);
        if (IN(P0 + 12)) { Gemm g{(const h16*)wsp(WS_OV + OV_ACT), (const h16*)wsp(WS_WCOM + W_DOWN), M, D, DFF, DFF, DFF}; StaticOrder S; S.init(M, D, G, bid);
            EpiRes E{(const float*)wsp(WS_XF), (float*)wsp(WS_YF)}; gemm_phase<EpiRes>(lds, g, S, E, wave0); }
        SEAM(P0 + 12);
        if (IN(P0 + 13)) {
            { TCOORDS ln_rows((const float*)wsp(WS_YF), inp(2) + (size_t)(L * 2 + 1) * D, inp(3) + (size_t)(L * 2 + 1) * D, (float*)wsp(WS_XF), (h16*)wsp(xhc_off), gw, NGW, lane); }
            __syncthreads();
            Gemm g{(const h16*)wsp(WS_PH), (const h16*)wsp(WS_WCOM + W_PP), M, D, 256, 256, 256}; StaticOrder S; S.init(M, D, G, bid);
            EpiH16 E{(h16*)wsp(WS_OV + OV_PP), D, 0, 1.0f}; gemm_phase<EpiH16>(lds, g, S, E, wave0);
        }
        SEAM(P0 + 13);
        if (IN(P0 + 14)) { Gemm g{(const h16*)wsp(xhc_off), (const h16*)wsp(WS_WCOM + W_GATE), M, D, D, D, D}; StaticOrder S; S.init(M, D, G, bid);
            EpiPle E{(const float*)wsp(WS_XF), (const h16*)wsp(WS_OV + OV_PP), (L == 3) ? outp() : (float*)wsp(WS_XF), (L == 3) ? (h16*)nullptr : (h16*)wsp(xho_off)}; gemm_phase<EpiPle>(lds, g, S, E, wave0); }
        if (L < 3) SEAM(P0 + 14);
    }
#undef IN
#undef SEAM
#undef TCOORDS
}

static bool phase_exists(int ph) {
    if (ph == 0) return true;
    const int L = (ph - 1) / PH_PER_LAYER, p = (ph - 1) % PH_PER_LAYER, kind = L % 3;
    if (p == 0 || (p >= 8 && p <= 14)) return true;
    if (kind == 0) return p >= 1 && p <= 3;
    if (kind == 1) return p >= 1 && p <= 2;
    return p >= 1 && p <= 6;
}
extern "C" void kernel_launch(void* const* d_in, const int* in_sizes, int n_in, void* d_out, int out_size, void* d_ws, size_t ws_size, hipStream_t stream) {
    static int grid = 0;
    if (grid == 0) {
        if (n_in != 33 || in_sizes[0] != M * D || out_size != M * D || ws_size < WS_END) { fprintf(stderr, "kernel_launch: unexpected shapes (n_in %d, in0 %d, out %d, ws %zu < %zu)\n", n_in, n_in > 0 ? in_sizes[0] : -1, out_size, ws_size, (size_t)WS_END); grid = -1; return; }
        int dev = 0, cus = 0, per_cu = 0;
        if (hipGetDevice(&dev) != hipSuccess || hipDeviceGetAttribute(&cus, hipDeviceAttributeMultiprocessorCount, dev) != hipSuccess) { grid = -1; return; }
        if (hipFuncSetAttribute((const void*)mega, hipFuncAttributeMaxDynamicSharedMemorySize, LDS_BYTES) != hipSuccess) { fprintf(stderr, "kernel_launch: hipFuncSetAttribute failed\n"); grid = -1; return; }
        if (hipOccupancyMaxActiveBlocksPerMultiprocessor(&per_cu, (const void*)mega, NTHR, LDS_BYTES) != hipSuccess || per_cu < 1) fprintf(stderr, "kernel_launch: occupancy query says %d\n", per_cu);
        (void)hipGetLastError();
        grid = cus;
    }
    if (grid < 0) return;
    (void)hipMemsetAsync((char*)d_ws + WS_CTL, 0, CTL_ZERO_BYTES, stream);
    Args a{};
    for (int i = 0; i < 33; ++i) a.in[i] = (const float*)d_in[i];
    a.out = (float*)d_out; a.ws = (unsigned char*)d_ws;
#if ONE_LAUNCH
    a.ph_lo = 0; a.ph_hi = N_PHASES;
    hipLaunchKernelGGL(mega, dim3(grid), dim3(NTHR), LDS_BYTES, stream, a);
#else
    for (int ph = 0; ph < N_PHASES; ++ph) { if (!phase_exists(ph)) continue; a.ph_lo = ph; a.ph_hi = ph + 1;
        hipLaunchKernelGGL(mega, dim3(grid), dim3(NTHR), LDS_BYTES, stream, a); }
#endif
}
```

```cpp
#include <hip/hip_runtime.h>
#include <cstdio>
#include <cstdint>
#include <cstddef>

#define LAS __attribute__((address_space(3)))
#define GAS __attribute__((address_space(1)))
#define DI __device__ __forceinline__
typedef _Float16 h16;
typedef _Float16 h16x8 __attribute__((ext_vector_type(8)));
typedef _Float16 h16x4 __attribute__((ext_vector_type(4)));
typedef _Float16 h16x2 __attribute__((ext_vector_type(2)));
typedef float f32x4 __attribute__((ext_vector_type(4)));
typedef float f32x2 __attribute__((ext_vector_type(2)));
typedef unsigned u32x4 __attribute__((ext_vector_type(4)));
typedef unsigned u32x2 __attribute__((ext_vector_type(2)));

#ifndef SKIPMASK
#define SKIPMASK 0
#endif
#ifndef PROBE_PH
#define PROBE_PH 11
#endif
#ifndef PROBE_N
#define PROBE_N 4
#endif
#ifndef PROBE_VAR
#define PROBE_VAR 0
#endif
#ifndef ONE_LAUNCH
#define ONE_LAUNCH 1
#endif

constexpr int SEQ = 8192, M = 16384, D = 2048, DFF = 5504, DFF2 = 11008, NWAVES = 8, NTHR = 512;
constexpr float ALPHA = 1.681792830507429f;
constexpr float LN_EPS = 1e-5f;

constexpr size_t MiB = 1u << 20;
constexpr size_t WS_CTL = 0, CTL_ZERO_BYTES = 1 * MiB;
constexpr size_t WS_COS = 1 * MiB, WS_SIN = 5 * MiB;
constexpr size_t WS_PH = 17 * MiB;
constexpr size_t WS_WMIX = 25 * MiB;
constexpr size_t WS_WCOM = 97 * MiB;
constexpr size_t WS_XF = 171 * MiB;
constexpr size_t WS_YF = 299 * MiB;
constexpr size_t WS_XH0 = 427 * MiB, WS_XH1 = 491 * MiB;
constexpr size_t WS_OV = 555 * MiB;
constexpr size_t WS_END = 1376 * MiB;
constexpr size_t W_RETA = 0, W_RETB = 32 * MiB, W_OUT = 56 * MiB;
constexpr size_t W_SWAQKV = 0;
constexpr size_t W_RW1 = 0, W_RW2 = 27 * MiB;
constexpr size_t W_UP = 0, W_DOWN = 43 * MiB, W_PP = 65 * MiB, W_GATE = 66 * MiB;
constexpr size_t OV_Q = 0, OV_K = 64 * MiB, OV_SG = 128 * MiB, OV_KT = 256 * MiB, OV_VT = 320 * MiB, OV_RALL = 448 * MiB;
constexpr size_t OV_QKV = 0, OV_SWAO = 128 * MiB;
constexpr size_t OV_LX = 0  , OV_RKV = 400 * MiB  , OV_MID = 592 * MiB  , OV_WAG = 616 * MiB  ;
constexpr size_t OV_HALO = 0  , OV_PP = 16 * MiB  , OV_ACT = 344 * MiB  ;
static_assert(OV_WAG + 192 * MiB <= WS_END - WS_OV && OV_RALL + 256 * MiB <= WS_END - WS_OV && OV_ACT + 172 * MiB <= WS_END - WS_OV, "overlay");

constexpr int LDS_BYTES = 155648;
constexpr int MISC_OFF = 151552;

DI unsigned pkh(float a, float b) { f32x2 v = {a, b}; h16x2 h = __builtin_convertvector(v, h16x2); return __builtin_bit_cast(unsigned, h); }
DI u32x2 pk4(f32x4 v) { u32x2 r; r.x = pkh(v[0], v[1]); r.y = pkh(v[2], v[3]); return r; }
DI u32x4 pk8(f32x4 a, f32x4 b) { u32x4 r; r.x = pkh(a[0], a[1]); r.y = pkh(a[2], a[3]); r.z = pkh(b[0], b[1]); r.w = pkh(b[2], b[3]); return r; }
DI int lane_id() { unsigned m = ~0u; asm volatile("" : "+s"(m)); int l = (int)__builtin_amdgcn_mbcnt_hi(m, __builtin_amdgcn_mbcnt_lo(m, 0u)); asm volatile("" : "+v"(l)); return l; }
DI float shfl_idx(float v, int src) { return __builtin_bit_cast(float, __builtin_amdgcn_ds_bpermute(src << 2, __builtin_bit_cast(int, v))); }
DI float shfl_xor_(float v, int o, int lane) { return shfl_idx(v, lane ^ o); }
DI float wave_sum(float v, int lane) {
#pragma unroll
    for (int o = 1; o < 64; o <<= 1) v += shfl_xor_(v, o, lane);
    return v;
}
DI float wave_max(float v, int lane) {
#pragma unroll
    for (int o = 1; o < 64; o <<= 1) v = fmaxf(v, shfl_xor_(v, o, lane));
    return v;
}
DI float sigmoidf_(float x) { return __builtin_amdgcn_rcpf(1.0f + __expf(-x)); }
__constant__ float L2GAMMA[8] = {-0.04580368961312479f, -0.02272007650008353f, -0.011315313227834146f, -0.005646563141142063f, -0.0028205190623786626f, -0.0014095702546713536f, -0.0007046129765893727f, -0.0003522634716290214f};
DI float log2gamma(int h) { return L2GAMMA[h]; }
DI f32x4 zero4() { float a, b, c, d; asm volatile("v_mov_b32 %0, 0\n\tv_mov_b32 %1, 0\n\tv_mov_b32 %2, 0\n\tv_mov_b32 %3, 0" : "=v"(a), "=v"(b), "=v"(c), "=v"(d)); return (f32x4){a, b, c, d}; }

namespace pg8 {
constexpr int BM = 256, BK = 64, HALF = 128, HTB = HALF * BK * 2, STAGE_BYTES = 8 * HTB, NXCD = 8, WGM = 8;
__host__ __device__ __forceinline__ int lds_byte(int r, int c) { const int st = (r >> 4) * 2 + (c >> 5), rr = r & 15, cc = c & 31, ob = rr * 64 + cc * 2; return st * 1024 + (ob ^ (((ob >> 9) & 1) << 5)); }
__host__ __device__ __forceinline__ void stage_rc(int b, int& R, int& C) { const int st = b / 1024, sb = b % 1024, swz = sb ^ (((sb >> 9) & 1) << 5); R = (st >> 1) * 16 + swz / 64; C = (st & 1) * 32 + (swz % 64) / 2; }
__host__ __device__ __forceinline__ int perm32(int rho) { const int n = rho >> 4, i = rho & 15; return 8 * (i >> 2) + 4 * n + (i & 3); }
struct Unit { int pm, pn; };
struct Gemm { const h16* A; const h16* Bt; int M, N, K, lda, ldb; };
struct StaticOrder {
    int nM, nN, nwg, G, c;
    __host__ __device__ void init(int M_, int N_, int G_, int c_) { nM = M_ / BM; nN = N_ / BM; nwg = nM * nN; G = G_; c = c_; }
    __host__ __device__ bool next(int i, Unit& u) const {
        const long L = (long)i * G + c; if (L >= nwg) return false;
        int wgid = (int)L; { const int q = nwg / NXCD, r = nwg % NXCD, xcd = wgid % NXCD, off = wgid / NXCD; wgid = (xcd < r ? xcd * (q + 1) : r * (q + 1) + (xcd - r) * q) + off; }
        const int nig = WGM * nN, gid = wgid / nig, fm = gid * WGM, gsz = (nM - fm) < WGM ? (nM - fm) : WGM;
        u.pm = fm + ((wgid % nig) % gsz); u.pn = (wgid % nig) / gsz; return true;
    }
};
template <class Epi, bool ALIGN_EPI = true>
__device__ __forceinline__ void gemm_phase(LAS unsigned char* lds, const Gemm g, const StaticOrder& S, const Epi& E, int wave0) {
    int wid = wave0; asm volatile("" : "+s"(wid));
    const int lane = lane_id();
    const int tid = wid * 64 + lane, wr = wid >> 2, wc = wid & 3, fr = lane & 15, fq = lane >> 4;
    int K = g.K; asm volatile("" : "+s"(K)); const int nt = K / BK;
    unsigned voffA[2], voffB[2];
#pragma unroll
    for (int i = 0; i < 2; ++i) { int R, C; stage_rc(tid * 16 + i * 8192, R, C); const int Rb = Epi::PERM ? ((R & ~31) + perm32(R & 31)) : R;
        const int Ra = Epi::ROWPERM ? ((R & ~63) + 4 * (R & 15) + ((R >> 4) & 3)) : R;
        voffA[i] = (unsigned)(Ra * g.lda + C) * 2u; voffB[i] = (unsigned)(Rb * g.ldb + C) * 2u; }
    const size_t kstep = (size_t)(BK * 2);
    const size_t hstepA = (size_t)HALF * g.lda * 2, hstepB = (size_t)HALF * g.ldb * 2;
    const size_t tstepA = 2 * hstepA, tstepB = 2 * hstepB;
    const unsigned ldsw = (unsigned)wid * 1024u;
    const int aoff = lds_byte(wr * 64 + fr, fq * 8), boff = lds_byte(wc * 32 + fr, fq * 8);
#define PG8_SA(b, h) (((b) * 2 + (h)) * HTB)
#define PG8_SB(b, h) ((4 + (b) * 2 + (h)) * HTB)
#define PG8_STAGE(bufoff, gbase, voff) do { _Pragma("unroll") for (int _i = 0; _i < 2; ++_i) \
        __builtin_amdgcn_global_load_lds((const unsigned*)((const char*)(gbase) + (voff)[_i]), (LAS unsigned*)(lds + (bufoff) + ldsw + _i * 8192), 16, 0, 0); } while (0)
#define PG8_LDA(dst, b, h) do { _Pragma("unroll") for (int m = 0; m < 4; ++m) _Pragma("unroll") for (int k = 0; k < 2; ++k) dst[m][k] = *(const LAS h16x8*)(lds + PG8_SA(b, h) + aoff + m * 2048 + k * 1024); } while (0)
#define PG8_LDB(dst, b, h) do { _Pragma("unroll") for (int n = 0; n < 2; ++n) _Pragma("unroll") for (int k = 0; k < 2; ++k) dst[n][k] = *(const LAS h16x8*)(lds + PG8_SB(b, h) + boff + n * 2048 + k * 1024); } while (0)
#define PG8_MMA(ai, bj, At, Bt) do { __builtin_amdgcn_s_setprio(1); _Pragma("unroll") for (int m = 0; m < 4; ++m) _Pragma("unroll") for (int n = 0; n < 2; ++n) _Pragma("unroll") for (int k = 0; k < 2; ++k) \
        acc[ai][bj][m][n] = __builtin_amdgcn_mfma_f32_16x16x32_f16(Bt[n][k], At[m][k], acc[ai][bj][m][n], 0, 0, 0); __builtin_amdgcn_s_setprio(0); } while (0)
#define PG8_WAIT_V(n) asm volatile("s_waitcnt vmcnt(" #n ")" ::: "memory")
#define PG8_WAIT_L(n) asm volatile("s_waitcnt lgkmcnt(" #n ")" ::: "memory")
#define PG8_BAR __builtin_amdgcn_s_barrier()
#define PG8_SCHED __builtin_amdgcn_sched_barrier(0)
    Unit cur, nxt; int ui = 0;
    if (!S.next(0, cur)) return;
    f32x4 acc[2][2][4][2];
#pragma unroll
    for (int a = 0; a < 2; ++a)
#pragma unroll
        for (int b = 0; b < 2; ++b)
#pragma unroll
            for (int m = 0; m < 4; ++m)
#pragma unroll
                for (int n = 0; n < 2; ++n) acc[a][b][m][n] = zero4();
    h16x8 At[4][2], B0[2][2], B1[2][2];
    const char* cA = (const char*)g.A + E.a_off(cur) + (size_t)cur.pm * tstepA; const char* cB = (const char*)g.Bt + (size_t)cur.pn * tstepB;
    PG8_STAGE(PG8_SB(0, 0), cB, voffB); PG8_STAGE(PG8_SB(0, 1), cB + hstepB, voffB); PG8_STAGE(PG8_SA(0, 0), cA, voffA); PG8_STAGE(PG8_SA(0, 1), cA + hstepA, voffA);
    if (wr == 1) PG8_BAR;
    PG8_WAIT_V(2); PG8_BAR;
    PG8_STAGE(PG8_SB(1, 0), cB + kstep, voffB); PG8_STAGE(PG8_SA(1, 0), cA + kstep, voffA); PG8_STAGE(PG8_SB(1, 1), cB + hstepB + kstep, voffB);
    PG8_WAIT_V(6); PG8_BAR;
    for (;;) {
        const bool has_next = S.next(ui + 1, nxt);
        E.pre(lds, cur, ui, wid);
        const char* nA = has_next ? (const char*)g.A + E.a_off(nxt) + (size_t)nxt.pm * tstepA : cA; const char* nB = has_next ? (const char*)g.Bt + (size_t)nxt.pn * tstepB : cB;
        for (int t = 0; t < nt; t += 2) {
            const bool last = (t == nt - 2);
            const char* a1 = cA + (size_t)(t + 1) * kstep;
            const char* a2 = last ? nA : cA + (size_t)(t + 2) * kstep; const char* b2 = last ? nB : cB + (size_t)(t + 2) * kstep;
            const char* a3 = a2 + kstep; const char* b3 = b2 + kstep;
            PG8_LDB(B0, 0, 0); PG8_LDB(B1, 0, 1); PG8_SCHED; PG8_LDA(At, 0, 0); PG8_STAGE(PG8_SA(1, 1), a1 + hstepA, voffA);
            PG8_WAIT_V(8); PG8_WAIT_L(0); PG8_BAR; PG8_MMA(0, 0, At, B0); PG8_MMA(0, 1, At, B1); PG8_BAR; PG8_SCHED;
            PG8_LDA(At, 0, 1); PG8_STAGE(PG8_SB(0, 0), b2, voffB); PG8_STAGE(PG8_SB(0, 1), b2 + hstepB, voffB); PG8_STAGE(PG8_SA(0, 0), a2, voffA);
            PG8_WAIT_V(8); PG8_WAIT_L(0); PG8_BAR; PG8_MMA(1, 0, At, B0); PG8_MMA(1, 1, At, B1); PG8_BAR; PG8_SCHED;
            PG8_LDB(B0, 1, 0); PG8_LDB(B1, 1, 1); PG8_SCHED; PG8_LDA(At, 1, 0); PG8_STAGE(PG8_SA(0, 1), a2 + hstepA, voffA);
            PG8_WAIT_V(8); PG8_WAIT_L(0); PG8_BAR; PG8_MMA(0, 0, At, B0); PG8_MMA(0, 1, At, B1); PG8_BAR; PG8_SCHED;
            PG8_LDA(At, 1, 1); PG8_STAGE(PG8_SB(1, 0), b3, voffB); PG8_STAGE(PG8_SB(1, 1), b3 + hstepB, voffB); PG8_STAGE(PG8_SA(1, 0), a3, voffA);
            PG8_WAIT_V(8); PG8_WAIT_L(0); PG8_BAR; PG8_MMA(1, 0, At, B0); PG8_MMA(1, 1, At, B1); PG8_BAR; PG8_SCHED;
        }
        if constexpr (ALIGN_EPI) { if (wr == 0) PG8_BAR; }
        { const int l2_ = lane_id(); int fr_ = l2_ & 15, fq_ = l2_ >> 4, wr_ = wr, wc_ = wc; asm volatile("" : "+v"(fr_), "+v"(fq_), "+s"(wr_), "+s"(wc_)); E(acc, cur, ui, wr_, wc_, fr_, fq_); }
        if (!has_next) break;
#pragma unroll
        for (int a = 0; a < 2; ++a)
#pragma unroll
            for (int b = 0; b < 2; ++b)
#pragma unroll
                for (int m = 0; m < 4; ++m)
#pragma unroll
                    for (int n = 0; n < 2; ++n) acc[a][b][m][n] = zero4();
        cur = nxt; cA = nA; cB = nB; ++ui;
        if constexpr (ALIGN_EPI) { if (wr == 1) PG8_BAR; }
    }
    PG8_WAIT_V(0);
    if constexpr (!ALIGN_EPI) { if (wr == 0) PG8_BAR; }
    PG8_BAR;
#undef PG8_SA
#undef PG8_SB
#undef PG8_STAGE
#undef PG8_LDA
#undef PG8_LDB
#undef PG8_MMA
#undef PG8_WAIT_V
#undef PG8_WAIT_L
#undef PG8_BAR
#undef PG8_SCHED
}
}
using pg8::Unit; using pg8::Gemm; using pg8::StaticOrder; using pg8::gemm_phase;
typedef const f32x4 (&AccRef)[2][2][4][2];

struct EpiRes {
    static constexpr bool PERM = true; static constexpr bool ROWPERM = false;
    const h16* res; h16* out;
    DI size_t a_off(const Unit&) const { return 0; }
    DI void pre(LAS unsigned char*, const Unit&, int, int) const {}
    DI void operator()(AccRef acc, const Unit& u, int ui, int wr, int wc, int fr, int fq) const {
        const int row0 = u.pm * 256 + wr * 64 + fr, col0 = u.pn * 256 + wc * 32 + 8 * fq;
        h16x8 r8[2][4][2];
#pragma unroll
        for (int ai = 0; ai < 2; ++ai)
#pragma unroll
            for (int m = 0; m < 4; ++m)
#pragma unroll
                for (int bj = 0; bj < 2; ++bj) r8[ai][m][bj] = *(const h16x8*)(res + (size_t)(row0 + ai * 128 + m * 16) * D + col0 + bj * 128);
#pragma unroll
        for (int ai = 0; ai < 2; ++ai)
#pragma unroll
            for (int m = 0; m < 4; ++m)
#pragma unroll
                for (int bj = 0; bj < 2; ++bj) { f32x4 a, b;
#pragma unroll
                    for (int j = 0; j < 4; ++j) { a[j] = (float)r8[ai][m][bj][j] * ALPHA + acc[ai][bj][m][0][j]; b[j] = (float)r8[ai][m][bj][4 + j] * ALPHA + acc[ai][bj][m][1][j]; }
                    *(u32x4*)(out + (size_t)(row0 + ai * 128 + m * 16) * D + col0 + bj * 128) = pk8(a, b); }
    }
};
struct EpiH16 {
    static constexpr bool PERM = true; static constexpr bool ROWPERM = false;
    h16* O; int ldc; int scale_cols; float scale;
    DI size_t a_off(const Unit&) const { return 0; }
    DI void pre(LAS unsigned char*, const Unit&, int, int) const {}
    DI void operator()(AccRef acc, const Unit& u, int ui, int wr, int wc, int fr, int fq) const {
        const int row0 = u.pm * 256 + wr * 64 + fr, col0 = u.pn * 256 + wc * 32 + 8 * fq;
        const float s = (u.pn * 256 < scale_cols) ? scale : 1.0f;
#pragma unroll
        for (int ai = 0; ai < 2; ++ai)
#pragma unroll
            for (int m = 0; m < 4; ++m) { h16* rowp = O + (size_t)(row0 + ai * 128 + m * 16) * ldc + col0;
#pragma unroll
                for (int bj = 0; bj < 2; ++bj) *(u32x4*)(rowp + bj * 128) = pk8(acc[ai][bj][m][0] * s, acc[ai][bj][m][1] * s); }
    }
};
struct EpiRetA {
    static constexpr bool PERM = true; static constexpr bool ROWPERM = false;
    h16 *Q, *Kb, *SG; const float *cosT, *sinT; h16* KT;
    DI size_t a_off(const Unit&) const { return 0; }
    DI void pre(LAS unsigned char*, const Unit&, int, int) const {}
    DI void operator()(AccRef acc, const Unit& u, int ui, int wr, int wc, int fr, int fq) const {
        const int row0 = u.pm * 256 + wr * 64 + fr, cb = wc * 32 + 8 * fq;
        if (u.pn < 16) {
            h16* dst = (u.pn < 8 ? Q : Kb) + (u.pn & 7) * 256 + cb; const float sc = u.pn < 8 ? 1.0f : 0.0625f;
#pragma unroll
            for (int ai = 0; ai < 2; ++ai) {
                f32x4 tc0[4], tc1[4], ts0[4], ts1[4];
#pragma unroll
                for (int m = 0; m < 4; ++m) { const int pos = (row0 + ai * 128 + m * 16) & (SEQ - 1);
                    tc0[m] = *(const f32x4*)(cosT + pos * 128 + cb); tc1[m] = *(const f32x4*)(cosT + pos * 128 + cb + 4); ts0[m] = *(const f32x4*)(sinT + pos * 128 + cb); ts1[m] = *(const f32x4*)(sinT + pos * 128 + cb + 4); }
#pragma unroll
                for (int m = 0; m < 4; ++m) { const int row = row0 + ai * 128 + m * 16, pos = row & (SEQ - 1);
                    const f32x4 c0 = tc0[m], c1 = tc1[m], s0 = ts0[m], s1 = ts1[m];
                    const f32x4 x1a = acc[ai][0][m][0], x1b = acc[ai][0][m][1], x2a = acc[ai][1][m][0], x2b = acc[ai][1][m][1];
                    const f32x4 o1a = (x1a * c0 - x2a * s0) * sc, o1b = (x1b * c1 - x2b * s1) * sc, o2a = (x1a * s0 + x2a * c0) * sc, o2b = (x1b * s1 + x2b * c1) * sc;
                    *(u32x4*)(dst + (size_t)row * D) = pk8(o1a, o1b);
                    *(u32x4*)(dst + (size_t)row * D + 128) = pk8(o2a, o2b);
                    if (u.pn >= 8) {
                        const float f = __builtin_amdgcn_exp2f((float)(127 - (pos & 127)) * log2gamma(u.pn & 7));
                        h16* kt = KT + (size_t)((u.pn & 7) * 256 + cb) * M + row;
#pragma unroll
                        for (int j = 0; j < 4; ++j) { kt[(size_t)j * M] = (h16)(o1a[j] * f); kt[(size_t)(4 + j) * M] = (h16)(o1b[j] * f); kt[(size_t)(128 + j) * M] = (h16)(o2a[j] * f); kt[(size_t)(132 + j) * M] = (h16)(o2b[j] * f); }
                    } }
            }
        } else {
            h16* dst = SG + (u.pn - 16) * 256 + cb;
#pragma unroll
            for (int ai = 0; ai < 2; ++ai)
#pragma unroll
                for (int m = 0; m < 4; ++m) { const int row = row0 + ai * 128 + m * 16;
#pragma unroll
                    for (int bj = 0; bj < 2; ++bj) { f32x4 a = acc[ai][bj][m][0], b = acc[ai][bj][m][1];
#pragma unroll
                        for (int j = 0; j < 4; ++j) { a[j] = a[j] * sigmoidf_(a[j]); b[j] = b[j] * sigmoidf_(b[j]); }
                        *(u32x4*)(dst + (size_t)row * 4096 + bj * 128) = pk8(a, b); } }
        }
    }
};
struct EpiRetB {
    static constexpr bool PERM = true; static constexpr bool ROWPERM = false;
    h16* VT;
    DI size_t a_off(const Unit&) const { return 0; }
    DI void pre(LAS unsigned char*, const Unit&, int, int) const {}
    DI void operator()(AccRef acc, const Unit& u, int ui, int wr, int wc, int fr, int fq) const {
        const int tokb = u.pn * 256 + wc * 32 + 8 * fq;
#pragma unroll
        for (int ai = 0; ai < 2; ++ai)
#pragma unroll
            for (int m = 0; m < 4; ++m) { const int f = u.pm * 256 + ai * 128 + wr * 64 + m * 16 + fr;
#pragma unroll
                for (int bj = 0; bj < 2; ++bj) *(u32x4*)(VT + (size_t)f * M + tokb + bj * 128) = pk8(acc[ai][bj][m][0], acc[ai][bj][m][1]); }
    }
};
struct EpiRw1 {
    static constexpr bool PERM = true; static constexpr bool ROWPERM = false;
    h16 *RKV, *MID;
    DI size_t a_off(const Unit& u) const { return (size_t)(u.pn < 24 ? u.pn >> 3 : u.pn - 21) * ((size_t)M * D * 2); }
    DI void pre(LAS unsigned char*, const Unit&, int, int) const {}
    DI void operator()(AccRef acc, const Unit& u, int ui, int wr, int wc, int fr, int fq) const {
        const int row0 = u.pm * 256 + wr * 64 + fr, cb = wc * 32 + 8 * fq;
        if (u.pn < 24) {
            h16* dst = RKV + (size_t)(u.pn >> 3) * ((size_t)M * D) + (u.pn & 7) * 256 + cb;
#pragma unroll
            for (int ai = 0; ai < 2; ++ai)
#pragma unroll
                for (int m = 0; m < 4; ++m)
#pragma unroll
                    for (int bj = 0; bj < 2; ++bj) *(u32x4*)(dst + (size_t)(row0 + ai * 128 + m * 16) * D + bj * 128) = pk8(acc[ai][bj][m][0], acc[ai][bj][m][1]);
        } else {
            const int t = u.pn - 24; h16* dst = MID + (size_t)t * ((size_t)M * 256) + cb;
#pragma unroll
            for (int ai = 0; ai < 2; ++ai)
#pragma unroll
                for (int m = 0; m < 4; ++m)
#pragma unroll
                    for (int bj = 0; bj < 2; ++bj) { f32x4 a = acc[ai][bj][m][0], b = acc[ai][bj][m][1];
#pragma unroll
                        for (int j = 0; j < 4; ++j) { if (t == 0) { a[j] = 1.0f - 2.0f * __builtin_amdgcn_rcpf(1.0f + __expf(2.0f * a[j])); b[j] = 1.0f - 2.0f * __builtin_amdgcn_rcpf(1.0f + __expf(2.0f * b[j])); }     else if (t == 2) { a[j] = sigmoidf_(a[j]); b[j] = sigmoidf_(b[j]); } }
                        *(u32x4*)(dst + (size_t)(row0 + ai * 128 + m * 16) * 256 + bj * 128) = pk8(a, b); }
        }
    }
};
DI float decay_of(float z) { return __expf(-0.6065306597126334f * sigmoidf_(z)); }
struct EpiRw2 {
    static constexpr bool PERM = true; static constexpr bool ROWPERM = false;
    h16* WAG; const float *w0, *a0;
    DI size_t a_off(const Unit& u) const { return (size_t)(u.pn >> 3) * ((size_t)M * 256 * 2); }
    DI void pre(LAS unsigned char*, const Unit&, int, int) const {}
    template <int T> DI void body(AccRef acc, h16* dst, const float* bias, int row0) const {
#pragma unroll
        for (int bj = 0; bj < 2; ++bj) { f32x4 ba, bb;
            if (T != 2) { ba = *(const f32x4*)(bias + bj * 128); bb = *(const f32x4*)(bias + bj * 128 + 4); }
#pragma unroll
            for (int ai = 0; ai < 2; ++ai)
#pragma unroll
                for (int m = 0; m < 4; ++m) { f32x4 a = acc[ai][bj][m][0], b = acc[ai][bj][m][1]; if (T != 2) { a = a + ba; b = b + bb; }
#pragma unroll
                    for (int j = 0; j < 4; ++j) { if (T == 0) { a[j] = decay_of(a[j]); b[j] = decay_of(b[j]); } else if (T == 1) { a[j] = sigmoidf_(a[j]); b[j] = sigmoidf_(b[j]); } }
                    *(u32x4*)(dst + (size_t)(row0 + ai * 128 + m * 16) * D + bj * 128) = pk8(a, b); } }
    }
    DI void operator()(AccRef acc, const Unit& u, int ui, int wr, int wc, int fr, int fq) const {
        const int row0 = u.pm * 256 + wr * 64 + fr, t = u.pn >> 3, colb = (u.pn & 7) * 256 + wc * 32 + 8 * fq;
        h16* dst = WAG + (size_t)t * ((size_t)M * D) + colb;
        if (t == 0) body<0>(acc, dst, w0 + colb, row0);
        else if (t == 1) body<1>(acc, dst, a0 + colb, row0);
        else body<2>(acc, dst, w0, row0);
    }
};
struct EpiPle {
    static constexpr bool PERM = true; static constexpr bool ROWPERM = false;
    const h16* x2; const h16* pp; float* outf; h16* xh;
    DI size_t a_off(const Unit&) const { return 0; }
    DI void pre(LAS unsigned char*, const Unit&, int, int) const {}
    DI void operator()(AccRef acc, const Unit& u, int ui, int wr, int wc, int fr, int fq) const {
        const int row0 = u.pm * 256 + wr * 64 + fr, col0 = u.pn * 256 + wc * 32 + 8 * fq;
#pragma unroll
        for (int ai = 0; ai < 2; ++ai) {
            h16x8 x8[4][2], p8[4][2];
#pragma unroll
            for (int m = 0; m < 4; ++m)
#pragma unroll
                for (int bj = 0; bj < 2; ++bj) { const size_t o = (size_t)(row0 + ai * 128 + m * 16) * D + col0 + bj * 128; x8[m][bj] = *(const h16x8*)(x2 + o); p8[m][bj] = *(const h16x8*)(pp + o); }
#pragma unroll
            for (int m = 0; m < 4; ++m)
#pragma unroll
                for (int bj = 0; bj < 2; ++bj) { const size_t o = (size_t)(row0 + ai * 128 + m * 16) * D + col0 + bj * 128; f32x4 a, b;
#pragma unroll
                    for (int j = 0; j < 4; ++j) { a[j] = (float)x8[m][bj][j] + (float)p8[m][bj][j] * sigmoidf_(acc[ai][bj][m][0][j]); b[j] = (float)x8[m][bj][4 + j] + (float)p8[m][bj][4 + j] * sigmoidf_(acc[ai][bj][m][1][j]); }
                    if (xh) *(u32x4*)(xh + o) = pk8(a, b); else { *(f32x4*)(outf + o) = a; *(f32x4*)(outf + o + 4) = b; } }
        }
    }
};
DI float row_shr1f(float old, float x) { return __builtin_bit_cast(float, __builtin_amdgcn_update_dpp(__builtin_bit_cast(int, old), __builtin_bit_cast(int, x), 0x111, 0xF, 0xF, false)); }
DI f32x4 row_shr1(f32x4 old, f32x4 v) {
    const float o0 = old[0], o1 = old[1], o2 = old[2], o3 = old[3], a0 = v[0], a1 = v[1], a2 = v[2], a3 = v[3];
    return (f32x4){row_shr1f(o0, a0), row_shr1f(o1, a1), row_shr1f(o2, a2), row_shr1f(o3, a3)}; }
constexpr int EU_WOFF = 139264;
template <bool TRIV> struct EpiUpT {
    static constexpr bool PERM = true; static constexpr bool ROWPERM = true;
    h16* ACT; float* HL; const float* cw; const float* cb; LAS float* hl;
    DI size_t a_off(const Unit&) const { return 0; }
    DI void pre(LAS unsigned char* lds, const Unit& u, int ui, int wid) const {
        if (wid < 4) { const int lane = lane_id(); const float* src = (wid < 3 ? cw + (size_t)wid * DFF2 : cb) + u.pn * 128 + (lane < 32 ? lane * 4 : DFF + (lane - 32) * 4);
            __builtin_amdgcn_global_load_lds((const unsigned*)src, (LAS unsigned*)(lds + EU_WOFF + (ui & 1) * 4096 + wid * 1024), 16, 0, 0); }
    }
    DI void operator()(AccRef acc, const Unit& u, int ui, int wr, int wc, int fr, int fq) const {
        const int cbase = wc * 32 + 8 * fq;
        if constexpr (TRIV) {
#pragma unroll
            for (int n = 0; n < 2; ++n) { const int cu = u.pn * 128 + cbase + 4 * n;
#pragma unroll
                for (int ai = 0; ai < 2; ++ai)
#pragma unroll
                    for (int m = 0; m < 4; ++m) *(u32x2*)(ACT + (size_t)(u.pm * 256 + ai * 128 + wr * 64 + m * 16 + fr) * DFF + cu) = pk4(acc[ai][0][m][n] * acc[ai][1][m][n]); }
            return;
        }
        if (fr == 15) {
#pragma unroll
            for (int ai = 0; ai < 2; ++ai)
#pragma unroll
                for (int bj = 0; bj < 2; ++bj)
#pragma unroll
                    for (int n = 0; n < 2; ++n) { LAS float* hp = hl + ((2 * ai + wr) * 2) * 256 + bj * 128 + cbase + 4 * n; *(LAS f32x4*)hp = acc[ai][bj][2][n]; *(LAS f32x4*)(hp + 256) = acc[ai][bj][3][n]; }
            if (wr == 1) {
#pragma unroll
                for (int bj = 0; bj < 2; ++bj)
#pragma unroll
                    for (int n = 0; n < 2; ++n) { float* gp = HL + (size_t)(u.pm * 4) * DFF2 + u.pn * 256 + bj * 128 + cbase + 4 * n; *(f32x4*)gp = acc[1][bj][2][n]; *(f32x4*)(gp + DFF2) = acc[1][bj][3][n]; }
            }
        }
        if (fr == 0 && wr == 0) {
#pragma unroll
            for (int bj = 0; bj < 2; ++bj)
#pragma unroll
                for (int n = 0; n < 2; ++n) { float* gp = HL + (size_t)(u.pm * 4 + 2) * DFF2 + u.pn * 256 + bj * 128 + cbase + 4 * n; *(f32x4*)gp = acc[0][bj][0][n]; *(f32x4*)(gp + DFF2) = acc[0][bj][1][n]; }
        }
        asm volatile("s_waitcnt lgkmcnt(0)" ::: "memory"); __builtin_amdgcn_s_barrier(); asm volatile("" ::: "memory");
        const LAS unsigned char* lds_ = (const LAS unsigned char*)hl - 131072;
#pragma unroll
        for (int ai = 0; ai < 2; ++ai) {
            const int blk = 2 * ai + wr;
            h16* arow = ACT + (size_t)(u.pm * 256 + ai * 128 + wr * 64 + 4 * fr) * DFF + u.pn * 128 + cbase;
            u32x2 P0[4];
#pragma unroll
            for (int n = 0; n < 2; ++n) {
                const LAS float* wl = (const LAS float*)(lds_ + EU_WOFF + (ui & 1) * 4096) + cbase + 4 * n;
                const LAS float* hp = hl + ((blk - 1) * 2) * 256 + cbase + 4 * n;
                f32x4 hu[4];
                {   const f32x4 w0 = *(const LAS f32x4*)wl, w1 = *(const LAS f32x4*)(wl + 256), w2 = *(const LAS f32x4*)(wl + 512), bb = *(const LAS f32x4*)(wl + 768);
                    f32x4 H1 = zero4(), H2 = zero4();
                    if (blk > 0) { H2 = *(const LAS f32x4*)hp; H1 = *(const LAS f32x4*)(hp + 256); }
                    const f32x4 c0 = acc[ai][0][0][n], c1 = acc[ai][0][1][n], c2 = acc[ai][0][2][n], c3 = acc[ai][0][3][n];
                    const f32x4 S3 = row_shr1(H1, c3), S2 = row_shr1(H2, c2);
                    hu[0] = bb + w2 * c0 + w1 * S3 + w0 * S2; hu[1] = bb + w2 * c1 + w1 * c0 + w0 * S3; hu[2] = bb + w2 * c2 + w1 * c1 + w0 * c0; hu[3] = bb + w2 * c3 + w1 * c2 + w0 * c1; }
                {   const f32x4 w0 = *(const LAS f32x4*)(wl + 128), w1 = *(const LAS f32x4*)(wl + 384), w2 = *(const LAS f32x4*)(wl + 640), bb = *(const LAS f32x4*)(wl + 896);
                    f32x4 H1 = zero4(), H2 = zero4();
                    if (blk > 0) { H2 = *(const LAS f32x4*)(hp + 128); H1 = *(const LAS f32x4*)(hp + 256 + 128); }
                    const f32x4 c0 = acc[ai][1][0][n], c1 = acc[ai][1][1][n], c2 = acc[ai][1][2][n], c3 = acc[ai][1][3][n];
                    const f32x4 S3 = row_shr1(H1, c3), S2 = row_shr1(H2, c2);
                    f32x4 hg[4];
                    hg[0] = bb + w2 * c0 + w1 * S3 + w0 * S2; hg[1] = bb + w2 * c1 + w1 * c0 + w0 * S3; hg[2] = bb + w2 * c2 + w1 * c1 + w0 * c0; hg[3] = bb + w2 * c3 + w1 * c2 + w0 * c1;
#pragma unroll
                    for (int m = 0; m < 4; ++m) { f32x4 o;
#pragma unroll
                        for (int j = 0; j < 4; ++j) o[j] = hg[m][j] * sigmoidf_(hg[m][j]) * hu[m][j];
                        const u32x2 pk_ = pk4(o); if (n == 0) P0[m] = pk_; else *(u32x4*)(arow + (size_t)m * DFF) = (u32x4){P0[m].x, P0[m].y, pk_.x, pk_.y}; } }
            }
        }
    }
};
using EpiUp = EpiUpT<false>;
DI void ffn_fixup(const float* HL, const float* cw, const float* cb, h16* ACT, int gtid, int NT) {
    for (int i = gtid; i < 64 * 2 * (DFF / 4); i += NT) { const int q = i % (DFF / 4), r = (i / (DFF / 4)) & 1, pm = i / (2 * (DFF / 4));
        if ((pm & 31) == 0) continue;
        const int c = 4 * q, hc = 256 * (c >> 7) + (c & 127);
        const float* cur = HL + (size_t)(pm * 4 + 2 + r) * DFF2 + hc; const float* m1 = r ? HL + (size_t)(pm * 4 + 2) * DFF2 + hc : HL + (size_t)((pm - 1) * 4 + 1) * DFF2 + hc;
        const float* m2 = r ? HL + (size_t)((pm - 1) * 4 + 1) * DFF2 + hc : HL + (size_t)((pm - 1) * 4) * DFF2 + hc;
        const f32x4 hu = *(const f32x4*)(cb + c) + *(const f32x4*)(cw + 2 * DFF2 + c) * *(const f32x4*)cur + *(const f32x4*)(cw + DFF2 + c) * *(const f32x4*)m1 + *(const f32x4*)(cw + c) * *(const f32x4*)m2;
        const int g = DFF + c;
        const f32x4 hg = *(const f32x4*)(cb + g) + *(const f32x4*)(cw + 2 * DFF2 + g) * *(const f32x4*)(cur + 128) + *(const f32x4*)(cw + DFF2 + g) * *(const f32x4*)(m1 + 128) + *(const f32x4*)(cw + g) * *(const f32x4*)(m2 + 128);
        f32x4 o;
#pragma unroll
        for (int j = 0; j < 4; ++j) o[j] = hg[j] * sigmoidf_(hg[j]) * hu[j];
        *(u32x2*)(ACT + (size_t)(pm * 256 + r) * DFF + c) = pk4(o); }
}

#define XB_TMO      128
#define XB_XCNT(j)  (256  + 64 * (j))
#define XB_XSUB(j)  (1280 + 64 * (j))
#define XB_XGEN(j)  (2304 + 64 * (j))
#define XB_TOP      3328
#define XB_TOPGEN   3392
#define XCD_BAR_WORDS 3456
#define XB_SPIN_CAP (1u << 18)
__device__ __forceinline__ unsigned xb_ld(unsigned* p)              { return __hip_atomic_load(p, __ATOMIC_RELAXED, __HIP_MEMORY_SCOPE_AGENT); }
__device__ __forceinline__ unsigned xb_add(unsigned* p, unsigned v) { return __hip_atomic_fetch_add(p, v, __ATOMIC_RELAXED, __HIP_MEMORY_SCOPE_AGENT); }
__device__ __forceinline__ unsigned xb_xcc_id() { return (unsigned)__builtin_amdgcn_s_getreg((3 << 11) | 20) & 0xFu; }
#define XB_SPIN(cond, bar) do { unsigned _sp = 0; while (cond) { __builtin_amdgcn_s_sleep(1); \
    if ((++_sp & 255u) == 0u) { if (xb_ld(&(bar)[XB_TMO])) break; if (_sp > XB_SPIN_CAP) { atomicAdd(&(bar)[XB_TMO], 1u); break; } } } } while (0)
struct XcdBarrier { unsigned* bar; unsigned x; volatile LAS unsigned* st; };
__device__ __forceinline__ XcdBarrier xcd_barrier_post(unsigned* bar, volatile LAS unsigned* st) {
    XcdBarrier b; b.bar = bar; b.x = xb_xcc_id(); b.st = st;
    if (threadIdx.x == 0) (void)xb_add(&bar[XB_XCNT(b.x)], 1u);
    return b;
}
__device__ __forceinline__ void xcd_barrier_complete(unsigned* bar, unsigned x, unsigned& nloc, unsigned& nx) {
    const unsigned G = gridDim.x * gridDim.y * gridDim.z;
    unsigned sum, cnt, mine, sp = 0u;
    for (;;) {
        sum = 0u; cnt = 0u; mine = 0u;
#pragma unroll
        for (unsigned j = 0; j < 16; ++j) { const unsigned c = xb_ld(&bar[XB_XCNT(j)]); sum += c; cnt += (c > 0u) ? 1u : 0u; mine = (j == x) ? c : mine; }
        if (sum == G) break;
        __builtin_amdgcn_s_sleep(1);
        if ((++sp & 255u) == 0u) { if (xb_ld(&bar[XB_TMO])) break; if (sp > XB_SPIN_CAP) { atomicAdd(&bar[XB_TMO], 1u); break; } }
    }
    nloc = mine > 0u ? mine : 1u; nx = cnt > 0u ? cnt : 1u;
}
__device__ __forceinline__ void xcd_barrier(const XcdBarrier& b, int wave0) {
    asm volatile("s_waitcnt vmcnt(0)" ::: "memory");
    __syncthreads();
    if (wave0 == 0 && lane_id() == 0) {
        unsigned* bar = b.bar;
        __builtin_amdgcn_s_waitcnt(0);
        unsigned nloc = b.st[0], nx = b.st[1];
        if (nloc == 0u) { xcd_barrier_complete(bar, b.x, nloc, nx); b.st[0] = nloc; b.st[1] = nx; }
        const unsigned old = xb_add(&bar[XB_XSUB(b.x)], 1u);
        const unsigned gen = old / nloc;
        if (old + 1u == (gen + 1u) * nloc) {
            __builtin_amdgcn_fence(__ATOMIC_RELEASE, "agent");
            asm volatile("s_waitcnt vmcnt(0)" ::: "memory");
            const unsigned og = xb_add(&bar[XB_TOP], 1u);
            const unsigned tg = og / nx;
            if (og + 1u == (tg + 1u) * nx) xb_add(&bar[XB_TOPGEN], 1u);
            else XB_SPIN(xb_ld(&bar[XB_TOPGEN]) == tg, bar);
            __builtin_amdgcn_fence(__ATOMIC_ACQUIRE, "agent");
            xb_add(&bar[XB_XGEN(b.x)], 1u);
            asm volatile("s_waitcnt vmcnt(0)" ::: "memory");
        } else {
            XB_SPIN(xb_ld(&bar[XB_XGEN(b.x)]) == gen, bar);
            __builtin_amdgcn_fence(__ATOMIC_ACQUIRE, "agent");
            asm volatile("s_waitcnt vmcnt(0)" ::: "memory");
        }
    }
    __syncthreads();
}

__constant__ unsigned char T5_BUCKET[128] = {0, 1, 2, 3, 4, 5, 6, 7, 8, 9, 10, 11, 12, 13, 14, 15, 16, 16, 16, 17, 17, 18, 18, 18, 19, 19, 19, 20, 20, 20, 20, 21, 21, 21, 21, 22, 22, 22, 22, 22, 23, 23, 23, 23, 23, 23, 24, 24, 24, 24, 24, 24, 25, 25, 25, 25, 25, 25, 25, 26, 26, 26, 26, 26, 26, 26, 26, 27, 27, 27, 27, 27, 27, 27, 27, 27, 27, 28, 28, 28, 28, 28, 28, 28, 28, 28, 28, 29, 29, 29, 29, 29, 29, 29, 29, 29, 29, 29, 29, 30, 30, 30, 30, 30, 30, 30, 30, 30, 30, 30, 30, 30, 30, 31, 31, 31, 31, 31, 31, 31, 31, 31, 31, 31, 31, 31, 31, 31};

template <bool UPMAP = false>
DI void cvt_job(const float* W, int ldw, int K, int ncols, int col0, h16* WT, int ldt, int row0, LAS float* scr, int gw, int NGW, int lane) {
    const int nblk = ncols / 32, nitems = (K / 64) * nblk;
    for (int item = gw; item < nitems; item += NGW) {
        const int kb = item / nblk, nb = item % nblk, k0 = 64 * kb, n0 = 32 * nb;
        const int ns = UPMAP ? 32 * (((nb & 7) < 4) ? (nb >> 3) * 4 + (nb & 7) : 172 + (nb >> 3) * 4 + (nb & 7) - 4) : n0;
#pragma unroll 8
        for (int i = 0; i < 32; ++i) { const int kk = 2 * i + (lane >> 5); scr[kk * 33 + (lane & 31)] = W[(size_t)(k0 + kk) * ldw + col0 + ns + (lane & 31)]; }
        asm volatile("s_waitcnt lgkmcnt(0)" ::: "memory");
        const int c = lane & 7;
#pragma unroll
        for (int j = 0; j < 4; ++j) { const int n = (lane >> 3) + 8 * j; const LAS float* s = scr + (8 * c) * 33 + n;
            u32x4 o; o.x = pkh(s[0 * 33], s[1 * 33]); o.y = pkh(s[2 * 33], s[3 * 33]); o.z = pkh(s[4 * 33], s[5 * 33]); o.w = pkh(s[6 * 33], s[7 * 33]);
            *(u32x4*)(WT + (size_t)(row0 + n0 + n) * ldt + k0 + 8 * c) = o; }
        asm volatile("s_waitcnt lgkmcnt(0)" ::: "memory");
    }
}
DI void cvt_small(const float* W, int ldw, int Ksrc, int nrows, h16* WT, int ldt, int row0, int gtid, int NT) {
    for (int i = gtid; i < nrows * ldt; i += NT) { const int n = i / ldt, k = i % ldt; WT[(size_t)(row0 + n) * ldt + k] = (h16)(k < Ksrc ? W[(size_t)k * ldw + n] : 0.f); }
}
DI void zero_rows(h16* WT, int ldt, int row0, int nrows, int gtid, int NT) {
    for (int i = gtid; i < nrows * ldt / 8; i += NT) *(u32x4*)(WT + (size_t)row0 * ldt + (size_t)i * 8) = __builtin_bit_cast(u32x4, zero4());
}
DI void cvt_flat(const float* src, h16* dst, size_t n, int gtid, int NT) {
    for (size_t i = (size_t)gtid * 8; i < n; i += (size_t)NT * 8) { const f32x4 a = *(const f32x4*)(src + i), b = *(const f32x4*)(src + i + 4); *(u32x4*)(dst + i) = pk8(a, b); }
}
DI float dpp_rowsum16(float v) {
    v += __builtin_bit_cast(float, __builtin_amdgcn_update_dpp(0, __builtin_bit_cast(int, v), 0xB1, 0xF, 0xF, false));
    v += __builtin_bit_cast(float, __builtin_amdgcn_update_dpp(0, __builtin_bit_cast(int, v), 0x4E, 0xF, 0xF, false));
    v += __builtin_bit_cast(float, __builtin_amdgcn_update_dpp(0, __builtin_bit_cast(int, v), 0x141, 0xF, 0xF, false));
    v += __builtin_bit_cast(float, __builtin_amdgcn_update_dpp(0, __builtin_bit_cast(int, v), 0x140, 0xF, 0xF, false));
    return v;
}
DI float wave_sum_dpp(float v) { v = dpp_rowsum16(v); const int b = __builtin_bit_cast(int, v);
    return (__builtin_bit_cast(float, __builtin_amdgcn_readlane(b, 0)) + __builtin_bit_cast(float, __builtin_amdgcn_readlane(b, 16))) + (__builtin_bit_cast(float, __builtin_amdgcn_readlane(b, 32)) + __builtin_bit_cast(float, __builtin_amdgcn_readlane(b, 48))); }
DI void ln_rows(const h16* src, const float* gain, const float* bias, h16* dsth, int gw, int NGW, int lane) {
    for (int m0 = 2 * gw; m0 < M; m0 += 2 * NGW) {
        h16x8 raw[2][4];
#pragma unroll
        for (int r = 0; r < 2; ++r) { const h16x8* xr = (const h16x8*)(src + (size_t)(m0 + r) * D) + lane;
#pragma unroll
            for (int j = 0; j < 4; ++j) raw[r][j] = xr[64 * j]; }
#pragma unroll
        for (int r = 0; r < 2; ++r) { float v[4][8]; float sm = 0.f;
#pragma unroll
            for (int j = 0; j < 4; ++j)
#pragma unroll
                for (int e = 0; e < 8; ++e) { v[j][e] = (float)raw[r][j][e]; sm += v[j][e]; }
            const float mean = wave_sum_dpp(sm) * (1.f / D); float s2 = 0.f;
#pragma unroll
            for (int j = 0; j < 4; ++j)
#pragma unroll
                for (int e = 0; e < 8; ++e) { v[j][e] -= mean; s2 += v[j][e] * v[j][e]; }
            const float rstd = 1.0f / sqrtf(wave_sum_dpp(s2) * (1.f / D) + LN_EPS);
#pragma unroll
            for (int j = 0; j < 4; ++j) { const int c = 8 * lane + 512 * j; const f32x4 g0 = *(const f32x4*)(gain + c), g1 = *(const f32x4*)(gain + c + 4), b0 = *(const f32x4*)(bias + c), b1 = *(const f32x4*)(bias + c + 4); f32x4 o0, o1;
#pragma unroll
                for (int e = 0; e < 4; ++e) { o0[e] = v[j][e] * rstd * g0[e] + b0[e]; o1[e] = v[j][4 + e] * rstd * g1[e] + b1[e]; }
                *(u32x4*)(dsth + (size_t)(m0 + r) * D + c) = pk8(o0, o1); }
        }
    }
}

constexpr int RS_SLOT = 24576, RS_NS = 6, RS_D = 5;
DI void ret_scan(LAS unsigned char* lds, const h16* KT, const h16* VT, h16* RALL, int bid, int G, int wave, int lane) {
    for (int task = bid; task < 256; task += G) {
        const int bh = (task & 7) * 2 + (task >> 7), sub = (task >> 3) & 15, dkh = sub >> 3, dve = sub & 7, h = bh & 7, b = bh >> 3, r16 = lane & 15, q4 = lane >> 4;
        const float cd = __builtin_amdgcn_exp2f(128.0f * log2gamma(h));
        const int lrow = lane >> 3, lpc = lane & 7;
        __syncthreads();
#define RS_ISSUE(st_) do { const int step_ = (st_), slot_ = step_ % RS_NS; _Pragma("unroll") for (int ii_ = 0; ii_ < 3; ++ii_) { const int row = 8 * (3 * wave + ii_) + lrow, c = lpc ^ ((row >> 1) & 7); \
            const h16* g_ = (row < 128 ? KT + (size_t)(h * 256 + dkh * 128 + row) * M : VT + (size_t)(h * 512 + dve * 64 + (row - 128)) * M) + (size_t)b * SEQ + step_ * 64 + c * 8; \
            __builtin_amdgcn_global_load_lds((const unsigned*)g_, (LAS unsigned*)(lds + slot_ * RS_SLOT + (3 * wave + ii_) * 1024), 16, 0, 0); } } while (0)
        for (int i = 0; i < RS_D; ++i) RS_ISSUE(i);
        f32x4 acc[4];
#pragma unroll
        for (int c = 0; c < 4; ++c) acc[c] = zero4();
        for (int st = 0; st < 128; ++st) {
            asm volatile("s_waitcnt vmcnt(12)" ::: "memory");
            asm volatile("" ::: "memory"); __builtin_amdgcn_s_barrier(); asm volatile("" ::: "memory");
            RS_ISSUE(st + RS_D < 128 ? st + RS_D : 127);
            if ((st & 1) == 0) { h16* rdst = RALL + (((size_t)bh * 64 + (st >> 1)) * 512 + dve * 64) * 256 + dkh * 128 + wave * 16 + q4 * 4;
#pragma unroll
                for (int nt = 0; nt < 4; ++nt) { *(u32x2*)(rdst + (size_t)(nt * 16 + r16) * 256) = pk4(acc[nt]); acc[nt] = acc[nt] * cd; } }
            const LAS unsigned char* sl = lds + (st % RS_NS) * RS_SLOT;
#pragma unroll
            for (int ks = 0; ks < 2; ++ks) { const int ra = wave * 16 + r16, c = ks * 4 + q4;
                const h16x8 af = *(const LAS h16x8*)(sl + ra * 128 + ((c ^ ((ra >> 1) & 7)) << 4));
#pragma unroll
                for (int nt = 0; nt < 4; ++nt) { const int rb = 128 + nt * 16 + r16; const h16x8 bf = *(const LAS h16x8*)(sl + rb * 128 + ((c ^ ((rb >> 1) & 7)) << 4));
                    acc[nt] = __builtin_amdgcn_mfma_f32_16x16x32_f16(af, bf, acc[nt], 0, 0, 0); } }
        }
        asm volatile("s_waitcnt vmcnt(0)" ::: "memory");
#undef RS_ISSUE
    }
}

constexpr int R2_QP = 528, R2_PP = 272, R2_REG2 = 67584, R2_BCS = 16384, R2_NS = 5, R2_D = 4;
DI void ret_core(LAS unsigned char* lds, const h16* Qg, const h16* Kg, const h16* VT, const h16* RALL, const h16* SG, h16* OG, const float* gn, int bid, int G, int tid, int wave, int  ) {
    LAS float* ST1 = (LAS float*)(lds + R2_REG2); LAS float* ST2 = ST1 + 512;
    for (int unit = bid; unit < 1024; unit += G) {
        int fr, fq, wr, wc;
#define R2_FRESH do { asm volatile("" : "+v"(tid), "+s"(wave)); fr = tid & 15; fq = (tid >> 4) & 3; wr = wave >> 2; wc = wave & 3; } while (0)
        R2_FRESH;
        const int bh = unit >> 6, n = unit & 63, b = bh >> 3, h = bh & 7, tok0 = b * SEQ + n * 128;
        const float l2g = log2gamma(h);
        const h16* rsrc = RALL + ((size_t)bh * 64 + n) * 512 * 256;
#define R2_ISSUE(st_) do { const int step_ = (st_); _Pragma("unroll") for (int ii_ = 0; ii_ < 2; ++ii_) { const int row_ = 16 * (2 * wave + ii_) + ((tid & 63) >> 2), pc_ = (tid & 3) ^ ((row_ >> 2) & 3); \
            const h16* g_ = (step_ < 16) ? rsrc + (size_t)((step_ >> 3) * 256 + row_) * 256 + (step_ & 7) * 32 + pc_ * 8 : VT + (size_t)(h * 512 + ((step_ - 16) >> 2) * 256 + row_) * M + tok0 + ((step_ - 16) & 3) * 32 + pc_ * 8; \
            __builtin_amdgcn_global_load_lds((const unsigned*)g_, (LAS unsigned*)(lds + R2_REG2 + (step_ % R2_NS) * R2_BCS + (2 * wave + ii_) * 1024), 16, 0, 0); } } while (0)
#define R2_STEP(st_, ABASE, APITCH, KOFF, HH) do { \
            asm volatile("s_waitcnt vmcnt(6) lgkmcnt(0)" ::: "memory");                                     \
            asm volatile("" ::: "memory"); __builtin_amdgcn_s_barrier(); asm volatile("" ::: "memory");     \
            R2_FRESH; \
            h16x8 af_[4]; \
            _Pragma("unroll") for (int m = 0; m < 4; ++m) af_[m] = *(const LAS h16x8*)(lds + (ABASE) + (wr * 64 + m * 16 + fr) * (APITCH) + ((KOFF) + fq * 8) * 2); \
            _Pragma("unroll") for (int e = 0; e < 4; ++e) { const int rb_ = wc * 64 + e * 16 + fr; const h16x8 bfr_ = *(const LAS h16x8*)(lds + R2_REG2 + ((st_) % R2_NS) * R2_BCS + rb_ * 64 + ((fq ^ ((rb_ >> 2) & 3)) << 4)); \
                _Pragma("unroll") for (int m = 0; m < 4; ++m) acc[m][(HH) * 4 + e] = __builtin_amdgcn_mfma_f32_16x16x32_f16(bfr_, af_[m], acc[m][(HH) * 4 + e], 0, 0, 0); } } while (0)
        __syncthreads();
        {
            u32x4 tq[8];
#pragma unroll
            for (int it = 0; it < 8; ++it) { const int p = tid + 512 * it, row = p >> 5, c16 = p & 31; tq[it] = *(const u32x4*)(Qg + (size_t)(tok0 + row) * D + h * 256 + c16 * 8); }
#pragma unroll
            for (int it = 0; it < 8; ++it) { const int p = tid + 512 * it, row = p >> 5, c16 = p & 31; *(LAS u32x4*)(lds + row * R2_QP + c16 * 16) = tq[it]; }
        }
        asm volatile("s_waitcnt vmcnt(0) lgkmcnt(0)" ::: "memory");
#pragma unroll
        for (int i = 0; i < R2_D; ++i) R2_ISSUE(i);
        f32x4 acc[4][8];
#pragma unroll
        for (int m = 0; m < 4; ++m)
#pragma unroll
            for (int e = 0; e < 8; ++e) acc[m][e] = zero4();
#pragma unroll
        for (int st = 0; st < 16; ++st) {
            R2_STEP(st, 0, R2_QP, (st & 7) * 32, st >> 3);
            R2_ISSUE(st + R2_D < 16 ? st + R2_D : 15);
            if ((st & 7) == 7) {
#pragma unroll
                for (int m = 0; m < 4; ++m) { const float f = __builtin_amdgcn_exp2f((float)(wr * 64 + m * 16 + fr + 1) * l2g);
#pragma unroll
                    for (int e = 0; e < 4; ++e) acc[m][(st >> 3) * 4 + e] = acc[m][(st >> 3) * 4 + e] * f; }
            }
        }
        asm volatile("s_waitcnt vmcnt(0) lgkmcnt(0)" ::: "memory");
        asm volatile("" ::: "memory"); __builtin_amdgcn_s_barrier(); asm volatile("" ::: "memory");
        R2_FRESH;
        {
            u32x4 tk[8];
#pragma unroll
            for (int it = 0; it < 8; ++it) { const int p = tid + 512 * it, row = p >> 5, c16 = p & 31; tk[it] = *(const u32x4*)(Kg + (size_t)(tok0 + row) * D + h * 256 + c16 * 8); }
#pragma unroll
            for (int it = 0; it < 8; ++it) { const int p = tid + 512 * it, row = p >> 5, c16 = p & 31; *(LAS u32x4*)(lds + R2_REG2 + row * R2_QP + c16 * 16) = tk[it]; }
        }
        __syncthreads();
        R2_FRESH;
        {
            f32x4 sacc[4][2];
#pragma unroll
            for (int m = 0; m < 4; ++m) { sacc[m][0] = zero4(); sacc[m][1] = zero4(); }
#pragma unroll
            for (int ks = 0; ks < 8; ++ks) {
                h16x8 af[4];
#pragma unroll
                for (int m = 0; m < 4; ++m) af[m] = *(const LAS h16x8*)(lds + (wr * 64 + m * 16 + fr) * R2_QP + (ks * 32 + fq * 8) * 2);
#pragma unroll
                for (int n2 = 0; n2 < 2; ++n2) { const h16x8 bfr = *(const LAS h16x8*)(lds + R2_REG2 + (wc * 32 + n2 * 16 + fr) * R2_QP + (ks * 32 + fq * 8) * 2);
#pragma unroll
                    for (int m = 0; m < 4; ++m) sacc[m][n2] = __builtin_amdgcn_mfma_f32_16x16x32_f16(bfr, af[m], sacc[m][n2], 0, 0, 0); }
            }
            __syncthreads();
            R2_FRESH;
#pragma unroll
            for (int i = 0; i < R2_D; ++i) R2_ISSUE(16 + i);
#pragma unroll
            for (int m = 0; m < 4; ++m) { const int i = wr * 64 + m * 16 + fr;
#pragma unroll
                for (int n2 = 0; n2 < 2; ++n2) { const int j0 = wc * 32 + n2 * 16 + fq * 4; f32x4 pv;
#pragma unroll
                    for (int j = 0; j < 4; ++j) { const int dd = i - (j0 + j); pv[j] = dd >= 0 ? sacc[m][n2][j] * __builtin_amdgcn_exp2f((float)dd * l2g) : 0.f; }
                    *(LAS u32x2*)(lds + i * R2_PP + j0 * 2) = pk4(pv); } }
        }
#pragma unroll
        for (int st = 16; st < 24; ++st) {
            R2_STEP(st, 0, R2_PP, ((st - 16) & 3) * 32, (st - 16) >> 2);
            R2_ISSUE(st + R2_D < 24 ? st + R2_D : 23);
        }
        asm volatile("s_waitcnt vmcnt(0)" ::: "memory");
        __syncthreads();
        R2_FRESH;
        float mean[4], rstd[4];
#pragma unroll
        for (int m = 0; m < 4; ++m) { float sm = 0.f;
#pragma unroll
            for (int e = 0; e < 8; ++e) sm += (acc[m][e][0] + acc[m][e][1]) + (acc[m][e][2] + acc[m][e][3]);
            sm += shfl_xor_(sm, 16, tid & 63); sm += shfl_xor_(sm, 32, tid & 63);
            if (fq == 0) ST1[(wr * 64 + m * 16 + fr) * 4 + wc] = sm; }
        __syncthreads();
#pragma unroll
        for (int m = 0; m < 4; ++m) { const f32x4 t = *(const LAS f32x4*)(ST1 + (wr * 64 + m * 16 + fr) * 4); mean[m] = ((t[0] + t[1]) + (t[2] + t[3])) * (1.0f / 512.0f); float q = 0.f;
#pragma unroll
            for (int e = 0; e < 8; ++e) { const f32x4 d = acc[m][e] - mean[m]; q += (d[0] * d[0] + d[1] * d[1]) + (d[2] * d[2] + d[3] * d[3]); }
            q += shfl_xor_(q, 16, tid & 63); q += shfl_xor_(q, 32, tid & 63);
            if (fq == 0) ST2[(wr * 64 + m * 16 + fr) * 4 + wc] = q; }
        __syncthreads();
        R2_FRESH;
#pragma unroll
        for (int m = 0; m < 4; ++m) { const f32x4 t = *(const LAS f32x4*)(ST2 + (wr * 64 + m * 16 + fr) * 4); rstd[m] = 1.0f / sqrtf(((t[0] + t[1]) + (t[2] + t[3])) * (1.0f / 512.0f) + 1e-5f); }
#pragma unroll
        for (int m = 0; m < 4; ++m) { const size_t ro = (size_t)(tok0 + wr * 64 + m * 16 + fr) * 4096 + h * 512;
            f32x4 gg[8]; h16x4 s4[8];
#pragma unroll
            for (int e = 0; e < 8; ++e) { const int col = (e >> 2) * 256 + wc * 64 + (e & 3) * 16 + fq * 4; gg[e] = *(const f32x4*)(gn + h * 512 + col); s4[e] = *(const h16x4*)(SG + ro + col); }
#pragma unroll
            for (int e = 0; e < 8; ++e) { const int col = (e >> 2) * 256 + wc * 64 + (e & 3) * 16 + fq * 4; f32x4 o;
#pragma unroll
                for (int j = 0; j < 4; ++j) o[j] = (acc[m][e][j] - mean[m]) * rstd[m] * gg[e][j] * (float)s4[e][j];
                *(u32x2*)(OG + ro + col) = pk4(o); } }
    }
#undef R2_FRESH
#undef R2_ISSUE
#undef R2_STEP
}

typedef float f32x16 __attribute__((ext_vector_type(16)));
constexpr int SW_KP = 144, SW_VP = 528, SW_VOFF = 36864, SW_BOFF = 36864 + 33792;
DI void swa_attn(LAS unsigned char* lds, const h16* QKV, const float* sinks, const float* relb, h16* O, int bid, int G, int tid, int wave, int lane) {
    for (int unit = bid; unit < 512; unit += G) {
        const int hkv = unit & 3, n = (unit >> 2) & 63, b = unit >> 8;
        const int tokq = b * SEQ + n * 128, tokk = tokq - 128, tmin = b * SEQ;
        __syncthreads();
#pragma unroll
        for (int it = 0; it < 4; ++it) { const int p = tid + 512 * it, row = p >> 3, c = p & 7; int tk = tokk + row; tk = tk < tmin ? tmin : tk;
            *(LAS u32x4*)(lds + row * SW_KP + c * 16) = *(const u32x4*)(QKV + (size_t)tk * 2560 + 2048 + hkv * 64 + c * 8); }
#pragma unroll
        for (int it = 0; it < 4; ++it) { const int p = tid + 512 * it, key = p & 255, c = p >> 8; int tk = tokk + key; tk = tk < tmin ? tmin : tk;
            const h16x8 v = *(const h16x8*)(QKV + (size_t)tk * 2560 + 2304 + hkv * 64 + c * 8);
#pragma unroll
            for (int j = 0; j < 8; ++j) *(LAS h16*)(lds + SW_VOFF + (c * 8 + j) * SW_VP + key * 2) = v[j]; }
        for (int idx = tid; idx < 1024; idx += NTHR) ((LAS float*)(lds + SW_BOFF))[idx] = relb[(int)T5_BUCKET[idx & 127] * 32 + hkv * 8 + (idx >> 7)];
        __syncthreads();
        const int hq = hkv * 8 + wave, r = lane & 31, h = lane >> 5;
        const float sink = sinks[hq];
        const LAS float* btab = (const LAS float*)(lds + SW_BOFF) + wave * 128;
        for (int qt = 0; qt < 4; ++qt) {
            h16x8 qf[4];
#pragma unroll
            for (int ks = 0; ks < 4; ++ks) qf[ks] = *(const h16x8*)(QKV + (size_t)(tokq + 32 * qt + r) * 2560 + hq * 64 + 16 * ks + 8 * h);
            f32x16 sc[5];
#pragma unroll
            for (int t5 = 0; t5 < 5; ++t5) {
#pragma unroll
                for (int i4 = 0; i4 < 4; ++i4) { const f32x4 z = zero4(); sc[t5][4 * i4] = z[0]; sc[t5][4 * i4 + 1] = z[1]; sc[t5][4 * i4 + 2] = z[2]; sc[t5][4 * i4 + 3] = z[3]; }
#pragma unroll
                for (int ks = 0; ks < 4; ++ks) { const h16x8 kf = *(const LAS h16x8*)(lds + (32 * (qt + t5) + r) * SW_KP + (16 * ks + 8 * h) * 2);
                    sc[t5] = __builtin_amdgcn_mfma_f32_32x32x16_f16(kf, qf[ks], sc[t5], 0, 0, 0); }
            }
            float mx = sink;
#pragma unroll
            for (int t5 = 0; t5 < 5; ++t5)
#pragma unroll
                for (int i = 0; i < 16; ++i) { const int key = 32 * (qt + t5) + (i & 3) + 8 * (i >> 2) + 4 * h, dist = 128 + 32 * qt + r - key;
                    const bool valid = dist >= 0 && dist < 128 && (n > 0 || key >= 128);
                    const float v = valid ? sc[t5][i] + btab[dist & 127] : -1e30f; sc[t5][i] = v; mx = fmaxf(mx, v); }
            mx = fmaxf(mx, shfl_xor_(mx, 32, lane));
            float sum = 0.f;
#pragma unroll
            for (int t5 = 0; t5 < 5; ++t5)
#pragma unroll
                for (int i = 0; i < 16; ++i) { const float pe = __expf(sc[t5][i] - mx); sc[t5][i] = pe; sum += pe; }
            sum += shfl_xor_(sum, 32, lane);
            const float inv = 1.0f / (sum + __expf(sink - mx));
            f32x16 o[2];
#pragma unroll
            for (int i4 = 0; i4 < 4; ++i4) { const f32x4 z = zero4(), y = zero4(); o[0][4 * i4] = z[0]; o[0][4 * i4 + 1] = z[1]; o[0][4 * i4 + 2] = z[2]; o[0][4 * i4 + 3] = z[3]; o[1][4 * i4] = y[0]; o[1][4 * i4 + 1] = y[1]; o[1][4 * i4 + 2] = y[2]; o[1][4 * i4 + 3] = y[3]; }
#pragma unroll
            for (int t5 = 0; t5 < 5; ++t5)
#pragma unroll
                for (int st = 0; st < 2; ++st) {
                    u32x4 pw; pw.x = pkh(sc[t5][8 * st + 0], sc[t5][8 * st + 1]); pw.y = pkh(sc[t5][8 * st + 2], sc[t5][8 * st + 3]); pw.z = pkh(sc[t5][8 * st + 4], sc[t5][8 * st + 5]); pw.w = pkh(sc[t5][8 * st + 6], sc[t5][8 * st + 7]);
                    const h16x8 pb = __builtin_bit_cast(h16x8, pw);
#pragma unroll
                    for (int dt = 0; dt < 2; ++dt) { const LAS unsigned char* vp = lds + SW_VOFF + (32 * dt + r) * SW_VP + (32 * (qt + t5) + 16 * st + 4 * h) * 2;
                        u32x4 vw; const u32x2 lo = *(const LAS u32x2*)vp, hi = *(const LAS u32x2*)(vp + 16); vw.x = lo.x; vw.y = lo.y; vw.z = hi.x; vw.w = hi.y;
                        o[dt] = __builtin_amdgcn_mfma_f32_32x32x16_f16(__builtin_bit_cast(h16x8, vw), pb, o[dt], 0, 0, 0); }
                }
            h16* orow = O + (size_t)(tokq + 32 * qt + r) * D + hq * 64;
#pragma unroll
            for (int dt = 0; dt < 2; ++dt)
#pragma unroll
                for (int g4 = 0; g4 < 4; ++g4) { f32x4 ov = {o[dt][4 * g4] * inv, o[dt][4 * g4 + 1] * inv, o[dt][4 * g4 + 2] * inv, o[dt][4 * g4 + 3] * inv};
                    *(u32x2*)(orow + 32 * dt + 8 * g4 + 4 * h) = pk4(ov); }
        }
    }
}

DI void rwkv_prep(const h16* __restrict__ X, const float* __restrict__ mix, h16* __restrict__ LX, int gtid, int NT) {
    for (int i = gtid; i < M * (D / 8); i += NT) { const int m = i >> 8, c = (i & 255) * 8; const h16x8 xh = *(const h16x8*)(X + (size_t)m * D + c);
        h16x8 ph = {0, 0, 0, 0, 0, 0, 0, 0}; if ((m & (SEQ - 1)) != 0) ph = *(const h16x8*)(X + (size_t)(m - 1) * D + c);
        f32x4 x0, x1, d0, d1;
#pragma unroll
        for (int j = 0; j < 4; ++j) { x0[j] = (float)xh[j]; x1[j] = (float)xh[4 + j]; d0[j] = (float)ph[j] - x0[j]; d1[j] = (float)ph[4 + j] - x1[j]; }
#pragma unroll
        for (int s = 0; s < 6; ++s) { const int mr = (s == 0) ? 0 : (s == 1) ? 2 : (s == 2) ? 3 : (s == 3) ? 1 : s; const f32x4 m0 = *(const f32x4*)(mix + mr * D + c), m1 = *(const f32x4*)(mix + mr * D + c + 4);
            *(u32x4*)(LX + (size_t)s * M * D + (size_t)m * D + c) = pk8(x0 + d0 * m0, x1 + d1 * m1); } }
}
constexpr int CB_ATL = 0, CB_RLL = 2560, CB_TT = 5632, CB_BK = 6144, CB_Q16 = 10240, CB_BYTES = 10496;
DI float dpp_allreduce16(float v) {
    v += __builtin_bit_cast(float, __builtin_amdgcn_update_dpp(0, __builtin_bit_cast(int, v), 0xB1, 0xF, 0xF, false));
    v += __builtin_bit_cast(float, __builtin_amdgcn_update_dpp(0, __builtin_bit_cast(int, v), 0x4E, 0xF, 0xF, false));
    v += __builtin_bit_cast(float, __builtin_amdgcn_update_dpp(0, __builtin_bit_cast(int, v), 0x141, 0xF, 0xF, false));
    v += __builtin_bit_cast(float, __builtin_amdgcn_update_dpp(0, __builtin_bit_cast(int, v), 0x140, 0xF, 0xF, false));
    return v;
}
constexpr int CP_PITCH = 144, CP_WAVE_LDS = 2 * 32 * 144 + 1024;
DI void rwkv_cprep(LAS unsigned char* lds, const h16* __restrict__ RKV, const h16* __restrict__ WAG, const float* __restrict__ k_k, const float* __restrict__ k_a, const float* __restrict__ r_k, unsigned char* __restrict__ CBG, float* __restrict__ BON, int gw, int NGW, int wave, int lane) {
    LAS unsigned char* AR = lds + wave * CP_WAVE_LDS; LAS unsigned char* BKt = AR + 32 * CP_PITCH; LAS float* LAB = (LAS float*)(BKt + 32 * CP_PITCH);
    for (int unit = gw; unit < 64 * 512; unit += NGW) {
        const int bh = unit >> 9, c = unit & 511, b = bh >> 5, hd = bh & 31, col = hd * 64 + lane, m0 = b * SEQ + c * 16;
        const float kkc = k_k[col], kac = k_a[col], rkc = r_k[col];
        float av[16], bv[16], kv[16], rv[16], pv[16]; float p = 1.0f, bonv = 0.f;
        h16 lr[16], lk[16], lw[16], la[16], lwn[8];
#pragma unroll
        for (int t = 0; t < 16; ++t) { const size_t o = (size_t)(m0 + t) * D + col; lr[t] = RKV[o]; lk[t] = RKV[(size_t)M * D + o]; lw[t] = WAG[o]; la[t] = WAG[(size_t)M * D + o]; }
#pragma unroll
        for (int t = 0; t < 8; ++t) lwn[t] = (c < 511) ? WAG[(size_t)(m0 + 16 + t) * D + col] : (h16)1.0f;
#pragma unroll
        for (int t = 0; t < 16; ++t) {
            const float r = (float)lr[t], k = (float)lk[t], w = (float)lw[t], al = (float)la[t];
            const float kkv = k * kkc; const float nrm = sqrtf(wave_sum_dpp(kkv * kkv)); const float kkn = kkv * __builtin_amdgcn_rcpf(fmaxf(nrm, 1e-12f));
            const float kp = k * (1.0f + (al - 1.0f) * kac);
            const float bon = wave_sum_dpp(r * kp * rkc); bonv = (lane == t) ? bon : bonv;
            p *= w; av[t] = -kkn; bv[t] = kkn * al; kv[t] = kp; rv[t] = r; pv[t] = p; }
        if (lane < 16) BON[(size_t)(m0 + lane) * 32 + hd] = bonv;
        float p8n = 1.0f;
#pragma unroll
        for (int t = 0; t < 8; ++t) p8n *= (float)lwn[t];
        const float inv8 = __builtin_amdgcn_rcpf(pv[7]), q16 = pv[15] * inv8 * p8n;
        const int pk_ = 32 * (lane >> 5) + 8 * ((lane >> 2) & 3) + 4 * ((lane >> 4) & 1) + (lane & 3);
        unsigned char* blk = CBG + (size_t)unit * CB_BYTES;
        h16* ATL = (h16*)(blk + CB_ATL); h16* RLL = (h16*)(blk + CB_RLL); h16* TT = (h16*)(blk + CB_TT); h16* BK = (h16*)(blk + CB_BK);
        float kh[16], bh_[16];
#pragma unroll
        for (int t = 0; t < 16; ++t) { const float qm = (t == 0) ? inv8 : pv[t - 1] * inv8, qt = pv[t] * inv8, iq = __builtin_amdgcn_rcpf(qt);
            const float At = av[t] * qm, Bt = bv[t] * iq, Kt = kv[t] * iq, Rt = rv[t] * qt;
            *(LAS h16*)(AR + t * CP_PITCH + lane * 2) = (h16)At; *(LAS h16*)(AR + (16 + t) * CP_PITCH + lane * 2) = (h16)Rt;
            *(LAS h16*)(BKt + t * CP_PITCH + lane * 2) = (h16)Bt; *(LAS h16*)(BKt + (16 + t) * CP_PITCH + lane * 2) = (h16)Kt;
            ATL[t * 80 + pk_] = (h16)At; RLL[t * 96 + pk_] = (h16)Rt; kh[t] = Kt * q16; bh_[t] = Bt * q16; }
        {
            u32x4 w0, w1, w2, w3;
            w0.x = pkh(kh[0], kh[1]); w0.y = pkh(kh[2], kh[3]); w0.z = pkh(kh[4], kh[5]); w0.w = pkh(kh[6], kh[7]); w1.x = pkh(kh[8], kh[9]); w1.y = pkh(kh[10], kh[11]); w1.z = pkh(kh[12], kh[13]); w1.w = pkh(kh[14], kh[15]);
            w2.x = pkh(bh_[0], bh_[1]); w2.y = pkh(bh_[2], bh_[3]); w2.z = pkh(bh_[4], bh_[5]); w2.w = pkh(bh_[6], bh_[7]); w3.x = pkh(bh_[8], bh_[9]); w3.y = pkh(bh_[10], bh_[11]); w3.z = pkh(bh_[12], bh_[13]); w3.w = pkh(bh_[14], bh_[15]);
            u32x4* br = (u32x4*)(BK + lane * 32);
            br[0] = (u32x4){w2.x, w2.y, w0.x, w0.y}; br[1] = (u32x4){w2.z, w2.w, w0.z, w0.w}; br[2] = (u32x4){w3.x, w3.y, w1.x, w1.y}; br[3] = (u32x4){w3.z, w3.w, w1.z, w1.w};
            ((float*)(blk + CB_Q16))[lane] = q16;
        }
        const int fr = lane & 15, fq = lane >> 4;
        f32x4 lab = zero4(), lak = zero4(), lrb = zero4(), lrk = zero4();
#pragma unroll
        for (int ks = 0; ks < 2; ++ks) {
            const h16x8 fa = *(const LAS h16x8*)(AR + fr * CP_PITCH + (ks * 32 + fq * 8) * 2), fR = *(const LAS h16x8*)(AR + (16 + fr) * CP_PITCH + (ks * 32 + fq * 8) * 2);
            const h16x8 fb = *(const LAS h16x8*)(BKt + fr * CP_PITCH + (ks * 32 + fq * 8) * 2), fk = *(const LAS h16x8*)(BKt + (16 + fr) * CP_PITCH + (ks * 32 + fq * 8) * 2);
            lab = __builtin_amdgcn_mfma_f32_16x16x32_f16(fb, fa, lab, 0, 0, 0); lak = __builtin_amdgcn_mfma_f32_16x16x32_f16(fk, fa, lak, 0, 0, 0);
            lrb = __builtin_amdgcn_mfma_f32_16x16x32_f16(fb, fR, lrb, 0, 0, 0); lrk = __builtin_amdgcn_mfma_f32_16x16x32_f16(fk, fR, lrk, 0, 0, 0);
        }
#pragma unroll
        for (int j = 0; j < 4; ++j) { const int tc = 4 * fq + j; if (tc >= fr) { lab[j] = 0.f; lak[j] = 0.f; } if (tc > fr) { lrb[j] = 0.f; lrk[j] = 0.f; } }
        *(LAS f32x4*)(LAB + fr * 16 + 4 * fq) = lab;
        *(u32x2*)(ATL + fr * 80 + 64 + 4 * fq) = pk4(lak); { const u32x2 pb = pk4(lrb), pk = pk4(lrk); *(u32x4*)(RLL + fr * 96 + 64 + 8 * fq) = (u32x4){pb.x, pb.y, pk.x, pk.y}; }
        {
            const int cc = lane & 15; float tr[16];
#pragma unroll
            for (int t = 0; t < 16; ++t) { float acc = (t == cc) ? 1.0f : 0.0f;
#pragma unroll
                for (int j = 0; j < 16; ++j) if (j < t) acc += LAB[t * 16 + j] * tr[j];
                tr[t] = acc; }
            if (lane < 16) {
#pragma unroll
                for (int t = 0; t < 16; ++t) TT[t * 16 + cc] = (h16)tr[t]; }
        }
    }
}
constexpr int CS_NS = 12, CS_D = 10, CS_SLOT = 11264, CS_VR = CS_NS * CS_SLOT;
DI void rwkv_cscan(LAS unsigned char* lds, const unsigned char* CBG, const h16* Vg, float* YS, int bid, int G, int wave, int lane) {
    for (int task = bid; task < 256; task += G) {
        const int bh = (task & 7) * 8 + (task >> 5), vs = (task >> 3) & 3, b = bh >> 5, hd = bh & 31, fr = lane & 15, fq = lane >> 4;
        const unsigned char* src = CBG + (size_t)bh * 512 * CB_BYTES;
        __syncthreads();
        const h16* vsrc = Vg + (size_t)(b * SEQ + ((lane & 31) >> 1)) * D + hd * 64 + vs * 16 + (lane & 1) * 8;
#define CS_ISSUE(n_) do { const unsigned char* g_ = src + (size_t)(n_) * CB_BYTES + lane * 16; LAS unsigned char* l_ = lds + ((n_) % CS_NS) * CS_SLOT; \
            for (int i = wave - 4; i < 11; i += 4) __builtin_amdgcn_global_load_lds((const unsigned*)(g_ + i * 1024), (LAS unsigned*)(l_ + i * 1024), 16, 0, 0); \
            if (wave == 7) __builtin_amdgcn_global_load_lds((const unsigned*)(vsrc + (size_t)(n_) * 16 * D), (LAS unsigned*)(lds + CS_VR + ((n_) % CS_NS) * 1024), 16, 0, 0); } while (0)
        if (wave >= 4) { for (int i = 0; i < CS_D; ++i) CS_ISSUE(i); asm volatile("s_waitcnt vmcnt(24)" ::: "memory"); static_assert(CS_D == 10, "vmcnt(24) = 3 x (CS_D - 2)"); }
#define CS_BAR do { asm volatile("s_waitcnt lgkmcnt(0)" ::: "memory"); __builtin_amdgcn_s_barrier(); asm volatile("" ::: "memory"); } while (0)
        CS_BAR;
        if (wave >= 4) {
            for (int n = 0; n < 512; ++n) {
                CS_ISSUE(n + CS_D < 512 ? n + CS_D : 511);
                asm volatile("s_waitcnt vmcnt(24)" ::: "memory");
                CS_BAR;
            }
        } else if (wave == 0) {
            struct Ops { f32x4 qq[4]; h16 vr[4]; h16x8 at[2], rl[2], rbk, bk[4]; h16x4 atv, ttx; };
#define CS_H8(lo_, hi_) __builtin_bit_cast(h16x8, (u32x4){(lo_).x, (lo_).y, (hi_).x, (hi_).y})
#define CS_SCHED __builtin_amdgcn_sched_barrier(0)
#define CS_STEP(S, T, n_) do { const int nn_ = (n_) + 1 < 512 ? (n_) + 1 : 511; const LAS unsigned char* blk = lds + (nn_ % CS_NS) * CS_SLOT; const LAS unsigned char* vimg = lds + CS_VR + (nn_ % CS_NS) * 1024; \
                const h16x4 vt4_ = (h16x4){S.vr[0], S.vr[1], S.vr[2], S.vr[3]}; const u32x2 vt2_ = __builtin_bit_cast(u32x2, vt4_); \
                const h16x8 xa0 = CS_H8(pk4(X[0]), pk4(X[1])), xa1 = CS_H8(pk4(X[2]), pk4(X[3]));                                                     \
                f32x4 wg = zero4();                                                                                                                    \
                wg = __builtin_amdgcn_mfma_f32_16x16x32_f16(S.at[0], xa0, wg, 0, 0, 0); \
                wg = __builtin_amdgcn_mfma_f32_16x16x32_f16(S.at[1], xa1, wg, 0, 0, 0); \
                wg = __builtin_amdgcn_mfma_f32_16x16x16f16(S.atv, vt4_, wg, 0, 0, 0); \
                f32x4 yt = zero4();                                                                                                                    \
                yt = __builtin_amdgcn_mfma_f32_16x16x32_f16(S.rl[0], xa0, yt, 0, 0, 0); \
                yt = __builtin_amdgcn_mfma_f32_16x16x32_f16(S.rl[1], xa1, yt, 0, 0, 0); \
                f32x4 qx[4]; _Pragma("unroll") for (int ct = 0; ct < 4; ++ct) qx[ct] = X[ct] * S.qq[ct]; \
                CS_SCHED; \
                _Pragma("unroll") for (int j = 0; j < 4; ++j) T.vr[j] = *(const LAS h16*)(vimg + (4 * fq + j) * 32 + fr * 2);                          \
                _Pragma("unroll") for (int ct = 0; ct < 4; ++ct) T.qq[ct] = *(const LAS f32x4*)(blk + CB_Q16 + (16 * ct + 4 * fq) * 4); \
                CS_SCHED; \
                f32x4 ut = zero4();                                                                                                                    \
                ut = __builtin_amdgcn_mfma_f32_16x16x16f16(S.ttx, __builtin_bit_cast(h16x4, pk4(wg)), ut, 0, 0, 0); \
                CS_SCHED; \
                _Pragma("unroll") for (int ct = 0; ct < 4; ++ct) T.bk[ct] = *(const LAS h16x8*)(blk + CB_BK + (16 * ct + fr) * 64 + fq * 16); \
                _Pragma("unroll") for (int sx = 0; sx < 2; ++sx) T.at[sx] = *(const LAS h16x8*)(blk + CB_ATL + fr * 160 + (sx * 4 + fq) * 16); \
                CS_SCHED; \
                const h16x8 uva = CS_H8(pk4(ut), vt2_); \
                  \
                _Pragma("unroll") for (int ct = 0; ct < 4; ++ct) X[ct] = __builtin_amdgcn_mfma_f32_16x16x32_f16(S.bk[ct], uva, qx[ct], 0, 0, 0); \
                yt = __builtin_amdgcn_mfma_f32_16x16x32_f16(S.rbk, uva, yt, 0, 0, 0); \
                CS_SCHED; \
                _Pragma("unroll") for (int sx = 0; sx < 2; ++sx) T.rl[sx] = *(const LAS h16x8*)(blk + CB_RLL + fr * 192 + (sx * 4 + fq) * 16); \
                T.atv = *(const LAS h16x4*)(blk + CB_ATL + fr * 160 + 128 + fq * 8); T.ttx = *(const LAS h16x4*)(blk + CB_TT + fr * 32 + fq * 8); \
                T.rbk = *(const LAS h16x8*)(blk + CB_RLL + fr * 192 + 128 + fq * 16); \
                float* yp = YS + ((size_t)bh * SEQ + (n_) * 16 + 4 * fq) * 64 + vs * 16 + fr; \
                _Pragma("unroll") for (int j = 0; j < 4; ++j) yp[j * 64] = yt[j]; } while (0)
            f32x4 X[4]; X[0] = zero4(); X[1] = zero4(); X[2] = zero4(); X[3] = zero4();
            Ops A, B;
            {   const LAS unsigned char* blk = lds; const LAS unsigned char* vimg = lds + CS_VR;
#pragma unroll
                for (int j = 0; j < 4; ++j) A.vr[j] = *(const LAS h16*)(vimg + (4 * fq + j) * 32 + fr * 2);
#pragma unroll
                for (int ct = 0; ct < 4; ++ct) { A.qq[ct] = *(const LAS f32x4*)(blk + CB_Q16 + (16 * ct + 4 * fq) * 4); A.bk[ct] = *(const LAS h16x8*)(blk + CB_BK + (16 * ct + fr) * 64 + fq * 16); }
#pragma unroll
                for (int sx = 0; sx < 2; ++sx) { A.at[sx] = *(const LAS h16x8*)(blk + CB_ATL + fr * 160 + (sx * 4 + fq) * 16); A.rl[sx] = *(const LAS h16x8*)(blk + CB_RLL + fr * 192 + (sx * 4 + fq) * 16); }
                A.atv = *(const LAS h16x4*)(blk + CB_ATL + fr * 160 + 128 + fq * 8); A.ttx = *(const LAS h16x4*)(blk + CB_TT + fr * 32 + fq * 8); A.rbk = *(const LAS h16x8*)(blk + CB_RLL + fr * 192 + 128 + fq * 16); }
            for (int n = 0; n < 512; n += 2) {
                CS_STEP(A, B, n); CS_BAR;
                CS_STEP(B, A, n + 1); CS_BAR;
            }
#undef CS_STEP
#undef CS_SCHED
#undef CS_H8
        } else {
            for (int n = 0; n < 512; ++n) CS_BAR;
        }
#undef CS_BAR
#undef CS_ISSUE
    }
}
DI void rwkv_post(const float* YS, const h16* Vg, const float* BON, const h16* Gt, const float* gg, const float* gb, h16* O, int gw, int NGW, int lane) {
    for (int task = gw; task < M * 8; task += NGW) { const int m = task >> 3, hg = task & 7, hd = hg * 4 + (lane >> 4), e0 = (lane & 15) * 4, col = hd * 64 + e0, b = m >> 13, t = m & (SEQ - 1);
        const size_t rb = (size_t)(b * 32 + hd) * SEQ + t;
        const f32x4 y = *(const f32x4*)(YS + rb * 64 + e0);
        const h16x4 v4 = *(const h16x4*)(Vg + (size_t)m * D + col), g4 = *(const h16x4*)(Gt + (size_t)m * D + col); const float bonus = BON[(size_t)m * 32 + hd];
        const f32x4 gn4 = *(const f32x4*)(gg + col), gb4 = *(const f32x4*)(gb + col);
        const float mean = dpp_allreduce16((y[0] + y[1]) + (y[2] + y[3])) * (1.0f / 64.0f); const f32x4 d = y - mean;
        const float var = dpp_allreduce16((d[0] * d[0] + d[1] * d[1]) + (d[2] * d[2] + d[3] * d[3])) * (1.0f / 64.0f);
        const f32x4 o = (d * (1.0f / sqrtf(var + 64e-5f)) * gn4 + gb4 + __builtin_convertvector(v4, f32x4) * bonus) * __builtin_convertvector(g4, f32x4);
        *(u32x2*)(O + (size_t)m * D + col) = pk4(o); }
}

struct Args { const float* in[33]; float* out; unsigned char* ws; int ph_lo, ph_hi, variant; };
constexpr int PH_PER_LAYER = 16, N_PHASES = 1 + 4 * PH_PER_LAYER;

#define CAS __attribute__((address_space(4)))
DI const CAS char* kargs() { const CAS char* kp = (const CAS char*)__builtin_amdgcn_kernarg_segment_ptr(); asm volatile("" : "+s"(kp)); return kp; }
DI const float* inp(int i) { return ((const float* const CAS*)kargs())[i]; }
DI unsigned char* wsp(size_t off) { return *(unsigned char* const CAS*)(kargs() + 272) + off; }
DI float* outp() { return *(float* const CAS*)(kargs() + 264); }
static_assert(offsetof(Args, out) == 264 && offsetof(Args, ws) == 272 && offsetof(Args, ph_lo) == 280, "Args layout");

__global__ void __launch_bounds__(NTHR, 2) mega(Args args) {
    extern __shared__ __attribute__((aligned(16))) unsigned char lds_raw[];
    LAS unsigned char* lds = (LAS unsigned char*)lds_raw;
    const int G = gridDim.x, bid = blockIdx.x;
    const int wave0 = __builtin_amdgcn_readfirstlane(threadIdx.x >> 6);
    {
        volatile LAS unsigned* MISC0 = (volatile LAS unsigned*)(lds + MISC_OFF);
        for (int u = threadIdx.x; u < (LDS_BYTES - MISC_OFF) / 4; u += NTHR) MISC0[u] = 0u;
        __syncthreads();
    }
    XcdBarrier bar = xcd_barrier_post((unsigned*)(args.ws + WS_CTL) + 4096, (volatile LAS unsigned*)(lds + MISC_OFF) + 8);
    const int lo = args.ph_lo, hi = args.ph_hi;
#define IN(k) (lo <= (k) && (k) < hi)
#define SEAM(k) do { if (IN(k) && IN((k) + 1)) xcd_barrier(bar, wave0); } while (0)
#define TCOORDS int wave = wave0; asm volatile("" : "+s"(wave)); int lane = lane_id(); int tid = wave * 64 + lane; \
    const int gw = bid * NWAVES + wave, NGW = G * NWAVES, gtid = bid * NTHR + tid, NT = G * NTHR; (void)lane; (void)gw; (void)NGW; (void)gtid; (void)NT;

    if (IN(0)) {
        TCOORDS
        cvt_flat(inp(0), (h16*)wsp(WS_XH0), (size_t)M * D, gtid, NT);
        float* cosT = (float*)wsp(WS_COS); float* sinT = (float*)wsp(WS_SIN);
        for (int i = gtid; i < SEQ * 128; i += NT) { const int pos = i >> 7, f = i & 127;
            const float pf = (float)pow(10000.0, (double)f / 128.0); const float inv = 1.0f / pf; const float ang = (float)pos * inv;
            const float c = (float)cos((double)ang), sn = (float)sin((double)ang);
            cosT[i] = c; sinT[i] = sn; }
    }
    SEAM(0);

    for (int L = 0; L < 4; ++L) {
        const int kind = L % 3, P0 = 1 + L * PH_PER_LAYER;
        const size_t xhc_off = (L & 1) ? WS_XH1 : WS_XH0, xho_off = (L & 1) ? WS_XH0 : WS_XH1;
        const size_t mixo_off = (kind == 0) ? WS_XF : WS_OV + (kind == 1 ? OV_SWAO : OV_RKV);
        const int kout = (kind == 0) ? 4096 : 2048;

        if (IN(P0 + 0) && !(SKIPMASK & 1)) {
            TCOORDS
            LAS float* scr = (LAS float*)(lds + wave * 16384);
            unsigned char* WMIX = wsp(WS_WMIX); unsigned char* WCOM = wsp(WS_WCOM);
            if (kind == 0) {
                const float* w = inp(4) + (size_t)(L / 3) * D * 12288;
                cvt_job(w, 12288, D, 2048, 0, (h16*)(WMIX + W_RETA), D, 0, scr, gw, NGW, lane);
                cvt_job(w, 12288, D, 2048, 2048, (h16*)(WMIX + W_RETA), D, 2048, scr, gw, NGW, lane);
                cvt_job(w, 12288, D, 4096, 8192, (h16*)(WMIX + W_RETA), D, 4096, scr, gw, NGW, lane);
                cvt_job(w, 12288, D, 4096, 4096, (h16*)(WMIX + W_RETB), D, 0, scr, gw, NGW, lane);
                cvt_job(inp(6) + (size_t)(L / 3) * 4096 * D, D, 4096, D, 0, (h16*)(WMIX + W_OUT), 4096, 0, scr, gw, NGW, lane);
            } else if (kind == 1) {
                cvt_job(inp(7), 2560, D, 2560, 0, (h16*)(WMIX + W_SWAQKV), D, 0, scr, gw, NGW, lane);
                cvt_job(inp(9), D, D, D, 0, (h16*)(WMIX + W_OUT), D, 0, scr, gw, NGW, lane);
            } else {
                h16* w1 = (h16*)(WMIX + W_RW1); h16* w2 = (h16*)(WMIX + W_RW2);
                for (int j = 0; j < 3; ++j) cvt_job(inp(12) + (size_t)j * D * D, D, D, D, 0, w1, D, j * D, scr, gw, NGW, lane);
                cvt_job(inp(14), 96, D, 96, 0, w1, D, 6144, scr, gw, NGW, lane); zero_rows(w1, D, 6144 + 96, 160, gtid, NT);
                cvt_job(inp(17), 96, D, 96, 0, w1, D, 6400, scr, gw, NGW, lane); zero_rows(w1, D, 6400 + 96, 160, gtid, NT);
                cvt_job(inp(19), 256, D, 256, 0, w1, D, 6656, scr, gw, NGW, lane);
                cvt_small(inp(15), D, 96, D, w2, 256, 0, gtid, NT);
                cvt_small(inp(18), D, 96, D, w2, 256, 2048, gtid, NT);
                cvt_job(inp(20), D, 256, D, 0, w2, 256, 4096, scr, gw, NGW, lane);
                cvt_job(inp(26), D, D, D, 0, (h16*)(WMIX + W_OUT), D, 0, scr, gw, NGW, lane);
            }
            cvt_job<true>(inp(27) + (size_t)L * D * DFF2, DFF2, D, DFF2, 0, (h16*)(WCOM + W_UP), D, 0, scr, gw, NGW, lane);
            cvt_job(inp(30) + (size_t)L * DFF * D, D, DFF, D, 0, (h16*)(WCOM + W_DOWN), DFF, 0, scr, gw, NGW, lane);
            cvt_job(inp(31) + (size_t)L * 256 * D, D, 256, D, 0, (h16*)(WCOM + W_PP), 256, 0, scr, gw, NGW, lane);
            cvt_job(inp(32) + (size_t)L * D * D, D, D, D, 0, (h16*)(WCOM + W_GATE), D, 0, scr, gw, NGW, lane);
            cvt_flat(inp(1) + (size_t)L * M * 256, (h16*)wsp(WS_PH), (size_t)M * 256, gtid, NT);
        }
        SEAM(P0 + 0);

        if (kind == 0) {
            if (IN(P0 + 1) && !(SKIPMASK & 2)) {
                { unsigned char* OV = wsp(WS_OV);
                  Gemm g{(const h16*)wsp(xhc_off), (const h16*)wsp(WS_WMIX + W_RETA), M, 8192, D, D, D}; StaticOrder S; S.init(M, 8192, G, bid);
                  EpiRetA E{(h16*)(OV + OV_Q), (h16*)(OV + OV_K), (h16*)(OV + OV_SG), (const float*)wsp(WS_COS), (const float*)wsp(WS_SIN), (h16*)(OV + OV_KT)};
                  gemm_phase<EpiRetA>(lds, g, S, E, wave0); }
                { unsigned char* OV = wsp(WS_OV);
                  Gemm g{(const h16*)wsp(WS_WMIX + W_RETB), (const h16*)wsp(xhc_off), 4096, M, D, D, D}; StaticOrder S; S.init(4096, M, G, bid);
                  EpiRetB E{(h16*)(OV + OV_VT)};
                  gemm_phase<EpiRetB>(lds, g, S, E, wave0); }
            }
            SEAM(P0 + 1);
            if (IN(P0 + 2) && !(SKIPMASK & 4)) { TCOORDS unsigned char* OV = wsp(WS_OV);
                ret_scan(lds, (const h16*)(OV + OV_KT), (const h16*)(OV + OV_VT), (h16*)(OV + OV_RALL), bid, G, wave, lane); }
            SEAM(P0 + 2);
            if (IN(P0 + 3) && !(SKIPMASK & 8)) { TCOORDS unsigned char* OV = wsp(WS_OV);
                ret_core(lds, (const h16*)(OV + OV_Q), (const h16*)(OV + OV_K), (const h16*)(OV + OV_VT), (const h16*)(OV + OV_RALL), (const h16*)(OV + OV_SG), (h16*)wsp(mixo_off), inp(5) + (size_t)(L / 3) * 4096, bid, G, tid, wave, lane); }
            SEAM(P0 + 3);
        } else if (kind == 1) {
            if (IN(P0 + 1)) { Gemm g{(const h16*)wsp(xhc_off), (const h16*)wsp(WS_WMIX + W_SWAQKV), M, 2560, D, D, D}; StaticOrder S; S.init(M, 2560, G, bid);
                EpiH16 E{(h16*)wsp(WS_OV + OV_QKV), 2560, 2048, 0.125f}; gemm_phase<EpiH16>(lds, g, S, E, wave0); }
            SEAM(P0 + 1);
            if (IN(P0 + 2) && !(SKIPMASK & 16)) { TCOORDS swa_attn(lds, (const h16*)wsp(WS_OV + OV_QKV), inp(8), inp(10), (h16*)wsp(mixo_off), bid, G, tid, wave, lane); }
            SEAM(P0 + 2);
        } else {
            if (IN(P0 + 1) && !(SKIPMASK & 128)) { TCOORDS rwkv_prep((const h16*)wsp(xhc_off), inp(11), (h16*)wsp(WS_OV + OV_LX), gtid, NT); }
            SEAM(P0 + 1);
            if (IN(P0 + 2)) { Gemm g{(const h16*)wsp(WS_OV + OV_LX), (const h16*)wsp(WS_WMIX + W_RW1), M, 6912, D, D, D}; StaticOrder S; S.init(M, 6912, G, bid);
                EpiRw1 E{(h16*)wsp(WS_OV + OV_RKV), (h16*)wsp(WS_OV + OV_MID)}; gemm_phase<EpiRw1>(lds, g, S, E, wave0); }
            SEAM(P0 + 2);
            if (IN(P0 + 3)) { Gemm g{(const h16*)wsp(WS_OV + OV_MID), (const h16*)wsp(WS_WMIX + W_RW2), M, 6144, 256, 256, 256}; StaticOrder S; S.init(M, 6144, G, bid);
                EpiRw2 E{(h16*)wsp(WS_OV + OV_WAG), inp(13), inp(16)}; gemm_phase<EpiRw2>(lds, g, S, E, wave0); }
            SEAM(P0 + 3);
            if (IN(P0 + 4)) { TCOORDS rwkv_cprep(lds, (const h16*)wsp(WS_OV + OV_RKV), (const h16*)wsp(WS_OV + OV_WAG), inp(21), inp(22), inp(23), wsp(WS_OV + OV_LX), (float*)wsp(WS_OV + OV_MID), gw, NGW, wave, lane); }
            SEAM(P0 + 4);
            if (IN(P0 + 5) && !(SKIPMASK & 32)) { TCOORDS rwkv_cscan(lds, wsp(WS_OV + OV_LX), (const h16*)wsp(WS_OV + OV_RKV) + (size_t)2 * M * D, (float*)wsp(WS_OV + OV_WAG), bid, G, wave, lane); }
            SEAM(P0 + 5);
            if (IN(P0 + 6)) { TCOORDS rwkv_post((const float*)wsp(WS_OV + OV_WAG), (const h16*)wsp(WS_OV + OV_RKV) + (size_t)2 * M * D, (const float*)wsp(WS_OV + OV_MID), (const h16*)wsp(WS_OV + OV_WAG) + (size_t)2 * M * D, inp(24), inp(25), (h16*)wsp(mixo_off), gw, NGW, lane); }
            SEAM(P0 + 6);
        }

        if (IN(P0 + 8)) { Gemm g{(const h16*)wsp(mixo_off), (const h16*)wsp(WS_WMIX + W_OUT), M, D, kout, kout, kout}; StaticOrder S; S.init(M, D, G, bid);
            EpiRes E{(const h16*)wsp(xhc_off), (h16*)wsp(WS_YF)}; gemm_phase<EpiRes>(lds, g, S, E, wave0); }
        SEAM(P0 + 8);
        if (IN(P0 + 9)) { TCOORDS ln_rows((const h16*)wsp(WS_YF), inp(2) + (size_t)(L * 2 + 0) * D, inp(3) + (size_t)(L * 2 + 0) * D, (h16*)wsp(xho_off), gw, NGW, lane); }
        SEAM(P0 + 9);
        if (IN(P0 + 10)) { Gemm g{(const h16*)wsp(xho_off), (const h16*)wsp(WS_WCOM + W_UP), M, DFF2, D, D, D}; StaticOrder S; S.init(M, DFF2, G, bid);
#if ONE_LAUNCH
            { EpiUp E{(h16*)wsp(WS_OV + OV_ACT), (float*)wsp(WS_OV + OV_HALO), inp(28) + (size_t)L * 3 * DFF2, inp(29) + (size_t)L * DFF2, (LAS float*)(lds + 131072)}; gemm_phase<EpiUp>(lds, g, S, E, wave0); } }
#else
            if (*(const int CAS*)(kargs() + 288)) { EpiUpT<true> E{(h16*)wsp(WS_OV + OV_ACT), (float*)wsp(WS_OV + OV_HALO), inp(28) + (size_t)L * 3 * DFF2, inp(29) + (size_t)L * DFF2, (LAS float*)(lds + 131072)}; gemm_phase<EpiUpT<true>>(lds, g, S, E, wave0); }
            else { EpiUp E{(h16*)wsp(WS_OV + OV_ACT), (float*)wsp(WS_OV + OV_HALO), inp(28) + (size_t)L * 3 * DFF2, inp(29) + (size_t)L * DFF2, (LAS float*)(lds + 131072)}; gemm_phase<EpiUp>(lds, g, S, E, wave0); } }
#endif
        SEAM(P0 + 10);
        if (IN(P0 + 11)) {
            { TCOORDS ffn_fixup((const float*)wsp(WS_OV + OV_HALO), inp(28) + (size_t)L * 3 * DFF2, inp(29) + (size_t)L * DFF2, (h16*)wsp(WS_OV + OV_ACT), gtid, NT); }
            Gemm g{(const h16*)wsp(WS_PH), (const h16*)wsp(WS_WCOM + W_PP), M, D, 256, 256, 256}; StaticOrder S; S.init(M, D, G, bid);
            EpiH16 E{(h16*)wsp(WS_OV + OV_PP), D, 0, 1.0f}; gemm_phase<EpiH16>(lds, g, S, E, wave0);
        }
        SEAM(P0 + 11);
        if (IN(P0 + 12)) { Gemm g{(const h16*)wsp(WS_OV + OV_ACT), (const h16*)wsp(WS_WCOM + W_DOWN), M, D, DFF, DFF, DFF}; StaticOrder S; S.init(M, D, G, bid);
            EpiRes E{(const h16*)wsp(xho_off), (h16*)wsp(WS_YF)}; gemm_phase<EpiRes>(lds, g, S, E, wave0); }
        SEAM(P0 + 12);
        if (IN(P0 + 13)) { TCOORDS ln_rows((const h16*)wsp(WS_YF), inp(2) + (size_t)(L * 2 + 1) * D, inp(3) + (size_t)(L * 2 + 1) * D, (h16*)wsp(xhc_off), gw, NGW, lane); }
        SEAM(P0 + 13);
        if (IN(P0 + 14)) { Gemm g{(const h16*)wsp(xhc_off), (const h16*)wsp(WS_WCOM + W_GATE), M, D, D, D, D}; StaticOrder S; S.init(M, D, G, bid);
            EpiPle E{(const h16*)wsp(xhc_off), (const h16*)wsp(WS_OV + OV_PP), outp(), (L == 3) ? (h16*)nullptr : (h16*)wsp(xho_off)}; gemm_phase<EpiPle>(lds, g, S, E, wave0); }
        if (L < 3) SEAM(P0 + 14);
    }
#undef IN
#undef SEAM
#undef TCOORDS
}

static bool phase_exists(int ph) {
    if (ph == 0) return true;
    const int L = (ph - 1) / PH_PER_LAYER, p = (ph - 1) % PH_PER_LAYER, kind = L % 3;
    if (p == 0 || (p >= 8 && p <= 14)) return true;
    if (kind == 0) return p >= 1 && p <= 3;
    if (kind == 1) return p >= 1 && p <= 2;
    return p >= 1 && p <= 6;
}
extern "C" void kernel_launch(void* const* d_in, const int* in_sizes, int n_in, void* d_out, int out_size, void* d_ws, size_t ws_size, hipStream_t stream) {
    static int grid = 0;
    if (grid == 0) {
        if (n_in != 33 || in_sizes[0] != M * D || out_size != M * D || ws_size < WS_END) { fprintf(stderr, "kernel_launch: unexpected shapes (n_in %d, in0 %d, out %d, ws %zu < %zu)\n", n_in, n_in > 0 ? in_sizes[0] : -1, out_size, ws_size, (size_t)WS_END); grid = -1; return; }
        int dev = 0, cus = 0, per_cu = 0;
        if (hipGetDevice(&dev) != hipSuccess || hipDeviceGetAttribute(&cus, hipDeviceAttributeMultiprocessorCount, dev) != hipSuccess) { grid = -1; return; }
        if (hipFuncSetAttribute((const void*)mega, hipFuncAttributeMaxDynamicSharedMemorySize, LDS_BYTES) != hipSuccess) { fprintf(stderr, "kernel_launch: hipFuncSetAttribute failed\n"); grid = -1; return; }
        if (hipOccupancyMaxActiveBlocksPerMultiprocessor(&per_cu, (const void*)mega, NTHR, LDS_BYTES) != hipSuccess || per_cu < 1) fprintf(stderr, "kernel_launch: occupancy query says %d\n", per_cu);
        (void)hipGetLastError();
        grid = cus;
    }
    if (grid < 0) return;
    (void)hipMemsetAsync((char*)d_ws + WS_CTL, 0, CTL_ZERO_BYTES, stream);
    Args a{};
    for (int i = 0; i < 33; ++i) a.in[i] = (const float*)d_in[i];
    a.out = (float*)d_out; a.ws = (unsigned char*)d_ws;
#if ONE_LAUNCH
    a.ph_lo = 0; a.ph_hi = N_PHASES;
    hipLaunchKernelGGL(mega, dim3(grid), dim3(NTHR), LDS_BYTES, stream, a);
#else
    for (int ph = 0; ph < N_PHASES; ++ph) { if (!phase_exists(ph)) continue; a.ph_lo = ph; a.ph_hi = ph + 1;
        if (ph == PROBE_PH) { a.variant = PROBE_VAR; for (int r = 0; r < PROBE_N; ++r) hipLaunchKernelGGL(mega, dim3(grid), dim3(NTHR), LDS_BYTES, stream, a); }
        a.variant = 0;
        hipLaunchKernelGGL(mega, dim3(grid), dim3(NTHR), LDS_BYTES, stream, a); }
#endif
}
```

```cpp
#include <hip/hip_runtime.h>
#include <cstdio>
#include <cstdint>
#include <cstddef>

#define LAS __attribute__((address_space(3)))
#define GAS __attribute__((address_space(1)))
#define DI __device__ __forceinline__
typedef _Float16 h16;
typedef _Float16 h16x8 __attribute__((ext_vector_type(8)));
typedef _Float16 h16x4 __attribute__((ext_vector_type(4)));
typedef _Float16 h16x2 __attribute__((ext_vector_type(2)));
typedef float f32x4 __attribute__((ext_vector_type(4)));
typedef float f32x2 __attribute__((ext_vector_type(2)));
typedef unsigned u32x4 __attribute__((ext_vector_type(4)));
typedef unsigned u32x2 __attribute__((ext_vector_type(2)));

#ifndef SKIPMASK
#define SKIPMASK 0
#endif
#ifndef PROBE_PH
#define PROBE_PH 11
#endif
#ifndef PROBE_N
#define PROBE_N 4
#endif
#ifndef PROBE_VAR
#define PROBE_VAR 0
#endif
#ifndef ONE_LAUNCH
#define ONE_LAUNCH 1
#endif

constexpr int SEQ = 8192, M = 16384, D = 2048, DFF = 5504, DFF2 = 11008, NWAVES = 8, NTHR = 512;
constexpr float ALPHA = 1.681792830507429f;
constexpr float LN_EPS = 1e-5f;

constexpr size_t MiB = 1u << 20;
constexpr size_t WS_CTL = 0, CTL_ZERO_BYTES = 1 * MiB;
constexpr size_t WS_COS = 1 * MiB, WS_SIN = 5 * MiB;
constexpr size_t WS_PH = 17 * MiB;
constexpr size_t WS_WMIX = 25 * MiB;
constexpr size_t WS_WCOM = 97 * MiB;
constexpr size_t WS_XF = 171 * MiB;
constexpr size_t WS_YF = 299 * MiB;
constexpr size_t WS_XH0 = 427 * MiB, WS_XH1 = 491 * MiB;
constexpr size_t WS_OV = 555 * MiB;
constexpr size_t WS_END = 1376 * MiB;
constexpr size_t W_RETA = 0, W_RETB = 32 * MiB, W_OUT = 56 * MiB;
constexpr size_t W_SWAQKV = 0;
constexpr size_t W_RW1 = 0, W_RW2 = 27 * MiB;
constexpr size_t W_UP = 0, W_DOWN = 43 * MiB, W_PP = 65 * MiB, W_GATE = 66 * MiB;
constexpr size_t OV_Q = 0, OV_K = 64 * MiB, OV_SG = 128 * MiB, OV_KT = 256 * MiB, OV_VT = 320 * MiB, OV_RALL = 448 * MiB;
constexpr size_t OV_QKV = 0, OV_SWAO = 128 * MiB;
constexpr size_t OV_LX = 0  , OV_RKV = 400 * MiB  , OV_MID = 592 * MiB  , OV_WAG = 616 * MiB  ;
constexpr size_t OV_HALO = 0  , OV_PP = 16 * MiB  , OV_ACT = 344 * MiB  ;
static_assert(OV_WAG + 192 * MiB <= WS_END - WS_OV && OV_RALL + 256 * MiB <= WS_END - WS_OV && OV_ACT + 172 * MiB <= WS_END - WS_OV, "overlay");

constexpr int LDS_BYTES = 155648;
constexpr int MISC_OFF = 151552;

DI unsigned pkh(float a, float b) { f32x2 v = {a, b}; h16x2 h = __builtin_convertvector(v, h16x2); return __builtin_bit_cast(unsigned, h); }
DI u32x2 pk4(f32x4 v) { u32x2 r; r.x = pkh(v[0], v[1]); r.y = pkh(v[2], v[3]); return r; }
DI u32x4 pk8(f32x4 a, f32x4 b) { u32x4 r; r.x = pkh(a[0], a[1]); r.y = pkh(a[2], a[3]); r.z = pkh(b[0], b[1]); r.w = pkh(b[2], b[3]); return r; }
DI int lane_id() { unsigned m = ~0u; asm volatile("" : "+s"(m)); int l = (int)__builtin_amdgcn_mbcnt_hi(m, __builtin_amdgcn_mbcnt_lo(m, 0u)); asm volatile("" : "+v"(l)); return l; }
DI float shfl_idx(float v, int src) { return __builtin_bit_cast(float, __builtin_amdgcn_ds_bpermute(src << 2, __builtin_bit_cast(int, v))); }
DI float shfl_xor_(float v, int o, int lane) { return shfl_idx(v, lane ^ o); }
DI float wave_sum(float v, int lane) {
#pragma unroll
    for (int o = 1; o < 64; o <<= 1) v += shfl_xor_(v, o, lane);
    return v;
}
DI float wave_max(float v, int lane) {
#pragma unroll
    for (int o = 1; o < 64; o <<= 1) v = fmaxf(v, shfl_xor_(v, o, lane));
    return v;
}
DI float sigmoidf_(float x) { return __builtin_amdgcn_rcpf(1.0f + __expf(-x)); }
__constant__ float L2GAMMA[8] = {-0.04580368961312479f, -0.02272007650008353f, -0.011315313227834146f, -0.005646563141142063f, -0.0028205190623786626f, -0.0014095702546713536f, -0.0007046129765893727f, -0.0003522634716290214f};
DI float log2gamma(int h) { return L2GAMMA[h]; }
DI f32x4 zero4() { float a, b, c, d; asm volatile("v_mov_b32 %0, 0\n\tv_mov_b32 %1, 0\n\tv_mov_b32 %2, 0\n\tv_mov_b32 %3, 0" : "=v"(a), "=v"(b), "=v"(c), "=v"(d)); return (f32x4){a, b, c, d}; }

namespace pg8 {
constexpr int BM = 256, BK = 64, HALF = 128, HTB = HALF * BK * 2, STAGE_BYTES = 8 * HTB, NXCD = 8, WGM = 8;
__host__ __device__ __forceinline__ int lds_byte(int r, int c) { const int st = (r >> 4) * 2 + (c >> 5), rr = r & 15, cc = c & 31, ob = rr * 64 + cc * 2; return st * 1024 + (ob ^ (((ob >> 9) & 1) << 5)); }
__host__ __device__ __forceinline__ void stage_rc(int b, int& R, int& C) { const int st = b / 1024, sb = b % 1024, swz = sb ^ (((sb >> 9) & 1) << 5); R = (st >> 1) * 16 + swz / 64; C = (st & 1) * 32 + (swz % 64) / 2; }
__host__ __device__ __forceinline__ int perm32(int rho) { const int n = rho >> 4, i = rho & 15; return 8 * (i >> 2) + 4 * n + (i & 3); }
struct Unit { int pm, pn; };
struct Gemm { const h16* A; const h16* Bt; int M, N, K, lda, ldb; };
struct StaticOrder {
    int nM, nN, nwg, G, c;
    __host__ __device__ void init(int M_, int N_, int G_, int c_) { nM = M_ / BM; nN = N_ / BM; nwg = nM * nN; G = G_; c = c_; }
    __host__ __device__ bool next(int i, Unit& u) const {
        const long L = (long)i * G + c; if (L >= nwg) return false;
        int wgid = (int)L; { const int q = nwg / NXCD, r = nwg % NXCD, xcd = wgid % NXCD, off = wgid / NXCD; wgid = (xcd < r ? xcd * (q + 1) : r * (q + 1) + (xcd - r) * q) + off; }
        const int nig = WGM * nN, gid = wgid / nig, fm = gid * WGM, gsz = (nM - fm) < WGM ? (nM - fm) : WGM;
        u.pm = fm + ((wgid % nig) % gsz); u.pn = (wgid % nig) / gsz; return true;
    }
};
template <class Epi, bool ALIGN_EPI = true>
__device__ __forceinline__ void gemm_phase(LAS unsigned char* lds, const Gemm g, const StaticOrder& S, const Epi& E, int wave0) {
    int wid = wave0; asm volatile("" : "+s"(wid));
    const int lane = lane_id();
    const int tid = wid * 64 + lane, wr = wid >> 2, wc = wid & 3, fr = lane & 15, fq = lane >> 4;
    int K = g.K; asm volatile("" : "+s"(K)); const int nt = K / BK;
    unsigned voffA[2], voffB[2];
#pragma unroll
    for (int i = 0; i < 2; ++i) { int R, C; stage_rc(tid * 16 + i * 8192, R, C); const int Rb = Epi::PERM ? ((R & ~31) + perm32(R & 31)) : R;
        const int Ra = Epi::ROWPERM ? ((R & ~63) + 4 * (R & 15) + ((R >> 4) & 3)) : R;
        voffA[i] = (unsigned)(Ra * g.lda + C) * 2u; voffB[i] = (unsigned)(Rb * g.ldb + C) * 2u; }
    const size_t kstep = (size_t)(BK * 2);
    const size_t hstepA = (size_t)HALF * g.lda * 2, hstepB = (size_t)HALF * g.ldb * 2;
    const size_t tstepA = 2 * hstepA, tstepB = 2 * hstepB;
    const unsigned ldsw = (unsigned)wid * 1024u;
    const int aoff = lds_byte(wr * 64 + fr, fq * 8), boff = lds_byte(wc * 32 + fr, fq * 8);
#define PG8_SA(b, h) (((b) * 2 + (h)) * HTB)
#define PG8_SB(b, h) ((4 + (b) * 2 + (h)) * HTB)
#define PG8_STAGE(bufoff, gbase, voff) do { _Pragma("unroll") for (int _i = 0; _i < 2; ++_i) \
        __builtin_amdgcn_global_load_lds((const unsigned*)((const char*)(gbase) + (voff)[_i]), (LAS unsigned*)(lds + (bufoff) + ldsw + _i * 8192), 16, 0, 0); } while (0)
#define PG8_LDA(dst, b, h) do { _Pragma("unroll") for (int m = 0; m < 4; ++m) _Pragma("unroll") for (int k = 0; k < 2; ++k) dst[m][k] = *(const LAS h16x8*)(lds + PG8_SA(b, h) + aoff + m * 2048 + k * 1024); } while (0)
#define PG8_LDB(dst, b, h) do { _Pragma("unroll") for (int n = 0; n < 2; ++n) _Pragma("unroll") for (int k = 0; k < 2; ++k) dst[n][k] = *(const LAS h16x8*)(lds + PG8_SB(b, h) + boff + n * 2048 + k * 1024); } while (0)
#define PG8_MMA(ai, bj, At, Bt) do { __builtin_amdgcn_s_setprio(1); _Pragma("unroll") for (int m = 0; m < 4; ++m) _Pragma("unroll") for (int n = 0; n < 2; ++n) _Pragma("unroll") for (int k = 0; k < 2; ++k) \
        acc[ai][bj][m][n] = __builtin_amdgcn_mfma_f32_16x16x32_f16(Bt[n][k], At[m][k], acc[ai][bj][m][n], 0, 0, 0); __builtin_amdgcn_s_setprio(0); } while (0)
#define PG8_WAIT_V(n) asm volatile("s_waitcnt vmcnt(" #n ")" ::: "memory")
#define PG8_WAIT_L(n) asm volatile("s_waitcnt lgkmcnt(" #n ")" ::: "memory")
#define PG8_BAR __builtin_amdgcn_s_barrier()
#define PG8_SCHED __builtin_amdgcn_sched_barrier(0)
    Unit cur, nxt; int ui = 0;
    if (!S.next(0, cur)) return;
    f32x4 acc[2][2][4][2];
#pragma unroll
    for (int a = 0; a < 2; ++a)
#pragma unroll
        for (int b = 0; b < 2; ++b)
#pragma unroll
            for (int m = 0; m < 4; ++m)
#pragma unroll
                for (int n = 0; n < 2; ++n) acc[a][b][m][n] = zero4();
    h16x8 At[4][2], B0[2][2], B1[2][2];
    const char* cA = (const char*)g.A + E.a_off(cur) + (size_t)cur.pm * tstepA; const char* cB = (const char*)g.Bt + (size_t)cur.pn * tstepB;
    PG8_STAGE(PG8_SB(0, 0), cB, voffB); PG8_STAGE(PG8_SB(0, 1), cB + hstepB, voffB); PG8_STAGE(PG8_SA(0, 0), cA, voffA); PG8_STAGE(PG8_SA(0, 1), cA + hstepA, voffA);
    if (wr == 1) PG8_BAR;
    PG8_WAIT_V(2); PG8_BAR;
    PG8_STAGE(PG8_SB(1, 0), cB + kstep, voffB); PG8_STAGE(PG8_SA(1, 0), cA + kstep, voffA); PG8_STAGE(PG8_SB(1, 1), cB + hstepB + kstep, voffB);
    PG8_WAIT_V(6); PG8_BAR;
    for (;;) {
        const bool has_next = S.next(ui + 1, nxt);
        E.pre(lds, cur, ui, wid);
        const char* nA = has_next ? (const char*)g.A + E.a_off(nxt) + (size_t)nxt.pm * tstepA : cA; const char* nB = has_next ? (const char*)g.Bt + (size_t)nxt.pn * tstepB : cB;
        for (int t = 0; t < nt; t += 2) {
            const bool last = (t == nt - 2);
            const char* a1 = cA + (size_t)(t + 1) * kstep;
            const char* a2 = last ? nA : cA + (size_t)(t + 2) * kstep; const char* b2 = last ? nB : cB + (size_t)(t + 2) * kstep;
            const char* a3 = a2 + kstep; const char* b3 = b2 + kstep;
            PG8_LDB(B0, 0, 0); PG8_LDB(B1, 0, 1); PG8_SCHED; PG8_LDA(At, 0, 0); PG8_STAGE(PG8_SA(1, 1), a1 + hstepA, voffA);
            PG8_WAIT_V(8); PG8_WAIT_L(0); PG8_BAR; PG8_MMA(0, 0, At, B0); PG8_MMA(0, 1, At, B1); PG8_BAR; PG8_SCHED;
            PG8_LDA(At, 0, 1); PG8_STAGE(PG8_SB(0, 0), b2, voffB); PG8_STAGE(PG8_SB(0, 1), b2 + hstepB, voffB); PG8_STAGE(PG8_SA(0, 0), a2, voffA);
            PG8_WAIT_V(8); PG8_WAIT_L(0); PG8_BAR; PG8_MMA(1, 0, At, B0); PG8_MMA(1, 1, At, B1); PG8_BAR; PG8_SCHED;
            PG8_LDB(B0, 1, 0); PG8_LDB(B1, 1, 1); PG8_SCHED; PG8_LDA(At, 1, 0); PG8_STAGE(PG8_SA(0, 1), a2 + hstepA, voffA);
            PG8_WAIT_V(8); PG8_WAIT_L(0); PG8_BAR; PG8_MMA(0, 0, At, B0); PG8_MMA(0, 1, At, B1); PG8_BAR; PG8_SCHED;
            PG8_LDA(At, 1, 1); PG8_STAGE(PG8_SB(1, 0), b3, voffB); PG8_STAGE(PG8_SB(1, 1), b3 + hstepB, voffB); PG8_STAGE(PG8_SA(1, 0), a3, voffA);
            PG8_WAIT_V(8); PG8_WAIT_L(0); PG8_BAR; PG8_MMA(1, 0, At, B0); PG8_MMA(1, 1, At, B1); PG8_BAR; PG8_SCHED;
        }
        if constexpr (ALIGN_EPI) { if (wr == 0) PG8_BAR; }
        { const int l2_ = lane_id(); int fr_ = l2_ & 15, fq_ = l2_ >> 4, wr_ = wr, wc_ = wc; asm volatile("" : "+v"(fr_), "+v"(fq_), "+s"(wr_), "+s"(wc_)); E(acc, cur, ui, wr_, wc_, fr_, fq_); }
        if (!has_next) break;
#pragma unroll
        for (int a = 0; a < 2; ++a)
#pragma unroll
            for (int b = 0; b < 2; ++b)
#pragma unroll
                for (int m = 0; m < 4; ++m)
#pragma unroll
                    for (int n = 0; n < 2; ++n) acc[a][b][m][n] = zero4();
        cur = nxt; cA = nA; cB = nB; ++ui;
        if constexpr (ALIGN_EPI) { if (wr == 1) PG8_BAR; }
    }
    PG8_WAIT_V(0);
    if constexpr (!ALIGN_EPI) { if (wr == 0) PG8_BAR; }
    PG8_BAR;
#undef PG8_SA
#undef PG8_SB
#undef PG8_STAGE
#undef PG8_LDA
#undef PG8_LDB
#undef PG8_MMA
#undef PG8_WAIT_V
#undef PG8_WAIT_L
#undef PG8_BAR
#undef PG8_SCHED
}
}
using pg8::Unit; using pg8::Gemm; using pg8::StaticOrder; using pg8::gemm_phase;
typedef const f32x4 (&AccRef)[2][2][4][2];

struct EpiRes {
    static constexpr bool PERM = true; static constexpr bool ROWPERM = false;
    const h16* res; h16* out;
    DI size_t a_off(const Unit&) const { return 0; }
    DI void pre(LAS unsigned char*, const Unit&, int, int) const {}
    DI void operator()(AccRef acc, const Unit& u, int ui, int wr, int wc, int fr, int fq) const {
        const int row0 = u.pm * 256 + wr * 64 + fr, col0 = u.pn * 256 + wc * 32 + 8 * fq;
        h16x8 r8[2][4][2];
#pragma unroll
        for (int ai = 0; ai < 2; ++ai)
#pragma unroll
            for (int m = 0; m < 4; ++m)
#pragma unroll
                for (int bj = 0; bj < 2; ++bj) r8[ai][m][bj] = *(const h16x8*)(res + (size_t)(row0 + ai * 128 + m * 16) * D + col0 + bj * 128);
#pragma unroll
        for (int ai = 0; ai < 2; ++ai)
#pragma unroll
            for (int m = 0; m < 4; ++m)
#pragma unroll
                for (int bj = 0; bj < 2; ++bj) { f32x4 a, b;
#pragma unroll
                    for (int j = 0; j < 4; ++j) { a[j] = (float)r8[ai][m][bj][j] * ALPHA + acc[ai][bj][m][0][j]; b[j] = (float)r8[ai][m][bj][4 + j] * ALPHA + acc[ai][bj][m][1][j]; }
                    *(u32x4*)(out + (size_t)(row0 + ai * 128 + m * 16) * D + col0 + bj * 128) = pk8(a, b); }
    }
};
struct EpiH16 {
    static constexpr bool PERM = true; static constexpr bool ROWPERM = false;
    h16* O; int ldc; int scale_cols; float scale;
    DI size_t a_off(const Unit&) const { return 0; }
    DI void pre(LAS unsigned char*, const Unit&, int, int) const {}
    DI void operator()(AccRef acc, const Unit& u, int ui, int wr, int wc, int fr, int fq) const {
        const int row0 = u.pm * 256 + wr * 64 + fr, col0 = u.pn * 256 + wc * 32 + 8 * fq;
        const float s = (u.pn * 256 < scale_cols) ? scale : 1.0f;
#pragma unroll
        for (int ai = 0; ai < 2; ++ai)
#pragma unroll
            for (int m = 0; m < 4; ++m) { h16* rowp = O + (size_t)(row0 + ai * 128 + m * 16) * ldc + col0;
#pragma unroll
                for (int bj = 0; bj < 2; ++bj) *(u32x4*)(rowp + bj * 128) = pk8(acc[ai][bj][m][0] * s, acc[ai][bj][m][1] * s); }
    }
};
struct EpiRetA {
    static constexpr bool PERM = true; static constexpr bool ROWPERM = false;
    h16 *Q, *Kb, *SG; const float *cosT, *sinT; h16* KT;
    DI size_t a_off(const Unit&) const { return 0; }
    DI void pre(LAS unsigned char*, const Unit&, int, int) const {}
    DI void operator()(AccRef acc, const Unit& u, int ui, int wr, int wc, int fr, int fq) const {
        const int row0 = u.pm * 256 + wr * 64 + fr, cb = wc * 32 + 8 * fq;
        if (u.pn < 16) {
            h16* dst = (u.pn < 8 ? Q : Kb) + (u.pn & 7) * 256 + cb; const float sc = u.pn < 8 ? 1.0f : 0.0625f;
#pragma unroll
            for (int ai = 0; ai < 2; ++ai) {
                f32x4 tc0[4], tc1[4], ts0[4], ts1[4];
#pragma unroll
                for (int m = 0; m < 4; ++m) { const int pos = (row0 + ai * 128 + m * 16) & (SEQ - 1);
                    tc0[m] = *(const f32x4*)(cosT + pos * 128 + cb); tc1[m] = *(const f32x4*)(cosT + pos * 128 + cb + 4); ts0[m] = *(const f32x4*)(sinT + pos * 128 + cb); ts1[m] = *(const f32x4*)(sinT + pos * 128 + cb + 4); }
#pragma unroll
                for (int m = 0; m < 4; ++m) { const int row = row0 + ai * 128 + m * 16, pos = row & (SEQ - 1);
                    const f32x4 c0 = tc0[m], c1 = tc1[m], s0 = ts0[m], s1 = ts1[m];
                    const f32x4 x1a = acc[ai][0][m][0], x1b = acc[ai][0][m][1], x2a = acc[ai][1][m][0], x2b = acc[ai][1][m][1];
                    const f32x4 o1a = (x1a * c0 - x2a * s0) * sc, o1b = (x1b * c1 - x2b * s1) * sc, o2a = (x1a * s0 + x2a * c0) * sc, o2b = (x1b * s1 + x2b * c1) * sc;
                    *(u32x4*)(dst + (size_t)row * D) = pk8(o1a, o1b);
                    *(u32x4*)(dst + (size_t)row * D + 128) = pk8(o2a, o2b);
                    if (u.pn >= 8) {
                        const float f = __builtin_amdgcn_exp2f((float)(127 - (pos & 127)) * log2gamma(u.pn & 7));
                        h16* kt = KT + (size_t)((u.pn & 7) * 256 + cb) * M + row;
#pragma unroll
                        for (int j = 0; j < 4; ++j) { kt[(size_t)j * M] = (h16)(o1a[j] * f); kt[(size_t)(4 + j) * M] = (h16)(o1b[j] * f); kt[(size_t)(128 + j) * M] = (h16)(o2a[j] * f); kt[(size_t)(132 + j) * M] = (h16)(o2b[j] * f); }
                    } }
            }
        } else {
            h16* dst = SG + (u.pn - 16) * 256 + cb;
#pragma unroll
            for (int ai = 0; ai < 2; ++ai)
#pragma unroll
                for (int m = 0; m < 4; ++m) { const int row = row0 + ai * 128 + m * 16;
#pragma unroll
                    for (int bj = 0; bj < 2; ++bj) { f32x4 a = acc[ai][bj][m][0], b = acc[ai][bj][m][1];
#pragma unroll
                        for (int j = 0; j < 4; ++j) { a[j] = a[j] * sigmoidf_(a[j]); b[j] = b[j] * sigmoidf_(b[j]); }
                        *(u32x4*)(dst + (size_t)row * 4096 + bj * 128) = pk8(a, b); } }
        }
    }
};
struct EpiRetB {
    static constexpr bool PERM = true; static constexpr bool ROWPERM = false;
    h16* VT;
    DI size_t a_off(const Unit&) const { return 0; }
    DI void pre(LAS unsigned char*, const Unit&, int, int) const {}
    DI void operator()(AccRef acc, const Unit& u, int ui, int wr, int wc, int fr, int fq) const {
        const int tokb = u.pn * 256 + wc * 32 + 8 * fq;
#pragma unroll
        for (int ai = 0; ai < 2; ++ai)
#pragma unroll
            for (int m = 0; m < 4; ++m) { const int f = u.pm * 256 + ai * 128 + wr * 64 + m * 16 + fr;
#pragma unroll
                for (int bj = 0; bj < 2; ++bj) *(u32x4*)(VT + (size_t)f * M + tokb + bj * 128) = pk8(acc[ai][bj][m][0], acc[ai][bj][m][1]); }
    }
};
struct EpiRw1 {
    static constexpr bool PERM = true; static constexpr bool ROWPERM = false;
    h16 *RKV, *MID;
    DI size_t a_off(const Unit& u) const { return (size_t)(u.pn < 24 ? u.pn >> 3 : u.pn - 21) * ((size_t)M * D * 2); }
    DI void pre(LAS unsigned char*, const Unit&, int, int) const {}
    DI void operator()(AccRef acc, const Unit& u, int ui, int wr, int wc, int fr, int fq) const {
        const int row0 = u.pm * 256 + wr * 64 + fr, cb = wc * 32 + 8 * fq;
        if (u.pn < 24) {
            h16* dst = RKV + (size_t)(u.pn >> 3) * ((size_t)M * D) + (u.pn & 7) * 256 + cb;
#pragma unroll
            for (int ai = 0; ai < 2; ++ai)
#pragma unroll
                for (int m = 0; m < 4; ++m)
#pragma unroll
                    for (int bj = 0; bj < 2; ++bj) *(u32x4*)(dst + (size_t)(row0 + ai * 128 + m * 16) * D + bj * 128) = pk8(acc[ai][bj][m][0], acc[ai][bj][m][1]);
        } else {
            const int t = u.pn - 24; h16* dst = MID + (size_t)t * ((size_t)M * 256) + cb;
#pragma unroll
            for (int ai = 0; ai < 2; ++ai)
#pragma unroll
                for (int m = 0; m < 4; ++m)
#pragma unroll
                    for (int bj = 0; bj < 2; ++bj) { f32x4 a = acc[ai][bj][m][0], b = acc[ai][bj][m][1];
#pragma unroll
                        for (int j = 0; j < 4; ++j) { if (t == 0) { a[j] = 1.0f - 2.0f * __builtin_amdgcn_rcpf(1.0f + __expf(2.0f * a[j])); b[j] = 1.0f - 2.0f * __builtin_amdgcn_rcpf(1.0f + __expf(2.0f * b[j])); }     else if (t == 2) { a[j] = sigmoidf_(a[j]); b[j] = sigmoidf_(b[j]); } }
                        *(u32x4*)(dst + (size_t)(row0 + ai * 128 + m * 16) * 256 + bj * 128) = pk8(a, b); }
        }
    }
};
DI float decay_of(float z) { return __expf(-0.6065306597126334f * sigmoidf_(z)); }
struct EpiRw2 {
    static constexpr bool PERM = true; static constexpr bool ROWPERM = false;
    h16* WAG; const float *w0, *a0;
    DI size_t a_off(const Unit& u) const { return (size_t)(u.pn >> 3) * ((size_t)M * 256 * 2); }
    DI void pre(LAS unsigned char*, const Unit&, int, int) const {}
    template <int T> DI void body(AccRef acc, h16* dst, const float* bias, int row0) const {
#pragma unroll
        for (int bj = 0; bj < 2; ++bj) { f32x4 ba, bb;
            if (T != 2) { ba = *(const f32x4*)(bias + bj * 128); bb = *(const f32x4*)(bias + bj * 128 + 4); }
#pragma unroll
            for (int ai = 0; ai < 2; ++ai)
#pragma unroll
                for (int m = 0; m < 4; ++m) { f32x4 a = acc[ai][bj][m][0], b = acc[ai][bj][m][1]; if (T != 2) { a = a + ba; b = b + bb; }
#pragma unroll
                    for (int j = 0; j < 4; ++j) { if (T == 0) { a[j] = decay_of(a[j]); b[j] = decay_of(b[j]); } else if (T == 1) { a[j] = sigmoidf_(a[j]); b[j] = sigmoidf_(b[j]); } }
                    *(u32x4*)(dst + (size_t)(row0 + ai * 128 + m * 16) * D + bj * 128) = pk8(a, b); } }
    }
    DI void operator()(AccRef acc, const Unit& u, int ui, int wr, int wc, int fr, int fq) const {
        const int row0 = u.pm * 256 + wr * 64 + fr, t = u.pn >> 3, colb = (u.pn & 7) * 256 + wc * 32 + 8 * fq;
        h16* dst = WAG + (size_t)t * ((size_t)M * D) + colb;
        if (t == 0) body<0>(acc, dst, w0 + colb, row0);
        else if (t == 1) body<1>(acc, dst, a0 + colb, row0);
        else body<2>(acc, dst, w0, row0);
    }
};
struct EpiPle {
    static constexpr bool PERM = true; static constexpr bool ROWPERM = false;
    const h16* x2; const h16* pp; float* outf; h16* xh;
    DI size_t a_off(const Unit&) const { return 0; }
    DI void pre(LAS unsigned char*, const Unit&, int, int) const {}
    DI void operator()(AccRef acc, const Unit& u, int ui, int wr, int wc, int fr, int fq) const {
        const int row0 = u.pm * 256 + wr * 64 + fr, col0 = u.pn * 256 + wc * 32 + 8 * fq;
#pragma unroll
        for (int ai = 0; ai < 2; ++ai) {
            h16x8 x8[4][2], p8[4][2];
#pragma unroll
            for (int m = 0; m < 4; ++m)
#pragma unroll
                for (int bj = 0; bj < 2; ++bj) { const size_t o = (size_t)(row0 + ai * 128 + m * 16) * D + col0 + bj * 128; x8[m][bj] = *(const h16x8*)(x2 + o); p8[m][bj] = *(const h16x8*)(pp + o); }
#pragma unroll
            for (int m = 0; m < 4; ++m)
#pragma unroll
                for (int bj = 0; bj < 2; ++bj) { const size_t o = (size_t)(row0 + ai * 128 + m * 16) * D + col0 + bj * 128; f32x4 a, b;
#pragma unroll
                    for (int j = 0; j < 4; ++j) { a[j] = (float)x8[m][bj][j] + (float)p8[m][bj][j] * sigmoidf_(acc[ai][bj][m][0][j]); b[j] = (float)x8[m][bj][4 + j] + (float)p8[m][bj][4 + j] * sigmoidf_(acc[ai][bj][m][1][j]); }
                    if (xh) *(u32x4*)(xh + o) = pk8(a, b); else { *(f32x4*)(outf + o) = a; *(f32x4*)(outf + o + 4) = b; } }
        }
    }
};
DI float row_shr1f(float old, float x) { return __builtin_bit_cast(float, __builtin_amdgcn_update_dpp(__builtin_bit_cast(int, old), __builtin_bit_cast(int, x), 0x111, 0xF, 0xF, false)); }
DI f32x4 row_shr1(f32x4 old, f32x4 v) {
    const float o0 = old[0], o1 = old[1], o2 = old[2], o3 = old[3], a0 = v[0], a1 = v[1], a2 = v[2], a3 = v[3];
    return (f32x4){row_shr1f(o0, a0), row_shr1f(o1, a1), row_shr1f(o2, a2), row_shr1f(o3, a3)}; }
constexpr int EU_WOFF = 139264;
template <bool TRIV> struct EpiUpT {
    static constexpr bool PERM = true; static constexpr bool ROWPERM = true;
    h16* ACT; float* HL; const float* cw; const float* cb; LAS float* hl;
    DI size_t a_off(const Unit&) const { return 0; }
    DI void pre(LAS unsigned char* lds, const Unit& u, int ui, int wid) const {
        if (wid < 4) { const int lane = lane_id(); const float* src = (wid < 3 ? cw + (size_t)wid * DFF2 : cb) + u.pn * 128 + (lane < 32 ? lane * 4 : DFF + (lane - 32) * 4);
            __builtin_amdgcn_global_load_lds((const unsigned*)src, (LAS unsigned*)(lds + EU_WOFF + (ui & 1) * 4096 + wid * 1024), 16, 0, 0); }
    }
    DI void operator()(AccRef acc, const Unit& u, int ui, int wr, int wc, int fr, int fq) const {
        const int cbase = wc * 32 + 8 * fq;
        if constexpr (TRIV) {
#pragma unroll
            for (int n = 0; n < 2; ++n) { const int cu = u.pn * 128 + cbase + 4 * n;
#pragma unroll
                for (int ai = 0; ai < 2; ++ai)
#pragma unroll
                    for (int m = 0; m < 4; ++m) *(u32x2*)(ACT + (size_t)(u.pm * 256 + ai * 128 + wr * 64 + m * 16 + fr) * DFF + cu) = pk4(acc[ai][0][m][n] * acc[ai][1][m][n]); }
            return;
        }
        if (fr == 15) {
#pragma unroll
            for (int ai = 0; ai < 2; ++ai)
#pragma unroll
                for (int bj = 0; bj < 2; ++bj)
#pragma unroll
                    for (int n = 0; n < 2; ++n) { LAS float* hp = hl + ((2 * ai + wr) * 2) * 256 + bj * 128 + cbase + 4 * n; *(LAS f32x4*)hp = acc[ai][bj][2][n]; *(LAS f32x4*)(hp + 256) = acc[ai][bj][3][n]; }
            if (wr == 1) {
#pragma unroll
                for (int bj = 0; bj < 2; ++bj)
#pragma unroll
                    for (int n = 0; n < 2; ++n) { float* gp = HL + (size_t)(u.pm * 4) * DFF2 + u.pn * 256 + bj * 128 + cbase + 4 * n; *(f32x4*)gp = acc[1][bj][2][n]; *(f32x4*)(gp + DFF2) = acc[1][bj][3][n]; }
            }
        }
        if (fr == 0 && wr == 0) {
#pragma unroll
            for (int bj = 0; bj < 2; ++bj)
#pragma unroll
                for (int n = 0; n < 2; ++n) { float* gp = HL + (size_t)(u.pm * 4 + 2) * DFF2 + u.pn * 256 + bj * 128 + cbase + 4 * n; *(f32x4*)gp = acc[0][bj][0][n]; *(f32x4*)(gp + DFF2) = acc[0][bj][1][n]; }
        }
        asm volatile("s_waitcnt lgkmcnt(0)" ::: "memory"); __builtin_amdgcn_s_barrier(); asm volatile("" ::: "memory");
        const LAS unsigned char* lds_ = (const LAS unsigned char*)hl - 131072;
#pragma unroll
        for (int ai = 0; ai < 2; ++ai) {
            const int blk = 2 * ai + wr;
            h16* arow = ACT + (size_t)(u.pm * 256 + ai * 128 + wr * 64 + 4 * fr) * DFF + u.pn * 128 + cbase;
            u32x2 P0[4];
#pragma unroll
            for (int n = 0; n < 2; ++n) {
                const LAS float* wl = (const LAS float*)(lds_ + EU_WOFF + (ui & 1) * 4096) + cbase + 4 * n;
                const LAS float* hp = hl + ((blk - 1) * 2) * 256 + cbase + 4 * n;
                f32x4 hu[4];
                {   const f32x4 w0 = *(const LAS f32x4*)wl, w1 = *(const LAS f32x4*)(wl + 256), w2 = *(const LAS f32x4*)(wl + 512), bb = *(const LAS f32x4*)(wl + 768);
                    f32x4 H1 = zero4(), H2 = zero4();
                    if (blk > 0) { H2 = *(const LAS f32x4*)hp; H1 = *(const LAS f32x4*)(hp + 256); }
                    const f32x4 c0 = acc[ai][0][0][n], c1 = acc[ai][0][1][n], c2 = acc[ai][0][2][n], c3 = acc[ai][0][3][n];
                    const f32x4 S3 = row_shr1(H1, c3), S2 = row_shr1(H2, c2);
                    hu[0] = bb + w2 * c0 + w1 * S3 + w0 * S2; hu[1] = bb + w2 * c1 + w1 * c0 + w0 * S3; hu[2] = bb + w2 * c2 + w1 * c1 + w0 * c0; hu[3] = bb + w2 * c3 + w1 * c2 + w0 * c1; }
                {   const f32x4 w0 = *(const LAS f32x4*)(wl + 128), w1 = *(const LAS f32x4*)(wl + 384), w2 = *(const LAS f32x4*)(wl + 640), bb = *(const LAS f32x4*)(wl + 896);
                    f32x4 H1 = zero4(), H2 = zero4();
                    if (blk > 0) { H2 = *(const LAS f32x4*)(hp + 128); H1 = *(const LAS f32x4*)(hp + 256 + 128); }
                    const f32x4 c0 = acc[ai][1][0][n], c1 = acc[ai][1][1][n], c2 = acc[ai][1][2][n], c3 = acc[ai][1][3][n];
                    const f32x4 S3 = row_shr1(H1, c3), S2 = row_shr1(H2, c2);
                    f32x4 hg[4];
                    hg[0] = bb + w2 * c0 + w1 * S3 + w0 * S2; hg[1] = bb + w2 * c1 + w1 * c0 + w0 * S3; hg[2] = bb + w2 * c2 + w1 * c1 + w0 * c0; hg[3] = bb + w2 * c3 + w1 * c2 + w0 * c1;
#pragma unroll
                    for (int m = 0; m < 4; ++m) { f32x4 o;
#pragma unroll
                        for (int j = 0; j < 4; ++j) o[j] = hg[m][j] * sigmoidf_(hg[m][j]) * hu[m][j];
                        const u32x2 pk_ = pk4(o); if (n == 0) P0[m] = pk_; else *(u32x4*)(arow + (size_t)m * DFF) = (u32x4){P0[m].x, P0[m].y, pk_.x, pk_.y}; } }
            }
        }
    }
};
using EpiUp = EpiUpT<false>;
DI void ffn_fixup(const float* HL, const float* cw, const float* cb, h16* ACT, int gtid, int NT) {
    for (int i = gtid; i < 64 * 2 * (DFF / 4); i += NT) { const int q = i % (DFF / 4), r = (i / (DFF / 4)) & 1, pm = i / (2 * (DFF / 4));
        if ((pm & 31) == 0) continue;
        const int c = 4 * q, hc = 256 * (c >> 7) + (c & 127);
        const float* cur = HL + (size_t)(pm * 4 + 2 + r) * DFF2 + hc; const float* m1 = r ? HL + (size_t)(pm * 4 + 2) * DFF2 + hc : HL + (size_t)((pm - 1) * 4 + 1) * DFF2 + hc;
        const float* m2 = r ? HL + (size_t)((pm - 1) * 4 + 1) * DFF2 + hc : HL + (size_t)((pm - 1) * 4) * DFF2 + hc;
        const f32x4 hu = *(const f32x4*)(cb + c) + *(const f32x4*)(cw + 2 * DFF2 + c) * *(const f32x4*)cur + *(const f32x4*)(cw + DFF2 + c) * *(const f32x4*)m1 + *(const f32x4*)(cw + c) * *(const f32x4*)m2;
        const int g = DFF + c;
        const f32x4 hg = *(const f32x4*)(cb + g) + *(const f32x4*)(cw + 2 * DFF2 + g) * *(const f32x4*)(cur + 128) + *(const f32x4*)(cw + DFF2 + g) * *(const f32x4*)(m1 + 128) + *(const f32x4*)(cw + g) * *(const f32x4*)(m2 + 128);
        f32x4 o;
#pragma unroll
        for (int j = 0; j < 4; ++j) o[j] = hg[j] * sigmoidf_(hg[j]) * hu[j];
        *(u32x2*)(ACT + (size_t)(pm * 256 + r) * DFF + c) = pk4(o); }
}

#define XB_TMO      128
#define XB_XCNT(j)  (256  + 64 * (j))
#define XB_XSUB(j)  (1280 + 64 * (j))
#define XB_XGEN(j)  (2304 + 64 * (j))
#define XB_TOP      3328
#define XB_TOPGEN   3392
#define XCD_BAR_WORDS 3456
#define XB_SPIN_CAP (1u << 18)
__device__ __forceinline__ unsigned xb_ld(unsigned* p)              { return __hip_atomic_load(p, __ATOMIC_RELAXED, __HIP_MEMORY_SCOPE_AGENT); }
__device__ __forceinline__ unsigned xb_add(unsigned* p, unsigned v) { return __hip_atomic_fetch_add(p, v, __ATOMIC_RELAXED, __HIP_MEMORY_SCOPE_AGENT); }
__device__ __forceinline__ unsigned xb_xcc_id() { return (unsigned)__builtin_amdgcn_s_getreg((3 << 11) | 20) & 0xFu; }
#define XB_SPIN(cond, bar) do { unsigned _sp = 0; while (cond) { __builtin_amdgcn_s_sleep(1); \
    if ((++_sp & 255u) == 0u) { if (xb_ld(&(bar)[XB_TMO])) break; if (_sp > XB_SPIN_CAP) { atomicAdd(&(bar)[XB_TMO], 1u); break; } } } } while (0)
struct XcdBarrier { unsigned* bar; unsigned x; volatile LAS unsigned* st; };
__device__ __forceinline__ XcdBarrier xcd_barrier_post(unsigned* bar, volatile LAS unsigned* st) {
    XcdBarrier b; b.bar = bar; b.x = xb_xcc_id(); b.st = st;
    if (threadIdx.x == 0) (void)xb_add(&bar[XB_XCNT(b.x)], 1u);
    return b;
}
__device__ __forceinline__ void xcd_barrier_complete(unsigned* bar, unsigned x, unsigned& nloc, unsigned& nx) {
    const unsigned G = gridDim.x * gridDim.y * gridDim.z;
    unsigned sum, cnt, mine, sp = 0u;
    for (;;) {
        sum = 0u; cnt = 0u; mine = 0u;
#pragma unroll
        for (unsigned j = 0; j < 16; ++j) { const unsigned c = xb_ld(&bar[XB_XCNT(j)]); sum += c; cnt += (c > 0u) ? 1u : 0u; mine = (j == x) ? c : mine; }
        if (sum == G) break;
        __builtin_amdgcn_s_sleep(1);
        if ((++sp & 255u) == 0u) { if (xb_ld(&bar[XB_TMO])) break; if (sp > XB_SPIN_CAP) { atomicAdd(&bar[XB_TMO], 1u); break; } }
    }
    nloc = mine > 0u ? mine : 1u; nx = cnt > 0u ? cnt : 1u;
}
__device__ __forceinline__ void xcd_barrier(const XcdBarrier& b, int wave0) {
    asm volatile("s_waitcnt vmcnt(0)" ::: "memory");
    __syncthreads();
    if (wave0 == 0 && lane_id() == 0) {
        unsigned* bar = b.bar;
        __builtin_amdgcn_s_waitcnt(0);
        unsigned nloc = b.st[0], nx = b.st[1];
        if (nloc == 0u) { xcd_barrier_complete(bar, b.x, nloc, nx); b.st[0] = nloc; b.st[1] = nx; }
        const unsigned old = xb_add(&bar[XB_XSUB(b.x)], 1u);
        const unsigned gen = old / nloc;
        if (old + 1u == (gen + 1u) * nloc) {
            __builtin_amdgcn_fence(__ATOMIC_RELEASE, "agent");
            asm volatile("s_waitcnt vmcnt(0)" ::: "memory");
            const unsigned og = xb_add(&bar[XB_TOP], 1u);
            const unsigned tg = og / nx;
            if (og + 1u == (tg + 1u) * nx) xb_add(&bar[XB_TOPGEN], 1u);
            else XB_SPIN(xb_ld(&bar[XB_TOPGEN]) == tg, bar);
            __builtin_amdgcn_fence(__ATOMIC_ACQUIRE, "agent");
            xb_add(&bar[XB_XGEN(b.x)], 1u);
            asm volatile("s_waitcnt vmcnt(0)" ::: "memory");
        } else {
            XB_SPIN(xb_ld(&bar[XB_XGEN(b.x)]) == gen, bar);
            __builtin_amdgcn_fence(__ATOMIC_ACQUIRE, "agent");
            asm volatile("s_waitcnt vmcnt(0)" ::: "memory");
        }
    }
    __syncthreads();
}

__constant__ unsigned char T5_BUCKET[128] = {0, 1, 2, 3, 4, 5, 6, 7, 8, 9, 10, 11, 12, 13, 14, 15, 16, 16, 16, 17, 17, 18, 18, 18, 19, 19, 19, 20, 20, 20, 20, 21, 21, 21, 21, 22, 22, 22, 22, 22, 23, 23, 23, 23, 23, 23, 24, 24, 24, 24, 24, 24, 25, 25, 25, 25, 25, 25, 25, 26, 26, 26, 26, 26, 26, 26, 26, 27, 27, 27, 27, 27, 27, 27, 27, 27, 27, 28, 28, 28, 28, 28, 28, 28, 28, 28, 28, 29, 29, 29, 29, 29, 29, 29, 29, 29, 29, 29, 29, 30, 30, 30, 30, 30, 30, 30, 30, 30, 30, 30, 30, 30, 30, 31, 31, 31, 31, 31, 31, 31, 31, 31, 31, 31, 31, 31, 31, 31};

template <bool UPMAP = false>
DI void cvt_job(const float* W, int ldw, int K, int ncols, int col0, h16* WT, int ldt, int row0, LAS float* scr, int gw, int NGW, int lane) {
    const int nblk = ncols / 32, nitems = (K / 64) * nblk;
    for (int item = gw; item < nitems; item += NGW) {
        const int kb = item / nblk, nb = item % nblk, k0 = 64 * kb, n0 = 32 * nb;
        const int ns = UPMAP ? 32 * (((nb & 7) < 4) ? (nb >> 3) * 4 + (nb & 7) : 172 + (nb >> 3) * 4 + (nb & 7) - 4) : n0;
#pragma unroll 8
        for (int i = 0; i < 32; ++i) { const int kk = 2 * i + (lane >> 5); scr[kk * 33 + (lane & 31)] = W[(size_t)(k0 + kk) * ldw + col0 + ns + (lane & 31)]; }
        asm volatile("s_waitcnt lgkmcnt(0)" ::: "memory");
        const int c = lane & 7;
#pragma unroll
        for (int j = 0; j < 4; ++j) { const int n = (lane >> 3) + 8 * j; const LAS float* s = scr + (8 * c) * 33 + n;
            u32x4 o; o.x = pkh(s[0 * 33], s[1 * 33]); o.y = pkh(s[2 * 33], s[3 * 33]); o.z = pkh(s[4 * 33], s[5 * 33]); o.w = pkh(s[6 * 33], s[7 * 33]);
            *(u32x4*)(WT + (size_t)(row0 + n0 + n) * ldt + k0 + 8 * c) = o; }
        asm volatile("s_waitcnt lgkmcnt(0)" ::: "memory");
    }
}
DI void cvt_small(const float* W, int ldw, int Ksrc, int nrows, h16* WT, int ldt, int row0, int gtid, int NT) {
    for (int i = gtid; i < nrows * ldt; i += NT) { const int n = i / ldt, k = i % ldt; WT[(size_t)(row0 + n) * ldt + k] = (h16)(k < Ksrc ? W[(size_t)k * ldw + n] : 0.f); }
}
DI void zero_rows(h16* WT, int ldt, int row0, int nrows, int gtid, int NT) {
    for (int i = gtid; i < nrows * ldt / 8; i += NT) *(u32x4*)(WT + (size_t)row0 * ldt + (size_t)i * 8) = __builtin_bit_cast(u32x4, zero4());
}
DI void cvt_flat(const float* src, h16* dst, size_t n, int gtid, int NT) {
    for (size_t i = (size_t)gtid * 8; i < n; i += (size_t)NT * 8) { const f32x4 a = *(const f32x4*)(src + i), b = *(const f32x4*)(src + i + 4); *(u32x4*)(dst + i) = pk8(a, b); }
}
DI float dpp_rowsum16(float v) {
    v += __builtin_bit_cast(float, __builtin_amdgcn_update_dpp(0, __builtin_bit_cast(int, v), 0xB1, 0xF, 0xF, false));
    v += __builtin_bit_cast(float, __builtin_amdgcn_update_dpp(0, __builtin_bit_cast(int, v), 0x4E, 0xF, 0xF, false));
    v += __builtin_bit_cast(float, __builtin_amdgcn_update_dpp(0, __builtin_bit_cast(int, v), 0x141, 0xF, 0xF, false));
    v += __builtin_bit_cast(float, __builtin_amdgcn_update_dpp(0, __builtin_bit_cast(int, v), 0x140, 0xF, 0xF, false));
    return v;
}
DI float wave_sum_dpp(float v) { v = dpp_rowsum16(v); const int b = __builtin_bit_cast(int, v);
    return (__builtin_bit_cast(float, __builtin_amdgcn_readlane(b, 0)) + __builtin_bit_cast(float, __builtin_amdgcn_readlane(b, 16))) + (__builtin_bit_cast(float, __builtin_amdgcn_readlane(b, 32)) + __builtin_bit_cast(float, __builtin_amdgcn_readlane(b, 48))); }
DI void ln_rows(const h16* src, const float* gain, const float* bias, h16* dsth, int gw, int NGW, int lane) {
    for (int m0 = 2 * gw; m0 < M; m0 += 2 * NGW) {
        h16x8 raw[2][4];
#pragma unroll
        for (int r = 0; r < 2; ++r) { const h16x8* xr = (const h16x8*)(src + (size_t)(m0 + r) * D) + lane;
#pragma unroll
            for (int j = 0; j < 4; ++j) raw[r][j] = xr[64 * j]; }
#pragma unroll
        for (int r = 0; r < 2; ++r) { float v[4][8]; float sm = 0.f;
#pragma unroll
            for (int j = 0; j < 4; ++j)
#pragma unroll
                for (int e = 0; e < 8; ++e) { v[j][e] = (float)raw[r][j][e]; sm += v[j][e]; }
            const float mean = wave_sum_dpp(sm) * (1.f / D); float s2 = 0.f;
#pragma unroll
            for (int j = 0; j < 4; ++j)
#pragma unroll
                for (int e = 0; e < 8; ++e) { v[j][e] -= mean; s2 += v[j][e] * v[j][e]; }
            const float rstd = 1.0f / sqrtf(wave_sum_dpp(s2) * (1.f / D) + LN_EPS);
#pragma unroll
            for (int j = 0; j < 4; ++j) { const int c = 8 * lane + 512 * j; const f32x4 g0 = *(const f32x4*)(gain + c), g1 = *(const f32x4*)(gain + c + 4), b0 = *(const f32x4*)(bias + c), b1 = *(const f32x4*)(bias + c + 4); f32x4 o0, o1;
#pragma unroll
                for (int e = 0; e < 4; ++e) { o0[e] = v[j][e] * rstd * g0[e] + b0[e]; o1[e] = v[j][4 + e] * rstd * g1[e] + b1[e]; }
                *(u32x4*)(dsth + (size_t)(m0 + r) * D + c) = pk8(o0, o1); }
        }
    }
}

constexpr int RS_SLOT = 24576, RS_NS = 6, RS_D = 5;
DI void ret_scan(LAS unsigned char* lds, const h16* KT, const h16* VT, h16* RALL, int bid, int G, int wave, int lane) {
    for (int task = bid; task < 256; task += G) {
        const int bh = (task & 7) * 2 + (task >> 7), sub = (task >> 3) & 15, dkh = sub >> 3, dve = sub & 7, h = bh & 7, b = bh >> 3, r16 = lane & 15, q4 = lane >> 4;
        const float cd = __builtin_amdgcn_exp2f(128.0f * log2gamma(h));
        const int lrow = lane >> 3, lpc = lane & 7;
        __syncthreads();
#define RS_ISSUE(st_) do { const int step_ = (st_), slot_ = step_ % RS_NS; _Pragma("unroll") for (int ii_ = 0; ii_ < 3; ++ii_) { const int row = 8 * (3 * wave + ii_) + lrow, c = lpc ^ ((row >> 1) & 7); \
            const h16* g_ = (row < 128 ? KT + (size_t)(h * 256 + dkh * 128 + row) * M : VT + (size_t)(h * 512 + dve * 64 + (row - 128)) * M) + (size_t)b * SEQ + step_ * 64 + c * 8; \
            __builtin_amdgcn_global_load_lds((const unsigned*)g_, (LAS unsigned*)(lds + slot_ * RS_SLOT + (3 * wave + ii_) * 1024), 16, 0, 0); } } while (0)
        for (int i = 0; i < RS_D; ++i) RS_ISSUE(i);
        f32x4 acc[4];
#pragma unroll
        for (int c = 0; c < 4; ++c) acc[c] = zero4();
        for (int st = 0; st < 128; ++st) {
            asm volatile("s_waitcnt vmcnt(12)" ::: "memory");
            asm volatile("" ::: "memory"); __builtin_amdgcn_s_barrier(); asm volatile("" ::: "memory");
            RS_ISSUE(st + RS_D < 128 ? st + RS_D : 127);
            if ((st & 1) == 0) { h16* rdst = RALL + (((size_t)bh * 64 + (st >> 1)) * 512 + dve * 64) * 256 + dkh * 128 + wave * 16 + q4 * 4;
#pragma unroll
                for (int nt = 0; nt < 4; ++nt) { *(u32x2*)(rdst + (size_t)(nt * 16 + r16) * 256) = pk4(acc[nt]); acc[nt] = acc[nt] * cd; } }
            const LAS unsigned char* sl = lds + (st % RS_NS) * RS_SLOT;
#pragma unroll
            for (int ks = 0; ks < 2; ++ks) { const int ra = wave * 16 + r16, c = ks * 4 + q4;
                const h16x8 af = *(const LAS h16x8*)(sl + ra * 128 + ((c ^ ((ra >> 1) & 7)) << 4));
#pragma unroll
                for (int nt = 0; nt < 4; ++nt) { const int rb = 128 + nt * 16 + r16; const h16x8 bf = *(const LAS h16x8*)(sl + rb * 128 + ((c ^ ((rb >> 1) & 7)) << 4));
                    acc[nt] = __builtin_amdgcn_mfma_f32_16x16x32_f16(af, bf, acc[nt], 0, 0, 0); } }
        }
        asm volatile("s_waitcnt vmcnt(0)" ::: "memory");
#undef RS_ISSUE
    }
}

constexpr int R2_QP = 528, R2_PP = 272, R2_REG2 = 67584, R2_BCS = 16384, R2_NS = 5, R2_D = 4;
DI void ret_core(LAS unsigned char* lds, const h16* Qg, const h16* Kg, const h16* VT, const h16* RALL, const h16* SG, h16* OG, const float* gn, int bid, int G, int tid, int wave, int  ) {
    LAS float* ST1 = (LAS float*)(lds + R2_REG2); LAS float* ST2 = ST1 + 512;
    for (int unit = bid; unit < 1024; unit += G) {
        int fr, fq, wr, wc;
#define R2_FRESH do { asm volatile("" : "+v"(tid), "+s"(wave)); fr = tid & 15; fq = (tid >> 4) & 3; wr = wave >> 2; wc = wave & 3; } while (0)
        R2_FRESH;
        const int bh = unit >> 6, n = unit & 63, b = bh >> 3, h = bh & 7, tok0 = b * SEQ + n * 128;
        const float l2g = log2gamma(h);
        const h16* rsrc = RALL + ((size_t)bh * 64 + n) * 512 * 256;
#define R2_ISSUE(st_) do { const int step_ = (st_); _Pragma("unroll") for (int ii_ = 0; ii_ < 2; ++ii_) { const int row_ = 16 * (2 * wave + ii_) + ((tid & 63) >> 2), pc_ = (tid & 3) ^ ((row_ >> 2) & 3); \
            const h16* g_ = (step_ < 16) ? rsrc + (size_t)((step_ >> 3) * 256 + row_) * 256 + (step_ & 7) * 32 + pc_ * 8 : VT + (size_t)(h * 512 + ((step_ - 16) >> 2) * 256 + row_) * M + tok0 + ((step_ - 16) & 3) * 32 + pc_ * 8; \
            __builtin_amdgcn_global_load_lds((const unsigned*)g_, (LAS unsigned*)(lds + R2_REG2 + (step_ % R2_NS) * R2_BCS + (2 * wave + ii_) * 1024), 16, 0, 0); } } while (0)
#define R2_STEP(st_, ABASE, APITCH, KOFF, HH) do { \
            asm volatile("s_waitcnt vmcnt(6) lgkmcnt(0)" ::: "memory");                                     \
            asm volatile("" ::: "memory"); __builtin_amdgcn_s_barrier(); asm volatile("" ::: "memory");     \
            R2_FRESH; \
            h16x8 af_[4]; \
            _Pragma("unroll") for (int m = 0; m < 4; ++m) af_[m] = *(const LAS h16x8*)(lds + (ABASE) + (wr * 64 + m * 16 + fr) * (APITCH) + ((KOFF) + fq * 8) * 2); \
            _Pragma("unroll") for (int e = 0; e < 4; ++e) { const int rb_ = wc * 64 + e * 16 + fr; const h16x8 bfr_ = *(const LAS h16x8*)(lds + R2_REG2 + ((st_) % R2_NS) * R2_BCS + rb_ * 64 + ((fq ^ ((rb_ >> 2) & 3)) << 4)); \
                _Pragma("unroll") for (int m = 0; m < 4; ++m) acc[m][(HH) * 4 + e] = __builtin_amdgcn_mfma_f32_16x16x32_f16(bfr_, af_[m], acc[m][(HH) * 4 + e], 0, 0, 0); } } while (0)
        __syncthreads();
        {
            u32x4 tq[8];
#pragma unroll
            for (int it = 0; it < 8; ++it) { const int p = tid + 512 * it, row = p >> 5, c16 = p & 31; tq[it] = *(const u32x4*)(Qg + (size_t)(tok0 + row) * D + h * 256 + c16 * 8); }
#pragma unroll
            for (int it = 0; it < 8; ++it) { const int p = tid + 512 * it, row = p >> 5, c16 = p & 31; *(LAS u32x4*)(lds + row * R2_QP + c16 * 16) = tq[it]; }
        }
        asm volatile("s_waitcnt vmcnt(0) lgkmcnt(0)" ::: "memory");
#pragma unroll
        for (int i = 0; i < R2_D; ++i) R2_ISSUE(i);
        f32x4 acc[4][8];
#pragma unroll
        for (int m = 0; m < 4; ++m)
#pragma unroll
            for (int e = 0; e < 8; ++e) acc[m][e] = zero4();
#pragma unroll
        for (int st = 0; st < 16; ++st) {
            R2_STEP(st, 0, R2_QP, (st & 7) * 32, st >> 3);
            R2_ISSUE(st + R2_D < 16 ? st + R2_D : 15);
            if ((st & 7) == 7) {
#pragma unroll
                for (int m = 0; m < 4; ++m) { const float f = __builtin_amdgcn_exp2f((float)(wr * 64 + m * 16 + fr + 1) * l2g);
#pragma unroll
                    for (int e = 0; e < 4; ++e) acc[m][(st >> 3) * 4 + e] = acc[m][(st >> 3) * 4 + e] * f; }
            }
        }
        asm volatile("s_waitcnt vmcnt(0) lgkmcnt(0)" ::: "memory");
        asm volatile("" ::: "memory"); __builtin_amdgcn_s_barrier(); asm volatile("" ::: "memory");
        R2_FRESH;
        {
            u32x4 tk[8];
#pragma unroll
            for (int it = 0; it < 8; ++it) { const int p = tid + 512 * it, row = p >> 5, c16 = p & 31; tk[it] = *(const u32x4*)(Kg + (size_t)(tok0 + row) * D + h * 256 + c16 * 8); }
#pragma unroll
            for (int it = 0; it < 8; ++it) { const int p = tid + 512 * it, row = p >> 5, c16 = p & 31; *(LAS u32x4*)(lds + R2_REG2 + row * R2_QP + c16 * 16) = tk[it]; }
        }
        __syncthreads();
        R2_FRESH;
        {
            f32x4 sacc[4][2];
#pragma unroll
            for (int m = 0; m < 4; ++m) { sacc[m][0] = zero4(); sacc[m][1] = zero4(); }
#pragma unroll
            for (int ks = 0; ks < 8; ++ks) {
                h16x8 af[4];
#pragma unroll
                for (int m = 0; m < 4; ++m) af[m] = *(const LAS h16x8*)(lds + (wr * 64 + m * 16 + fr) * R2_QP + (ks * 32 + fq * 8) * 2);
#pragma unroll
                for (int n2 = 0; n2 < 2; ++n2) { const h16x8 bfr = *(const LAS h16x8*)(lds + R2_REG2 + (wc * 32 + n2 * 16 + fr) * R2_QP + (ks * 32 + fq * 8) * 2);
#pragma unroll
                    for (int m = 0; m < 4; ++m) sacc[m][n2] = __builtin_amdgcn_mfma_f32_16x16x32_f16(bfr, af[m], sacc[m][n2], 0, 0, 0); }
            }
            __syncthreads();
            R2_FRESH;
#pragma unroll
            for (int i = 0; i < R2_D; ++i) R2_ISSUE(16 + i);
#pragma unroll
            for (int m = 0; m < 4; ++m) { const int i = wr * 64 + m * 16 + fr;
#pragma unroll
                for (int n2 = 0; n2 < 2; ++n2) { const int j0 = wc * 32 + n2 * 16 + fq * 4; f32x4 pv;
#pragma unroll
                    for (int j = 0; j < 4; ++j) { const int dd = i - (j0 + j); pv[j] = dd >= 0 ? sacc[m][n2][j] * __builtin_amdgcn_exp2f((float)dd * l2g) : 0.f; }
                    *(LAS u32x2*)(lds + i * R2_PP + j0 * 2) = pk4(pv); } }
        }
#pragma unroll
        for (int st = 16; st < 24; ++st) {
            R2_STEP(st, 0, R2_PP, ((st - 16) & 3) * 32, (st - 16) >> 2);
            R2_ISSUE(st + R2_D < 24 ? st + R2_D : 23);
        }
        asm volatile("s_waitcnt vmcnt(0)" ::: "memory");
        __syncthreads();
        R2_FRESH;
        float mean[4], rstd[4];
#pragma unroll
        for (int m = 0; m < 4; ++m) { float sm = 0.f;
#pragma unroll
            for (int e = 0; e < 8; ++e) sm += (acc[m][e][0] + acc[m][e][1]) + (acc[m][e][2] + acc[m][e][3]);
            sm += shfl_xor_(sm, 16, tid & 63); sm += shfl_xor_(sm, 32, tid & 63);
            if (fq == 0) ST1[(wr * 64 + m * 16 + fr) * 4 + wc] = sm; }
        __syncthreads();
#pragma unroll
        for (int m = 0; m < 4; ++m) { const f32x4 t = *(const LAS f32x4*)(ST1 + (wr * 64 + m * 16 + fr) * 4); mean[m] = ((t[0] + t[1]) + (t[2] + t[3])) * (1.0f / 512.0f); float q = 0.f;
#pragma unroll
            for (int e = 0; e < 8; ++e) { const f32x4 d = acc[m][e] - mean[m]; q += (d[0] * d[0] + d[1] * d[1]) + (d[2] * d[2] + d[3] * d[3]); }
            q += shfl_xor_(q, 16, tid & 63); q += shfl_xor_(q, 32, tid & 63);
            if (fq == 0) ST2[(wr * 64 + m * 16 + fr) * 4 + wc] = q; }
        __syncthreads();
        R2_FRESH;
#pragma unroll
        for (int m = 0; m < 4; ++m) { const f32x4 t = *(const LAS f32x4*)(ST2 + (wr * 64 + m * 16 + fr) * 4); rstd[m] = 1.0f / sqrtf(((t[0] + t[1]) + (t[2] + t[3])) * (1.0f / 512.0f) + 1e-5f); }
#pragma unroll
        for (int m = 0; m < 4; ++m) { const size_t ro = (size_t)(tok0 + wr * 64 + m * 16 + fr) * 4096 + h * 512;
            f32x4 gg[8]; h16x4 s4[8];
#pragma unroll
            for (int e = 0; e < 8; ++e) { const int col = (e >> 2) * 256 + wc * 64 + (e & 3) * 16 + fq * 4; gg[e] = *(const f32x4*)(gn + h * 512 + col); s4[e] = *(const h16x4*)(SG + ro + col); }
#pragma unroll
            for (int e = 0; e < 8; ++e) { const int col = (e >> 2) * 256 + wc * 64 + (e & 3) * 16 + fq * 4; f32x4 o;
#pragma unroll
                for (int j = 0; j < 4; ++j) o[j] = (acc[m][e][j] - mean[m]) * rstd[m] * gg[e][j] * (float)s4[e][j];
                *(u32x2*)(OG + ro + col) = pk4(o); } }
    }
#undef R2_FRESH
#undef R2_ISSUE
#undef R2_STEP
}

typedef float f32x16 __attribute__((ext_vector_type(16)));
constexpr int SW_KP = 144, SW_VP = 528, SW_VOFF = 36864, SW_BOFF = 36864 + 33792;
DI void swa_attn(LAS unsigned char* lds, const h16* QKV, const float* sinks, const float* relb, h16* O, int bid, int G, int tid, int wave, int lane) {
    for (int unit = bid; unit < 512; unit += G) {
        const int hkv = unit & 3, n = (unit >> 2) & 63, b = unit >> 8;
        const int tokq = b * SEQ + n * 128, tokk = tokq - 128, tmin = b * SEQ;
        __syncthreads();
#pragma unroll
        for (int it = 0; it < 4; ++it) { const int p = tid + 512 * it, row = p >> 3, c = p & 7; int tk = tokk + row; tk = tk < tmin ? tmin : tk;
            *(LAS u32x4*)(lds + row * SW_KP + c * 16) = *(const u32x4*)(QKV + (size_t)tk * 2560 + 2048 + hkv * 64 + c * 8); }
#pragma unroll
        for (int it = 0; it < 4; ++it) { const int p = tid + 512 * it, key = p & 255, c = p >> 8; int tk = tokk + key; tk = tk < tmin ? tmin : tk;
            const h16x8 v = *(const h16x8*)(QKV + (size_t)tk * 2560 + 2304 + hkv * 64 + c * 8);
#pragma unroll
            for (int j = 0; j < 8; ++j) *(LAS h16*)(lds + SW_VOFF + (c * 8 + j) * SW_VP + key * 2) = v[j]; }
        for (int idx = tid; idx < 1024; idx += NTHR) ((LAS float*)(lds + SW_BOFF))[idx] = relb[(int)T5_BUCKET[idx & 127] * 32 + hkv * 8 + (idx >> 7)];
        __syncthreads();
        const int hq = hkv * 8 + wave, r = lane & 31, h = lane >> 5;
        const float sink = sinks[hq];
        const LAS float* btab = (const LAS float*)(lds + SW_BOFF) + wave * 128;
        for (int qt = 0; qt < 4; ++qt) {
            h16x8 qf[4];
#pragma unroll
            for (int ks = 0; ks < 4; ++ks) qf[ks] = *(const h16x8*)(QKV + (size_t)(tokq + 32 * qt + r) * 2560 + hq * 64 + 16 * ks + 8 * h);
            f32x16 sc[5];
#pragma unroll
            for (int t5 = 0; t5 < 5; ++t5) {
#pragma unroll
                for (int i4 = 0; i4 < 4; ++i4) { const f32x4 z = zero4(); sc[t5][4 * i4] = z[0]; sc[t5][4 * i4 + 1] = z[1]; sc[t5][4 * i4 + 2] = z[2]; sc[t5][4 * i4 + 3] = z[3]; }
#pragma unroll
                for (int ks = 0; ks < 4; ++ks) { const h16x8 kf = *(const LAS h16x8*)(lds + (32 * (qt + t5) + r) * SW_KP + (16 * ks + 8 * h) * 2);
                    sc[t5] = __builtin_amdgcn_mfma_f32_32x32x16_f16(kf, qf[ks], sc[t5], 0, 0, 0); }
            }
            float mx = sink;
#pragma unroll
            for (int t5 = 0; t5 < 5; ++t5)
#pragma unroll
                for (int i = 0; i < 16; ++i) { const int key = 32 * (qt + t5) + (i & 3) + 8 * (i >> 2) + 4 * h, dist = 128 + 32 * qt + r - key;
                    const bool valid = dist >= 0 && dist < 128 && (n > 0 || key >= 128);
                    const float v = valid ? sc[t5][i] + btab[dist & 127] : -1e30f; sc[t5][i] = v; mx = fmaxf(mx, v); }
            mx = fmaxf(mx, shfl_xor_(mx, 32, lane));
            float sum = 0.f;
#pragma unroll
            for (int t5 = 0; t5 < 5; ++t5)
#pragma unroll
                for (int i = 0; i < 16; ++i) { const float pe = __expf(sc[t5][i] - mx); sc[t5][i] = pe; sum += pe; }
            sum += shfl_xor_(sum, 32, lane);
            const float inv = 1.0f / (sum + __expf(sink - mx));
            f32x16 o[2];
#pragma unroll
            for (int i4 = 0; i4 < 4; ++i4) { const f32x4 z = zero4(), y = zero4(); o[0][4 * i4] = z[0]; o[0][4 * i4 + 1] = z[1]; o[0][4 * i4 + 2] = z[2]; o[0][4 * i4 + 3] = z[3]; o[1][4 * i4] = y[0]; o[1][4 * i4 + 1] = y[1]; o[1][4 * i4 + 2] = y[2]; o[1][4 * i4 + 3] = y[3]; }
#pragma unroll
            for (int t5 = 0; t5 < 5; ++t5)
#pragma unroll
                for (int st = 0; st < 2; ++st) {
                    u32x4 pw; pw.x = pkh(sc[t5][8 * st + 0], sc[t5][8 * st + 1]); pw.y = pkh(sc[t5][8 * st + 2], sc[t5][8 * st + 3]); pw.z = pkh(sc[t5][8 * st + 4], sc[t5][8 * st + 5]); pw.w = pkh(sc[t5][8 * st + 6], sc[t5][8 * st + 7]);
                    const h16x8 pb = __builtin_bit_cast(h16x8, pw);
#pragma unroll
                    for (int dt = 0; dt < 2; ++dt) { const LAS unsigned char* vp = lds + SW_VOFF + (32 * dt + r) * SW_VP + (32 * (qt + t5) + 16 * st + 4 * h) * 2;
                        u32x4 vw; const u32x2 lo = *(const LAS u32x2*)vp, hi = *(const LAS u32x2*)(vp + 16); vw.x = lo.x; vw.y = lo.y; vw.z = hi.x; vw.w = hi.y;
                        o[dt] = __builtin_amdgcn_mfma_f32_32x32x16_f16(__builtin_bit_cast(h16x8, vw), pb, o[dt], 0, 0, 0); }
                }
            h16* orow = O + (size_t)(tokq + 32 * qt + r) * D + hq * 64;
#pragma unroll
            for (int dt = 0; dt < 2; ++dt)
#pragma unroll
                for (int g4 = 0; g4 < 4; ++g4) { f32x4 ov = {o[dt][4 * g4] * inv, o[dt][4 * g4 + 1] * inv, o[dt][4 * g4 + 2] * inv, o[dt][4 * g4 + 3] * inv};
                    *(u32x2*)(orow + 32 * dt + 8 * g4 + 4 * h) = pk4(ov); }
        }
    }
}

DI void rwkv_prep(const h16* __restrict__ X, const float* __restrict__ mix, h16* __restrict__ LX, int gtid, int NT) {
    for (int i = gtid; i < M * (D / 8); i += NT) { const int m = i >> 8, c = (i & 255) * 8; const h16x8 xh = *(const h16x8*)(X + (size_t)m * D + c);
        h16x8 ph = {0, 0, 0, 0, 0, 0, 0, 0}; if ((m & (SEQ - 1)) != 0) ph = *(const h16x8*)(X + (size_t)(m - 1) * D + c);
        f32x4 x0, x1, d0, d1;
#pragma unroll
        for (int j = 0; j < 4; ++j) { x0[j] = (float)xh[j]; x1[j] = (float)xh[4 + j]; d0[j] = (float)ph[j] - x0[j]; d1[j] = (float)ph[4 + j] - x1[j]; }
#pragma unroll
        for (int s = 0; s < 6; ++s) { const int mr = (s == 0) ? 0 : (s == 1) ? 2 : (s == 2) ? 3 : (s == 3) ? 1 : s; const f32x4 m0 = *(const f32x4*)(mix + mr * D + c), m1 = *(const f32x4*)(mix + mr * D + c + 4);
            *(u32x4*)(LX + (size_t)s * M * D + (size_t)m * D + c) = pk8(x0 + d0 * m0, x1 + d1 * m1); } }
}
constexpr int CB_ATL = 0, CB_RLL = 2560, CB_TT = 5632, CB_BK = 6144, CB_Q16 = 10240, CB_BYTES = 10496;
DI float dpp_allreduce16(float v) {
    v += __builtin_bit_cast(float, __builtin_amdgcn_update_dpp(0, __builtin_bit_cast(int, v), 0xB1, 0xF, 0xF, false));
    v += __builtin_bit_cast(float, __builtin_amdgcn_update_dpp(0, __builtin_bit_cast(int, v), 0x4E, 0xF, 0xF, false));
    v += __builtin_bit_cast(float, __builtin_amdgcn_update_dpp(0, __builtin_bit_cast(int, v), 0x141, 0xF, 0xF, false));
    v += __builtin_bit_cast(float, __builtin_amdgcn_update_dpp(0, __builtin_bit_cast(int, v), 0x140, 0xF, 0xF, false));
    return v;
}
constexpr int CP_PITCH = 144, CP_WAVE_LDS = 2 * 32 * 144 + 1024;
DI void rwkv_cprep(LAS unsigned char* lds, const h16* __restrict__ RKV, const h16* __restrict__ WAG, const float* __restrict__ k_k, const float* __restrict__ k_a, const float* __restrict__ r_k, unsigned char* __restrict__ CBG, float* __restrict__ BON, int gw, int NGW, int wave, int lane) {
    LAS unsigned char* AR = lds + wave * CP_WAVE_LDS; LAS unsigned char* BKt = AR + 32 * CP_PITCH; LAS float* LAB = (LAS float*)(BKt + 32 * CP_PITCH);
    h16 lr[16], lk[16], lw[16], la[16], lwn[8]; float kkc = 0.f, kac = 0.f, rkc = 0.f;
#define CP_LOADS(u_) do { const int bh_ = (u_) >> 9, c_ = (u_) & 511, col_ = (bh_ & 31) * 64 + lane, m0_ = (bh_ >> 5) * SEQ + c_ * 16; kkc = k_k[col_]; kac = k_a[col_]; rkc = r_k[col_]; \
        _Pragma("unroll") for (int t = 0; t < 16; ++t) { const size_t o = (size_t)(m0_ + t) * D + col_; lr[t] = RKV[o]; lk[t] = RKV[(size_t)M * D + o]; lw[t] = WAG[o]; la[t] = WAG[(size_t)M * D + o]; } \
        _Pragma("unroll") for (int t = 0; t < 8; ++t) lwn[t] = (c_ < 511) ? WAG[(size_t)(m0_ + 16 + t) * D + col_] : (h16)1.0f;     \
    } while (0)
    if (gw < 64 * 512) CP_LOADS(gw);
    for (int unit = gw; unit < 64 * 512; unit += NGW) {
        const int bh = unit >> 9, c = unit & 511, b = bh >> 5, hd = bh & 31, m0 = b * SEQ + c * 16; (void)c;
        float av[16], bv[16], kv[16], rv[16], pv[16]; float p = 1.0f, bonv = 0.f;
#pragma unroll
        for (int t = 0; t < 16; ++t) {
            const float r = (float)lr[t], k = (float)lk[t], w = (float)lw[t], al = (float)la[t];
            const float kkv = k * kkc; const float nrm = sqrtf(wave_sum_dpp(kkv * kkv)); const float kkn = kkv * __builtin_amdgcn_rcpf(fmaxf(nrm, 1e-12f));
            const float kp = k * (1.0f + (al - 1.0f) * kac);
            const float bon = wave_sum_dpp(r * kp * rkc); bonv = (lane == t) ? bon : bonv;
            p *= w; av[t] = -kkn; bv[t] = kkn * al; kv[t] = kp; rv[t] = r; pv[t] = p; }
        if (lane < 16) BON[(size_t)(m0 + lane) * 32 + hd] = bonv;
        float p8n = 1.0f;
#pragma unroll
        for (int t = 0; t < 8; ++t) p8n *= (float)lwn[t];
        if (unit + NGW < 64 * 512) CP_LOADS(unit + NGW);
        const float inv8 = __builtin_amdgcn_rcpf(pv[7]), q16 = pv[15] * inv8 * p8n;
        const int pk_ = 32 * (lane >> 5) + 8 * ((lane >> 2) & 3) + 4 * ((lane >> 4) & 1) + (lane & 3);
        unsigned char* blk = CBG + (size_t)unit * CB_BYTES;
        h16* ATL = (h16*)(blk + CB_ATL); h16* RLL = (h16*)(blk + CB_RLL); h16* TT = (h16*)(blk + CB_TT); h16* BK = (h16*)(blk + CB_BK);
        float kh[16], bh_[16];
#pragma unroll
        for (int t = 0; t < 16; ++t) { const float qm = (t == 0) ? inv8 : pv[t - 1] * inv8, qt = pv[t] * inv8, iq = __builtin_amdgcn_rcpf(qt);
            const float At = av[t] * qm, Bt = bv[t] * iq, Kt = kv[t] * iq, Rt = rv[t] * qt;
            *(LAS h16*)(AR + t * CP_PITCH + pk_ * 2) = (h16)At; *(LAS h16*)(AR + (16 + t) * CP_PITCH + pk_ * 2) = (h16)Rt;
            *(LAS h16*)(BKt + t * CP_PITCH + pk_ * 2) = (h16)Bt; *(LAS h16*)(BKt + (16 + t) * CP_PITCH + pk_ * 2) = (h16)Kt;
            kh[t] = Kt * q16; bh_[t] = Bt * q16; }
#pragma unroll
        for (int i = 0; i < 2; ++i) { const int idx = lane + 64 * i, row = idx >> 3, seg = idx & 7;
            *(u32x4*)(ATL + row * 80 + seg * 8) = *(const LAS u32x4*)(AR + row * CP_PITCH + seg * 16); *(u32x4*)(RLL + row * 96 + seg * 8) = *(const LAS u32x4*)(AR + (16 + row) * CP_PITCH + seg * 16); }
        {
            u32x4 w0, w1, w2, w3;
            w0.x = pkh(kh[0], kh[1]); w0.y = pkh(kh[2], kh[3]); w0.z = pkh(kh[4], kh[5]); w0.w = pkh(kh[6], kh[7]); w1.x = pkh(kh[8], kh[9]); w1.y = pkh(kh[10], kh[11]); w1.z = pkh(kh[12], kh[13]); w1.w = pkh(kh[14], kh[15]);
            w2.x = pkh(bh_[0], bh_[1]); w2.y = pkh(bh_[2], bh_[3]); w2.z = pkh(bh_[4], bh_[5]); w2.w = pkh(bh_[6], bh_[7]); w3.x = pkh(bh_[8], bh_[9]); w3.y = pkh(bh_[10], bh_[11]); w3.z = pkh(bh_[12], bh_[13]); w3.w = pkh(bh_[14], bh_[15]);
            u32x4* br = (u32x4*)(BK + lane * 32);
            br[0] = (u32x4){w2.x, w2.y, w0.x, w0.y}; br[1] = (u32x4){w2.z, w2.w, w0.z, w0.w}; br[2] = (u32x4){w3.x, w3.y, w1.x, w1.y}; br[3] = (u32x4){w3.z, w3.w, w1.z, w1.w};
            ((float*)(blk + CB_Q16))[lane] = q16;
        }
        const int fr = lane & 15, fq = lane >> 4;
        f32x4 lab = zero4(), lak = zero4(), lrb = zero4(), lrk = zero4();
#pragma unroll
        for (int ks = 0; ks < 2; ++ks) {
            const h16x8 fa = *(const LAS h16x8*)(AR + fr * CP_PITCH + (ks * 32 + fq * 8) * 2), fR = *(const LAS h16x8*)(AR + (16 + fr) * CP_PITCH + (ks * 32 + fq * 8) * 2);
            const h16x8 fb = *(const LAS h16x8*)(BKt + fr * CP_PITCH + (ks * 32 + fq * 8) * 2), fk = *(const LAS h16x8*)(BKt + (16 + fr) * CP_PITCH + (ks * 32 + fq * 8) * 2);
            lab = __builtin_amdgcn_mfma_f32_16x16x32_f16(fb, fa, lab, 0, 0, 0); lak = __builtin_amdgcn_mfma_f32_16x16x32_f16(fk, fa, lak, 0, 0, 0);
            lrb = __builtin_amdgcn_mfma_f32_16x16x32_f16(fb, fR, lrb, 0, 0, 0); lrk = __builtin_amdgcn_mfma_f32_16x16x32_f16(fk, fR, lrk, 0, 0, 0);
        }
#pragma unroll
        for (int j = 0; j < 4; ++j) { const int tc = 4 * fq + j; if (tc >= fr) { lab[j] = 0.f; lak[j] = 0.f; } if (tc > fr) { lrb[j] = 0.f; lrk[j] = 0.f; } }
        *(LAS f32x4*)(LAB + fr * 16 + 4 * fq) = lab;
        *(u32x2*)(ATL + fr * 80 + 64 + 4 * fq) = pk4(lak); { const u32x2 pb = pk4(lrb), pk = pk4(lrk); *(u32x4*)(RLL + fr * 96 + 64 + 8 * fq) = (u32x4){pb.x, pb.y, pk.x, pk.y}; }
        {
            const int cc = lane & 15; float tr[16];
#pragma unroll
            for (int t = 0; t < 16; ++t) { float acc = (t == cc) ? 1.0f : 0.0f;
#pragma unroll
                for (int j = 0; j < 16; ++j) if (j < t) acc += LAB[t * 16 + j] * tr[j];
                tr[t] = acc; }
            if (lane < 16) {
#pragma unroll
                for (int t = 0; t < 16; ++t) TT[t * 16 + cc] = (h16)tr[t]; }
        }
    }
#undef CP_LOADS
}
constexpr int CS_NS = 12, CS_D = 10, CS_SLOT = 11264, CS_VR = CS_NS * CS_SLOT;
DI void rwkv_cscan(LAS unsigned char* lds, const unsigned char* CBG, const h16* Vg, float* YS, int bid, int G, int wave, int lane) {
    for (int task = bid; task < 256; task += G) {
        const int bh = (task & 7) * 8 + (task >> 5), vs = (task >> 3) & 3, b = bh >> 5, hd = bh & 31, fr = lane & 15, fq = lane >> 4;
        const unsigned char* src = CBG + (size_t)bh * 512 * CB_BYTES;
        __syncthreads();
        const h16* vsrc = Vg + (size_t)(b * SEQ + ((lane & 31) >> 1)) * D + hd * 64 + vs * 16 + (lane & 1) * 8;
#define CS_ISSUE(n_) do { const unsigned char* g_ = src + (size_t)(n_) * CB_BYTES + lane * 16; LAS unsigned char* l_ = lds + ((n_) % CS_NS) * CS_SLOT; \
            for (int i = wave - 4; i < 11; i += 4) __builtin_amdgcn_global_load_lds((const unsigned*)(g_ + i * 1024), (LAS unsigned*)(l_ + i * 1024), 16, 0, 0); \
            if (wave == 7) __builtin_amdgcn_global_load_lds((const unsigned*)(vsrc + (size_t)(n_) * 16 * D), (LAS unsigned*)(lds + CS_VR + ((n_) % CS_NS) * 1024), 16, 0, 0); } while (0)
        if (wave >= 4) { for (int i = 0; i < CS_D; ++i) CS_ISSUE(i); asm volatile("s_waitcnt vmcnt(24)" ::: "memory"); static_assert(CS_D == 10, "vmcnt(24) = 3 x (CS_D - 2)"); }
#define CS_BAR do { asm volatile("s_waitcnt lgkmcnt(0)" ::: "memory"); __builtin_amdgcn_s_barrier(); asm volatile("" ::: "memory"); } while (0)
        CS_BAR;
        if (wave >= 4) {
            for (int n = 0; n < 512; ++n) {
                CS_ISSUE(n + CS_D < 512 ? n + CS_D : 511);
                asm volatile("s_waitcnt vmcnt(24)" ::: "memory");
                CS_BAR;
            }
        } else if (wave == 0) {
            struct Ops { f32x4 qq[4]; h16 vr[4]; h16x8 at[2], rl[2], rbk, bk[4]; h16x4 atv, ttx; };
#define CS_H8(lo_, hi_) __builtin_bit_cast(h16x8, (u32x4){(lo_).x, (lo_).y, (hi_).x, (hi_).y})
#define CS_SCHED __builtin_amdgcn_sched_barrier(0)
#define CS_STEP(S, T, n_) do { const int nn_ = (n_) + 1 < 512 ? (n_) + 1 : 511; const LAS unsigned char* blk = lds + (nn_ % CS_NS) * CS_SLOT; const LAS unsigned char* vimg = lds + CS_VR + (nn_ % CS_NS) * 1024; \
                const h16x4 vt4_ = (h16x4){S.vr[0], S.vr[1], S.vr[2], S.vr[3]}; const u32x2 vt2_ = __builtin_bit_cast(u32x2, vt4_); \
                const h16x8 xa0 = CS_H8(pk4(X[0]), pk4(X[1])), xa1 = CS_H8(pk4(X[2]), pk4(X[3]));                                                     \
                f32x4 wg = zero4();                                                                                                                    \
                wg = __builtin_amdgcn_mfma_f32_16x16x32_f16(S.at[0], xa0, wg, 0, 0, 0); \
                wg = __builtin_amdgcn_mfma_f32_16x16x32_f16(S.at[1], xa1, wg, 0, 0, 0); \
                wg = __builtin_amdgcn_mfma_f32_16x16x16f16(S.atv, vt4_, wg, 0, 0, 0); \
                f32x4 yt = zero4();                                                                                                                    \
                yt = __builtin_amdgcn_mfma_f32_16x16x32_f16(S.rl[0], xa0, yt, 0, 0, 0); \
                yt = __builtin_amdgcn_mfma_f32_16x16x32_f16(S.rl[1], xa1, yt, 0, 0, 0); \
                f32x4 qx[4]; _Pragma("unroll") for (int ct = 0; ct < 4; ++ct) qx[ct] = X[ct] * S.qq[ct]; \
                CS_SCHED; \
                _Pragma("unroll") for (int j = 0; j < 4; ++j) T.vr[j] = *(const LAS h16*)(vimg + (4 * fq + j) * 32 + fr * 2);                          \
                _Pragma("unroll") for (int ct = 0; ct < 4; ++ct) T.qq[ct] = *(const LAS f32x4*)(blk + CB_Q16 + (16 * ct + 4 * fq) * 4); \
                CS_SCHED; \
                f32x4 ut = zero4();                                                                                                                    \
                ut = __builtin_amdgcn_mfma_f32_16x16x16f16(S.ttx, __builtin_bit_cast(h16x4, pk4(wg)), ut, 0, 0, 0); \
                CS_SCHED; \
                _Pragma("unroll") for (int ct = 0; ct < 4; ++ct) T.bk[ct] = *(const LAS h16x8*)(blk + CB_BK + (16 * ct + fr) * 64 + fq * 16); \
                _Pragma("unroll") for (int sx = 0; sx < 2; ++sx) T.at[sx] = *(const LAS h16x8*)(blk + CB_ATL + fr * 160 + (sx * 4 + fq) * 16); \
                CS_SCHED; \
                const h16x8 uva = CS_H8(pk4(ut), vt2_); \
                  \
                _Pragma("unroll") for (int ct = 0; ct < 4; ++ct) X[ct] = __builtin_amdgcn_mfma_f32_16x16x32_f16(S.bk[ct], uva, qx[ct], 0, 0, 0); \
                yt = __builtin_amdgcn_mfma_f32_16x16x32_f16(S.rbk, uva, yt, 0, 0, 0); \
                CS_SCHED; \
                _Pragma("unroll") for (int sx = 0; sx < 2; ++sx) T.rl[sx] = *(const LAS h16x8*)(blk + CB_RLL + fr * 192 + (sx * 4 + fq) * 16); \
                T.atv = *(const LAS h16x4*)(blk + CB_ATL + fr * 160 + 128 + fq * 8); T.ttx = *(const LAS h16x4*)(blk + CB_TT + fr * 32 + fq * 8); \
                T.rbk = *(const LAS h16x8*)(blk + CB_RLL + fr * 192 + 128 + fq * 16); \
                float* yp = YS + ((size_t)bh * SEQ + (n_) * 16 + 4 * fq) * 64 + vs * 16 + fr; \
                _Pragma("unroll") for (int j = 0; j < 4; ++j) yp[j * 64] = yt[j]; } while (0)
            f32x4 X[4]; X[0] = zero4(); X[1] = zero4(); X[2] = zero4(); X[3] = zero4();
            Ops A, B;
            {   const LAS unsigned char* blk = lds; const LAS unsigned char* vimg = lds + CS_VR;
#pragma unroll
                for (int j = 0; j < 4; ++j) A.vr[j] = *(const LAS h16*)(vimg + (4 * fq + j) * 32 + fr * 2);
#pragma unroll
                for (int ct = 0; ct < 4; ++ct) { A.qq[ct] = *(const LAS f32x4*)(blk + CB_Q16 + (16 * ct + 4 * fq) * 4); A.bk[ct] = *(const LAS h16x8*)(blk + CB_BK + (16 * ct + fr) * 64 + fq * 16); }
#pragma unroll
                for (int sx = 0; sx < 2; ++sx) { A.at[sx] = *(const LAS h16x8*)(blk + CB_ATL + fr * 160 + (sx * 4 + fq) * 16); A.rl[sx] = *(const LAS h16x8*)(blk + CB_RLL + fr * 192 + (sx * 4 + fq) * 16); }
                A.atv = *(const LAS h16x4*)(blk + CB_ATL + fr * 160 + 128 + fq * 8); A.ttx = *(const LAS h16x4*)(blk + CB_TT + fr * 32 + fq * 8); A.rbk = *(const LAS h16x8*)(blk + CB_RLL + fr * 192 + 128 + fq * 16); }
            for (int n = 0; n < 512; n += 2) {
                CS_STEP(A, B, n); CS_BAR;
                CS_STEP(B, A, n + 1); CS_BAR;
            }
#undef CS_STEP
#undef CS_SCHED
#undef CS_H8
        } else {
            for (int n = 0; n < 512; ++n) CS_BAR;
        }
#undef CS_BAR
#undef CS_ISSUE
    }
}
DI void rwkv_post(const float* YS, const h16* Vg, const float* BON, const h16* Gt, const float* gg, const float* gb, h16* O, int gw, int NGW, int lane) {
    for (int task = gw; task < M * 8; task += NGW) { const int m = task >> 3, hg = task & 7, hd = hg * 4 + (lane >> 4), e0 = (lane & 15) * 4, col = hd * 64 + e0, b = m >> 13, t = m & (SEQ - 1);
        const size_t rb = (size_t)(b * 32 + hd) * SEQ + t;
        const f32x4 y = *(const f32x4*)(YS + rb * 64 + e0);
        const h16x4 v4 = *(const h16x4*)(Vg + (size_t)m * D + col), g4 = *(const h16x4*)(Gt + (size_t)m * D + col); const float bonus = BON[(size_t)m * 32 + hd];
        const f32x4 gn4 = *(const f32x4*)(gg + col), gb4 = *(const f32x4*)(gb + col);
        const float mean = dpp_allreduce16((y[0] + y[1]) + (y[2] + y[3])) * (1.0f / 64.0f); const f32x4 d = y - mean;
        const float var = dpp_allreduce16((d[0] * d[0] + d[1] * d[1]) + (d[2] * d[2] + d[3] * d[3])) * (1.0f / 64.0f);
        const f32x4 o = (d * (1.0f / sqrtf(var + 64e-5f)) * gn4 + gb4 + __builtin_convertvector(v4, f32x4) * bonus) * __builtin_convertvector(g4, f32x4);
        *(u32x2*)(O + (size_t)m * D + col) = pk4(o); }
}

struct Args { const float* in[33]; float* out; unsigned char* ws; int ph_lo, ph_hi, variant; };
constexpr int PH_PER_LAYER = 16, N_PHASES = 1 + 4 * PH_PER_LAYER;

#define CAS __attribute__((address_space(4)))
DI const CAS char* kargs() { const CAS char* kp = (const CAS char*)__builtin_amdgcn_kernarg_segment_ptr(); asm volatile("" : "+s"(kp)); return kp; }
DI const float* inp(int i) { return ((const float* const CAS*)kargs())[i]; }
DI unsigned char* wsp(size_t off) { return *(unsigned char* const CAS*)(kargs() + 272) + off; }
DI float* outp() { return *(float* const CAS*)(kargs() + 264); }
static_assert(offsetof(Args, out) == 264 && offsetof(Args, ws) == 272 && offsetof(Args, ph_lo) == 280, "Args layout");

__global__ void __launch_bounds__(NTHR, 2) mega(Args args) {
    extern __shared__ __attribute__((aligned(16))) unsigned char lds_raw[];
    LAS unsigned char* lds = (LAS unsigned char*)lds_raw;
    const int G = gridDim.x, bid = blockIdx.x;
    const int wave0 = __builtin_amdgcn_readfirstlane(threadIdx.x >> 6);
    {
        volatile LAS unsigned* MISC0 = (volatile LAS unsigned*)(lds + MISC_OFF);
        for (int u = threadIdx.x; u < (LDS_BYTES - MISC_OFF) / 4; u += NTHR) MISC0[u] = 0u;
        __syncthreads();
    }
    XcdBarrier bar = xcd_barrier_post((unsigned*)(args.ws + WS_CTL) + 4096, (volatile LAS unsigned*)(lds + MISC_OFF) + 8);
    const int lo = args.ph_lo, hi = args.ph_hi;
#define IN(k) (lo <= (k) && (k) < hi)
#define SEAM(k) do { if (IN(k) && IN((k) + 1)) xcd_barrier(bar, wave0); } while (0)
#define TCOORDS int wave = wave0; asm volatile("" : "+s"(wave)); int lane = lane_id(); int tid = wave * 64 + lane; \
    const int gw = bid * NWAVES + wave, NGW = G * NWAVES, gtid = bid * NTHR + tid, NT = G * NTHR; (void)lane; (void)gw; (void)NGW; (void)gtid; (void)NT;

    if (IN(0)) {
        TCOORDS
        cvt_flat(inp(0), (h16*)wsp(WS_XH0), (size_t)M * D, gtid, NT);
        float* cosT = (float*)wsp(WS_COS); float* sinT = (float*)wsp(WS_SIN);
        for (int i = gtid; i < SEQ * 128; i += NT) { const int pos = i >> 7, f = i & 127;
            const float pf = (float)pow(10000.0, (double)f / 128.0); const float inv = 1.0f / pf; const float ang = (float)pos * inv;
            const float c = (float)cos((double)ang), sn = (float)sin((double)ang);
            cosT[i] = c; sinT[i] = sn; }
    }
    SEAM(0);

    for (int L = 0; L < 4; ++L) {
        const int kind = L % 3, P0 = 1 + L * PH_PER_LAYER;
        const size_t xhc_off = (L & 1) ? WS_XH1 : WS_XH0, xho_off = (L & 1) ? WS_XH0 : WS_XH1;
        const size_t mixo_off = (kind == 0) ? WS_XF : WS_OV + (kind == 1 ? OV_SWAO : OV_RKV);
        const int kout = (kind == 0) ? 4096 : 2048;

        if (IN(P0 + 0) && !(SKIPMASK & 1)) {
            TCOORDS
            LAS float* scr = (LAS float*)(lds + wave * 16384);
            unsigned char* WMIX = wsp(WS_WMIX); unsigned char* WCOM = wsp(WS_WCOM);
            if (kind == 0) {
                const float* w = inp(4) + (size_t)(L / 3) * D * 12288;
                cvt_job(w, 12288, D, 2048, 0, (h16*)(WMIX + W_RETA), D, 0, scr, gw, NGW, lane);
                cvt_job(w, 12288, D, 2048, 2048, (h16*)(WMIX + W_RETA), D, 2048, scr, gw, NGW, lane);
                cvt_job(w, 12288, D, 4096, 8192, (h16*)(WMIX + W_RETA), D, 4096, scr, gw, NGW, lane);
                cvt_job(w, 12288, D, 4096, 4096, (h16*)(WMIX + W_RETB), D, 0, scr, gw, NGW, lane);
                cvt_job(inp(6) + (size_t)(L / 3) * 4096 * D, D, 4096, D, 0, (h16*)(WMIX + W_OUT), 4096, 0, scr, gw, NGW, lane);
            } else if (kind == 1) {
                cvt_job(inp(7), 2560, D, 2560, 0, (h16*)(WMIX + W_SWAQKV), D, 0, scr, gw, NGW, lane);
                cvt_job(inp(9), D, D, D, 0, (h16*)(WMIX + W_OUT), D, 0, scr, gw, NGW, lane);
            } else {
                h16* w1 = (h16*)(WMIX + W_RW1); h16* w2 = (h16*)(WMIX + W_RW2);
                for (int j = 0; j < 3; ++j) cvt_job(inp(12) + (size_t)j * D * D, D, D, D, 0, w1, D, j * D, scr, gw, NGW, lane);
                cvt_job(inp(14), 96, D, 96, 0, w1, D, 6144, scr, gw, NGW, lane); zero_rows(w1, D, 6144 + 96, 160, gtid, NT);
                cvt_job(inp(17), 96, D, 96, 0, w1, D, 6400, scr, gw, NGW, lane); zero_rows(w1, D, 6400 + 96, 160, gtid, NT);
                cvt_job(inp(19), 256, D, 256, 0, w1, D, 6656, scr, gw, NGW, lane);
                cvt_small(inp(15), D, 96, D, w2, 256, 0, gtid, NT);
                cvt_small(inp(18), D, 96, D, w2, 256, 2048, gtid, NT);
                cvt_job(inp(20), D, 256, D, 0, w2, 256, 4096, scr, gw, NGW, lane);
                cvt_job(inp(26), D, D, D, 0, (h16*)(WMIX + W_OUT), D, 0, scr, gw, NGW, lane);
            }
            cvt_job<true>(inp(27) + (size_t)L * D * DFF2, DFF2, D, DFF2, 0, (h16*)(WCOM + W_UP), D, 0, scr, gw, NGW, lane);
            cvt_job(inp(30) + (size_t)L * DFF * D, D, DFF, D, 0, (h16*)(WCOM + W_DOWN), DFF, 0, scr, gw, NGW, lane);
            cvt_job(inp(31) + (size_t)L * 256 * D, D, 256, D, 0, (h16*)(WCOM + W_PP), 256, 0, scr, gw, NGW, lane);
            cvt_job(inp(32) + (size_t)L * D * D, D, D, D, 0, (h16*)(WCOM + W_GATE), D, 0, scr, gw, NGW, lane);
            cvt_flat(inp(1) + (size_t)L * M * 256, (h16*)wsp(WS_PH), (size_t)M * 256, gtid, NT);
        }
        SEAM(P0 + 0);

        if (kind == 0) {
            if (IN(P0 + 1) && !(SKIPMASK & 2)) {
                { unsigned char* OV = wsp(WS_OV);
                  Gemm g{(const h16*)wsp(xhc_off), (const h16*)wsp(WS_WMIX + W_RETA), M, 8192, D, D, D}; StaticOrder S; S.init(M, 8192, G, bid);
                  EpiRetA E{(h16*)(OV + OV_Q), (h16*)(OV + OV_K), (h16*)(OV + OV_SG), (const float*)wsp(WS_COS), (const float*)wsp(WS_SIN), (h16*)(OV + OV_KT)};
                  gemm_phase<EpiRetA>(lds, g, S, E, wave0); }
                { unsigned char* OV = wsp(WS_OV);
                  Gemm g{(const h16*)wsp(WS_WMIX + W_RETB), (const h16*)wsp(xhc_off), 4096, M, D, D, D}; StaticOrder S; S.init(4096, M, G, bid);
                  EpiRetB E{(h16*)(OV + OV_VT)};
                  gemm_phase<EpiRetB>(lds, g, S, E, wave0); }
            }
            SEAM(P0 + 1);
            if (IN(P0 + 2) && !(SKIPMASK & 4)) { TCOORDS unsigned char* OV = wsp(WS_OV);
                ret_scan(lds, (const h16*)(OV + OV_KT), (const h16*)(OV + OV_VT), (h16*)(OV + OV_RALL), bid, G, wave, lane); }
            SEAM(P0 + 2);
            if (IN(P0 + 3) && !(SKIPMASK & 8)) { TCOORDS unsigned char* OV = wsp(WS_OV);
                ret_core(lds, (const h16*)(OV + OV_Q), (const h16*)(OV + OV_K), (const h16*)(OV + OV_VT), (const h16*)(OV + OV_RALL), (const h16*)(OV + OV_SG), (h16*)wsp(mixo_off), inp(5) + (size_t)(L / 3) * 4096, bid, G, tid, wave, lane); }
            SEAM(P0 + 3);
        } else if (kind == 1) {
            if (IN(P0 + 1)) { Gemm g{(const h16*)wsp(xhc_off), (const h16*)wsp(WS_WMIX + W_SWAQKV), M, 2560, D, D, D}; StaticOrder S; S.init(M, 2560, G, bid);
                EpiH16 E{(h16*)wsp(WS_OV + OV_QKV), 2560, 2048, 0.125f}; gemm_phase<EpiH16>(lds, g, S, E, wave0); }
            SEAM(P0 + 1);
            if (IN(P0 + 2) && !(SKIPMASK & 16)) { TCOORDS swa_attn(lds, (const h16*)wsp(WS_OV + OV_QKV), inp(8), inp(10), (h16*)wsp(mixo_off), bid, G, tid, wave, lane); }
            SEAM(P0 + 2);
        } else {
            if (IN(P0 + 1) && !(SKIPMASK & 128)) { TCOORDS rwkv_prep((const h16*)wsp(xhc_off), inp(11), (h16*)wsp(WS_OV + OV_LX), gtid, NT); }
            SEAM(P0 + 1);
            if (IN(P0 + 2)) { Gemm g{(const h16*)wsp(WS_OV + OV_LX), (const h16*)wsp(WS_WMIX + W_RW1), M, 6912, D, D, D}; StaticOrder S; S.init(M, 6912, G, bid);
                EpiRw1 E{(h16*)wsp(WS_OV + OV_RKV), (h16*)wsp(WS_OV + OV_MID)}; gemm_phase<EpiRw1>(lds, g, S, E, wave0); }
            SEAM(P0 + 2);
            if (IN(P0 + 3)) { Gemm g{(const h16*)wsp(WS_OV + OV_MID), (const h16*)wsp(WS_WMIX + W_RW2), M, 6144, 256, 256, 256}; StaticOrder S; S.init(M, 6144, G, bid);
                EpiRw2 E{(h16*)wsp(WS_OV + OV_WAG), inp(13), inp(16)}; gemm_phase<EpiRw2>(lds, g, S, E, wave0); }
            SEAM(P0 + 3);
            if (IN(P0 + 4)) { TCOORDS rwkv_cprep(lds, (const h16*)wsp(WS_OV + OV_RKV), (const h16*)wsp(WS_OV + OV_WAG), inp(21), inp(22), inp(23), wsp(WS_OV + OV_LX), (float*)wsp(WS_OV + OV_MID), gw, NGW, wave, lane); }
            SEAM(P0 + 4);
            if (IN(P0 + 5) && !(SKIPMASK & 32)) { TCOORDS rwkv_cscan(lds, wsp(WS_OV + OV_LX), (const h16*)wsp(WS_OV + OV_RKV) + (size_t)2 * M * D, (float*)wsp(WS_OV + OV_WAG), bid, G, wave, lane); }
            SEAM(P0 + 5);
            if (IN(P0 + 6)) { TCOORDS rwkv_post((const float*)wsp(WS_OV + OV_WAG), (const h16*)wsp(WS_OV + OV_RKV) + (size_t)2 * M * D, (const float*)wsp(WS_OV + OV_MID), (const h16*)wsp(WS_OV + OV_WAG) + (size_t)2 * M * D, inp(24), inp(25), (h16*)wsp(mixo_off), gw, NGW, lane); }
            SEAM(P0 + 6);
        }

        if (IN(P0 + 8)) { Gemm g{(const h16*)wsp(mixo_off), (const h16*)wsp(WS_WMIX + W_OUT), M, D, kout, kout, kout}; StaticOrder S; S.init(M, D, G, bid);
            EpiRes E{(const h16*)wsp(xhc_off), (h16*)wsp(WS_YF)}; gemm_phase<EpiRes>(lds, g, S, E, wave0); }
        SEAM(P0 + 8);
        if (IN(P0 + 9)) { TCOORDS ln_rows((const h16*)wsp(WS_YF), inp(2) + (size_t)(L * 2 + 0) * D, inp(3) + (size_t)(L * 2 + 0) * D, (h16*)wsp(xho_off), gw, NGW, lane); }
        SEAM(P0 + 9);
        if (IN(P0 + 10)) { Gemm g{(const h16*)wsp(xho_off), (const h16*)wsp(WS_WCOM + W_UP), M, DFF2, D, D, D}; StaticOrder S; S.init(M, DFF2, G, bid);
#if ONE_LAUNCH
            { EpiUp E{(h16*)wsp(WS_OV + OV_ACT), (float*)wsp(WS_OV + OV_HALO), inp(28) + (size_t)L * 3 * DFF2, inp(29) + (size_t)L * DFF2, (LAS float*)(lds + 131072)}; gemm_phase<EpiUp>(lds, g, S, E, wave0); } }
#else
            if (*(const int CAS*)(kargs() + 288)) { EpiUpT<true> E{(h16*)wsp(WS_OV + OV_ACT), (float*)wsp(WS_OV + OV_HALO), inp(28) + (size_t)L * 3 * DFF2, inp(29) + (size_t)L * DFF2, (LAS float*)(lds + 131072)}; gemm_phase<EpiUpT<true>>(lds, g, S, E, wave0); }
            else { EpiUp E{(h16*)wsp(WS_OV + OV_ACT), (float*)wsp(WS_OV + OV_HALO), inp(28) + (size_t)L * 3 * DFF2, inp(29) + (size_t)L * DFF2, (LAS float*)(lds + 131072)}; gemm_phase<EpiUp>(lds, g, S, E, wave0); } }
#endif
        SEAM(P0 + 10);
        if (IN(P0 + 11)) {
            { TCOORDS ffn_fixup((const float*)wsp(WS_OV + OV_HALO), inp(28) + (size_t)L * 3 * DFF2, inp(29) + (size_t)L * DFF2, (h16*)wsp(WS_OV + OV_ACT), gtid, NT); }
            Gemm g{(const h16*)wsp(WS_PH), (const h16*)wsp(WS_WCOM + W_PP), M, D, 256, 256, 256}; StaticOrder S; S.init(M, D, G, bid);
            EpiH16 E{(h16*)wsp(WS_OV + OV_PP), D, 0, 1.0f}; gemm_phase<EpiH16>(lds, g, S, E, wave0);
        }
        SEAM(P0 + 11);
        if (IN(P0 + 12)) { Gemm g{(const h16*)wsp(WS_OV + OV_ACT), (const h16*)wsp(WS_WCOM + W_DOWN), M, D, DFF, DFF, DFF}; StaticOrder S; S.init(M, D, G, bid);
            EpiRes E{(const h16*)wsp(xho_off), (h16*)wsp(WS_YF)}; gemm_phase<EpiRes>(lds, g, S, E, wave0); }
        SEAM(P0 + 12);
        if (IN(P0 + 13)) { TCOORDS ln_rows((const h16*)wsp(WS_YF), inp(2) + (size_t)(L * 2 + 1) * D, inp(3) + (size_t)(L * 2 + 1) * D, (h16*)wsp(xhc_off), gw, NGW, lane); }
        SEAM(P0 + 13);
        if (IN(P0 + 14)) { Gemm g{(const h16*)wsp(xhc_off), (const h16*)wsp(WS_WCOM + W_GATE), M, D, D, D, D}; StaticOrder S; S.init(M, D, G, bid);
            EpiPle E{(const h16*)wsp(xhc_off), (const h16*)wsp(WS_OV + OV_PP), outp(), (L == 3) ? (h16*)nullptr : (h16*)wsp(xho_off)}; gemm_phase<EpiPle>(lds, g, S, E, wave0); }
        if (L < 3) SEAM(P0 + 14);
    }
#undef IN
#undef SEAM
#undef TCOORDS
}

static bool phase_exists(int ph) {
    if (ph == 0) return true;
    const int L = (ph - 1) / PH_PER_LAYER, p = (ph - 1) % PH_PER_LAYER, kind = L % 3;
    if (p == 0 || (p >= 8 && p <= 14)) return true;
    if (kind == 0) return p >= 1 && p <= 3;
    if (kind == 1) return p >= 1 && p <= 2;
    return p >= 1 && p <= 6;
}
extern "C" void kernel_launch(void* const* d_in, const int* in_sizes, int n_in, void* d_out, int out_size, void* d_ws, size_t ws_size, hipStream_t stream) {
    static int grid = 0;
    if (grid == 0) {
        if (n_in != 33 || in_sizes[0] != M * D || out_size != M * D || ws_size < WS_END) { fprintf(stderr, "kernel_launch: unexpected shapes (n_in %d, in0 %d, out %d, ws %zu < %zu)\n", n_in, n_in > 0 ? in_sizes[0] : -1, out_size, ws_size, (size_t)WS_END); grid = -1; return; }
        int dev = 0, cus = 0, per_cu = 0;
        if (hipGetDevice(&dev) != hipSuccess || hipDeviceGetAttribute(&cus, hipDeviceAttributeMultiprocessorCount, dev) != hipSuccess) { grid = -1; return; }
        if (hipFuncSetAttribute((const void*)mega, hipFuncAttributeMaxDynamicSharedMemorySize, LDS_BYTES) != hipSuccess) { fprintf(stderr, "kernel_launch: hipFuncSetAttribute failed\n"); grid = -1; return; }
        if (hipOccupancyMaxActiveBlocksPerMultiprocessor(&per_cu, (const void*)mega, NTHR, LDS_BYTES) != hipSuccess || per_cu < 1) fprintf(stderr, "kernel_launch: occupancy query says %d\n", per_cu);
        (void)hipGetLastError();
        grid = cus;
    }
    if (grid < 0) return;
    (void)hipMemsetAsync((char*)d_ws + WS_CTL, 0, CTL_ZERO_BYTES, stream);
    Args a{};
    for (int i = 0; i < 33; ++i) a.in[i] = (const float*)d_in[i];
    a.out = (float*)d_out; a.ws = (unsigned char*)d_ws;
#if ONE_LAUNCH
    a.ph_lo = 0; a.ph_hi = N_PHASES;
    hipLaunchKernelGGL(mega, dim3(grid), dim3(NTHR), LDS_BYTES, stream, a);
#else
    for (int ph = 0; ph < N_PHASES; ++ph) { if (!phase_exists(ph)) continue; a.ph_lo = ph; a.ph_hi = ph + 1;
        if (ph == PROBE_PH) { a.variant = PROBE_VAR; for (int r = 0; r < PROBE_N; ++r) hipLaunchKernelGGL(mega, dim3(grid), dim3(NTHR), LDS_BYTES, stream, a); }
        a.variant = 0;
        hipLaunchKernelGGL(mega, dim3(grid), dim3(NTHR), LDS_BYTES, stream, a); }
#endif
}
```

```cpp
#include <hip/hip_runtime.h>
#include <cstdio>
#include <cstdint>
#include <cstddef>

#define LAS __attribute__((address_space(3)))
#define GAS __attribute__((address_space(1)))
#define DI __device__ __forceinline__
typedef _Float16 h16;
typedef _Float16 h16x8 __attribute__((ext_vector_type(8)));
typedef _Float16 h16x4 __attribute__((ext_vector_type(4)));
typedef _Float16 h16x2 __attribute__((ext_vector_type(2)));
typedef float f32x4 __attribute__((ext_vector_type(4)));
typedef float f32x2 __attribute__((ext_vector_type(2)));
typedef unsigned u32x4 __attribute__((ext_vector_type(4)));
typedef unsigned u32x2 __attribute__((ext_vector_type(2)));

#ifndef SKIPMASK
#define SKIPMASK 0
#endif
#ifndef PROBE_PH
#define PROBE_PH 11
#endif
#ifndef PROBE_N
#define PROBE_N 4
#endif
#ifndef PROBE_VAR
#define PROBE_VAR 0
#endif
#ifndef ONE_LAUNCH
#define ONE_LAUNCH 1
#endif

constexpr int SEQ = 8192, M = 16384, D = 2048, DFF = 5504, DFF2 = 11008, NWAVES = 8, NTHR = 512;
constexpr float ALPHA = 1.681792830507429f;
constexpr float LN_EPS = 1e-5f;

constexpr size_t MiB = 1u << 20;
constexpr size_t WS_CTL = 0, CTL_ZERO_BYTES = 1 * MiB;
constexpr size_t WS_COS = 1 * MiB, WS_SIN = 5 * MiB;
constexpr size_t WS_STAT = 9 * MiB;
constexpr size_t WS_PH = 17 * MiB;
constexpr size_t WS_WMIX = 25 * MiB;
constexpr size_t WS_WCOM = 97 * MiB;
constexpr size_t WS_XF = 171 * MiB;
constexpr size_t WS_YF = 299 * MiB;
constexpr size_t WS_XH0 = 427 * MiB, WS_XH1 = 491 * MiB;
constexpr size_t WS_XBQ = WS_YF + 64 * MiB;
constexpr size_t WS_XBP = 555 * MiB + 704 * MiB;
constexpr size_t WS_OV = 555 * MiB;
constexpr size_t WS_END = 1376 * MiB;
constexpr size_t W_RETA = 0, W_RETB = 32 * MiB, W_OUT = 56 * MiB;
constexpr size_t W_SWAQKV = 0;
constexpr size_t W_RW1 = 0, W_RW2 = 27 * MiB;
constexpr size_t W_UP = 0, W_DOWN = 43 * MiB, W_PP = 65 * MiB, W_GATE = 66 * MiB;
constexpr size_t OV_Q = 0, OV_K = 64 * MiB, OV_SG = 128 * MiB, OV_KT = 256 * MiB, OV_VT = 320 * MiB, OV_RALL = 448 * MiB;
constexpr size_t OV_QKV = 0, OV_SWAO = 128 * MiB;
constexpr size_t OV_LX = 0  , OV_RKV = 400 * MiB  , OV_MID = 592 * MiB  , OV_WAG = 616 * MiB  ;
constexpr size_t OV_HALO = 0  , OV_PP = 16 * MiB  , OV_ACT = 344 * MiB  ;
static_assert(OV_WAG + 192 * MiB <= WS_END - WS_OV && OV_RALL + 256 * MiB <= WS_END - WS_OV && OV_ACT + 172 * MiB <= WS_END - WS_OV, "overlay");

constexpr int LDS_BYTES = 155648;
constexpr int MISC_OFF = 151552;

DI unsigned pkh(float a, float b) { f32x2 v = {a, b}; h16x2 h = __builtin_convertvector(v, h16x2); return __builtin_bit_cast(unsigned, h); }
typedef __bf16 bf16x2_t __attribute__((ext_vector_type(2)));
typedef __bf16 bf16x8_t __attribute__((ext_vector_type(8)));
DI unsigned pkb(float a, float b) { f32x2 v = {a, b}; bf16x2_t h = __builtin_convertvector(v, bf16x2_t); return __builtin_bit_cast(unsigned, h); }
DI u32x2 pkb4(f32x4 v) { u32x2 r; r.x = pkb(v[0], v[1]); r.y = pkb(v[2], v[3]); return r; }
DI u32x4 pkb8(f32x4 a, f32x4 b) { u32x4 r; r.x = pkb(a[0], a[1]); r.y = pkb(a[2], a[3]); r.z = pkb(b[0], b[1]); r.w = pkb(b[2], b[3]); return r; }
DI u32x2 pk4(f32x4 v) { u32x2 r; r.x = pkh(v[0], v[1]); r.y = pkh(v[2], v[3]); return r; }
DI u32x4 pk8(f32x4 a, f32x4 b) { u32x4 r; r.x = pkh(a[0], a[1]); r.y = pkh(a[2], a[3]); r.z = pkh(b[0], b[1]); r.w = pkh(b[2], b[3]); return r; }
DI int lane_id() { unsigned m = ~0u; asm volatile("" : "+s"(m)); int l = (int)__builtin_amdgcn_mbcnt_hi(m, __builtin_amdgcn_mbcnt_lo(m, 0u)); asm volatile("" : "+v"(l)); return l; }
DI float shfl_idx(float v, int src) { return __builtin_bit_cast(float, __builtin_amdgcn_ds_bpermute(src << 2, __builtin_bit_cast(int, v))); }
DI float shfl_xor_(float v, int o, int lane) { return shfl_idx(v, lane ^ o); }
DI float wave_sum(float v, int lane) {
#pragma unroll
    for (int o = 1; o < 64; o <<= 1) v += shfl_xor_(v, o, lane);
    return v;
}
DI float wave_max(float v, int lane) {
#pragma unroll
    for (int o = 1; o < 64; o <<= 1) v = fmaxf(v, shfl_xor_(v, o, lane));
    return v;
}
DI float sigmoidf_(float x) { return __builtin_amdgcn_rcpf(1.0f + __expf(-x)); }
__constant__ float L2GAMMA[8] = {-0.04580368961312479f, -0.02272007650008353f, -0.011315313227834146f, -0.005646563141142063f, -0.0028205190623786626f, -0.0014095702546713536f, -0.0007046129765893727f, -0.0003522634716290214f};
DI float log2gamma(int h) { return L2GAMMA[h]; }
DI f32x4 zero4() { float a, b, c, d; asm volatile("v_mov_b32 %0, 0\n\tv_mov_b32 %1, 0\n\tv_mov_b32 %2, 0\n\tv_mov_b32 %3, 0" : "=v"(a), "=v"(b), "=v"(c), "=v"(d)); return (f32x4){a, b, c, d}; }

namespace pg8 {
constexpr int BM = 256, BK = 64, HALF = 128, HTB = HALF * BK * 2, STAGE_BYTES = 8 * HTB, NXCD = 8, WGM = 8;
__host__ __device__ __forceinline__ int lds_byte(int r, int c) { const int st = (r >> 4) * 2 + (c >> 5), rr = r & 15, cc = c & 31, ob = rr * 64 + cc * 2; return st * 1024 + (ob ^ (((ob >> 9) & 1) << 5)); }
__host__ __device__ __forceinline__ void stage_rc(int b, int& R, int& C) { const int st = b / 1024, sb = b % 1024, swz = sb ^ (((sb >> 9) & 1) << 5); R = (st >> 1) * 16 + swz / 64; C = (st & 1) * 32 + (swz % 64) / 2; }
__host__ __device__ __forceinline__ int perm32(int rho) { const int n = rho >> 4, i = rho & 15; return 8 * (i >> 2) + 4 * n + (i & 3); }
struct Unit { int pm, pn; };
struct Gemm { const h16* A; const h16* Bt; int M, N, K, lda, ldb; };
struct StaticOrder {
    int nM, nN, nwg, G, c;
    __host__ __device__ void init(int M_, int N_, int G_, int c_) { nM = M_ / BM; nN = N_ / BM; nwg = nM * nN; G = G_; c = c_; }
    __host__ __device__ bool next(int i, Unit& u) const {
        const long L = (long)i * G + c; if (L >= nwg) return false;
        int wgid = (int)L; { const int q = nwg / NXCD, r = nwg % NXCD, xcd = wgid % NXCD, off = wgid / NXCD; wgid = (xcd < r ? xcd * (q + 1) : r * (q + 1) + (xcd - r) * q) + off; }
        const int nig = WGM * nN, gid = wgid / nig, fm = gid * WGM, gsz = (nM - fm) < WGM ? (nM - fm) : WGM;
        u.pm = fm + ((wgid % nig) % gsz); u.pn = (wgid % nig) / gsz; return true;
    }
};
struct PPOrder {
    int G, c, r;
    __host__ __device__ void init(int nup, int G_, int c_) { G = G_; c = c_; r = nup % G_; }
    __host__ __device__ bool next(int i, Unit& u) const {
        int t;
        if (G == 256 && r == 192) { if (c >= 192) { if (i >= 5) return false; t = 192 + (c - 192) * 5 + i; } else { if (i >= 1) return false; t = c; } }
        else { t = i * G + c; if (t >= 512) return false; }
        u.pm = t >> 3; u.pn = t & 7; return true;
    }
};
template <class Epi, bool ALIGN_EPI = true, class Order = StaticOrder>
__device__ __forceinline__ void gemm_phase(LAS unsigned char* lds, const Gemm g, const Order& S, const Epi& E, int wave0) {
    int wid = wave0; asm volatile("" : "+s"(wid));
    const int lane = lane_id();
    const int tid = wid * 64 + lane, wr = wid >> 2, wc = wid & 3, fr = lane & 15, fq = lane >> 4;
    int K = g.K; asm volatile("" : "+s"(K)); const int nt = K / BK;
    unsigned voffA[2], voffB[2];
#pragma unroll
    for (int i = 0; i < 2; ++i) { int R, C; stage_rc(tid * 16 + i * 8192, R, C); const int Rb = Epi::PERM ? ((R & ~31) + perm32(R & 31)) : R;
        const int Ra = Epi::ROWPERM ? ((R & ~63) + 4 * (R & 15) + ((R >> 4) & 3)) : R;
        voffA[i] = (unsigned)(Ra * g.lda + C) * 2u; voffB[i] = (unsigned)(Rb * g.ldb + C) * 2u; }
    const size_t kstep = (size_t)(BK * 2);
    const size_t hstepA = (size_t)HALF * g.lda * 2, hstepB = (size_t)HALF * g.ldb * 2;
    const size_t tstepA = 2 * hstepA, tstepB = 2 * hstepB;
    const unsigned ldsw = (unsigned)wid * 1024u;
    const int aoff = lds_byte(wr * 64 + fr, fq * 8), boff = lds_byte(wc * 32 + fr, fq * 8);
#define PG8_SA(b, h) (((b) * 2 + (h)) * HTB)
#define PG8_SB(b, h) ((4 + (b) * 2 + (h)) * HTB)
#define PG8_STAGE(bufoff, gbase, voff) do { _Pragma("unroll") for (int _i = 0; _i < 2; ++_i) \
        __builtin_amdgcn_global_load_lds((const unsigned*)((const char*)(gbase) + (voff)[_i]), (LAS unsigned*)(lds + (bufoff) + ldsw + _i * 8192), 16, 0, 0); } while (0)
#define PG8_LDA(dst, b, h) do { _Pragma("unroll") for (int m = 0; m < 4; ++m) _Pragma("unroll") for (int k = 0; k < 2; ++k) dst[m][k] = *(const LAS h16x8*)(lds + PG8_SA(b, h) + aoff + m * 2048 + k * 1024); } while (0)
#define PG8_LDB(dst, b, h) do { _Pragma("unroll") for (int n = 0; n < 2; ++n) _Pragma("unroll") for (int k = 0; k < 2; ++k) dst[n][k] = *(const LAS h16x8*)(lds + PG8_SB(b, h) + boff + n * 2048 + k * 1024); } while (0)
#define PG8_MMA(ai, bj, At, Bt) do { __builtin_amdgcn_s_setprio(1); _Pragma("unroll") for (int m = 0; m < 4; ++m) _Pragma("unroll") for (int n = 0; n < 2; ++n) _Pragma("unroll") for (int k = 0; k < 2; ++k) \
        acc[ai][bj][m][n] = __builtin_amdgcn_mfma_f32_16x16x32_bf16(__builtin_bit_cast(bf16x8_t, Bt[n][k]), __builtin_bit_cast(bf16x8_t, At[m][k]), acc[ai][bj][m][n], 0, 0, 0); __builtin_amdgcn_s_setprio(0); } while (0)
#define PG8_WAIT_V(n) asm volatile("s_waitcnt vmcnt(" #n ")" ::: "memory")
#define PG8_WAIT_L(n) asm volatile("s_waitcnt lgkmcnt(" #n ")" ::: "memory")
#define PG8_BAR __builtin_amdgcn_s_barrier()
#define PG8_SCHED __builtin_amdgcn_sched_barrier(0)
    Unit cur, nxt; int ui = 0;
    if (!S.next(0, cur)) return;
    f32x4 acc[2][2][4][2];
#pragma unroll
    for (int a = 0; a < 2; ++a)
#pragma unroll
        for (int b = 0; b < 2; ++b)
#pragma unroll
            for (int m = 0; m < 4; ++m)
#pragma unroll
                for (int n = 0; n < 2; ++n) acc[a][b][m][n] = zero4();
    h16x8 At[4][2], B0[2][2], B1[2][2];
    const char* cA = (const char*)g.A + E.a_off(cur) + (size_t)cur.pm * tstepA; const char* cB = (const char*)g.Bt + (size_t)cur.pn * tstepB;
    PG8_STAGE(PG8_SB(0, 0), cB, voffB); PG8_STAGE(PG8_SB(0, 1), cB + hstepB, voffB); PG8_STAGE(PG8_SA(0, 0), cA, voffA); PG8_STAGE(PG8_SA(0, 1), cA + hstepA, voffA);
    if (wr == 1) PG8_BAR;
    PG8_WAIT_V(2); PG8_BAR;
    PG8_STAGE(PG8_SB(1, 0), cB + kstep, voffB); PG8_STAGE(PG8_SA(1, 0), cA + kstep, voffA); PG8_STAGE(PG8_SB(1, 1), cB + hstepB + kstep, voffB);
    PG8_WAIT_V(6); PG8_BAR;
    for (;;) {
        const bool has_next = S.next(ui + 1, nxt);
        E.pre(lds, cur, ui, wid);
        const char* nA = has_next ? (const char*)g.A + E.a_off(nxt) + (size_t)nxt.pm * tstepA : cA; const char* nB = has_next ? (const char*)g.Bt + (size_t)nxt.pn * tstepB : cB;
        for (int t = 0; t < nt; t += 2) {
            const bool last = (t == nt - 2);
            const char* a1 = cA + (size_t)(t + 1) * kstep;
            const char* a2 = last ? nA : cA + (size_t)(t + 2) * kstep; const char* b2 = last ? nB : cB + (size_t)(t + 2) * kstep;
            const char* a3 = a2 + kstep; const char* b3 = b2 + kstep;
            PG8_LDB(B0, 0, 0); PG8_LDB(B1, 0, 1); PG8_SCHED; PG8_LDA(At, 0, 0); PG8_STAGE(PG8_SA(1, 1), a1 + hstepA, voffA);
            PG8_WAIT_V(8); PG8_WAIT_L(0); PG8_BAR; PG8_MMA(0, 0, At, B0); PG8_MMA(0, 1, At, B1); PG8_BAR; PG8_SCHED;
            PG8_LDA(At, 0, 1); PG8_STAGE(PG8_SB(0, 0), b2, voffB); PG8_STAGE(PG8_SB(0, 1), b2 + hstepB, voffB); PG8_STAGE(PG8_SA(0, 0), a2, voffA);
            PG8_WAIT_V(8); PG8_WAIT_L(0); PG8_BAR; PG8_MMA(1, 0, At, B0); PG8_MMA(1, 1, At, B1); PG8_BAR; PG8_SCHED;
            PG8_LDB(B0, 1, 0); PG8_LDB(B1, 1, 1); PG8_SCHED; PG8_LDA(At, 1, 0); PG8_STAGE(PG8_SA(0, 1), a2 + hstepA, voffA);
            PG8_WAIT_V(8); PG8_WAIT_L(0); PG8_BAR; PG8_MMA(0, 0, At, B0); PG8_MMA(0, 1, At, B1); PG8_BAR; PG8_SCHED;
            PG8_LDA(At, 1, 1); PG8_STAGE(PG8_SB(1, 0), b3, voffB); PG8_STAGE(PG8_SB(1, 1), b3 + hstepB, voffB); PG8_STAGE(PG8_SA(1, 0), a3, voffA);
            PG8_WAIT_V(8); PG8_WAIT_L(0); PG8_BAR; PG8_MMA(1, 0, At, B0); PG8_MMA(1, 1, At, B1); PG8_BAR; PG8_SCHED;
        }
        if constexpr (ALIGN_EPI) { if (wr == 0) PG8_BAR; }
        { const int l2_ = lane_id(); int fr_ = l2_ & 15, fq_ = l2_ >> 4, wr_ = wr, wc_ = wc; asm volatile("" : "+v"(fr_), "+v"(fq_), "+s"(wr_), "+s"(wc_)); E(acc, cur, ui, wr_, wc_, fr_, fq_); }
        if (!has_next) break;
#pragma unroll
        for (int a = 0; a < 2; ++a)
#pragma unroll
            for (int b = 0; b < 2; ++b)
#pragma unroll
                for (int m = 0; m < 4; ++m)
#pragma unroll
                    for (int n = 0; n < 2; ++n) acc[a][b][m][n] = zero4();
        cur = nxt; cA = nA; cB = nB; ++ui;
        if constexpr (ALIGN_EPI) { if (wr == 1) PG8_BAR; }
    }
    PG8_WAIT_V(0);
    if constexpr (!ALIGN_EPI) { if (wr == 0) PG8_BAR; }
    PG8_BAR;
#undef PG8_SA
#undef PG8_SB
#undef PG8_STAGE
#undef PG8_LDA
#undef PG8_LDB
#undef PG8_MMA
#undef PG8_WAIT_V
#undef PG8_WAIT_L
#undef PG8_BAR
#undef PG8_SCHED
}
}
using pg8::Unit; using pg8::Gemm; using pg8::StaticOrder; using pg8::PPOrder; using pg8::gemm_phase;
typedef const f32x4 (&AccRef)[2][2][4][2];

template <bool LNRES> struct EpiResT {
    static constexpr bool PERM = true; static constexpr bool ROWPERM = false;
    const h16* res; h16* out; const float* stat; const float* gain; const float* bias;
    DI size_t a_off(const Unit&) const { return 0; }
    DI void pre(LAS unsigned char*, const Unit&, int, int) const {}
    DI void operator()(AccRef acc, const Unit& u, int ui, int wr, int wc, int fr, int fq) const {
        const int row0 = u.pm * 256 + wr * 64 + fr, col0 = u.pn * 256 + wc * 32 + 8 * fq;
        if constexpr (!LNRES) {
            h16x8 q8[2][4][2];
#pragma unroll
            for (int ai = 0; ai < 2; ++ai)
#pragma unroll
                for (int m = 0; m < 4; ++m)
#pragma unroll
                    for (int bj = 0; bj < 2; ++bj) q8[ai][m][bj] = *(const h16x8*)(res + (size_t)(row0 + ai * 128 + m * 16) * D + col0 + bj * 128);
#pragma unroll
            for (int ai = 0; ai < 2; ++ai)
#pragma unroll
                for (int m = 0; m < 4; ++m)
#pragma unroll
                    for (int bj = 0; bj < 2; ++bj) { f32x4 a, b;
#pragma unroll
                        for (int j = 0; j < 4; ++j) { a[j] = (float)q8[ai][m][bj][j] * ALPHA + acc[ai][bj][m][0][j]; b[j] = (float)q8[ai][m][bj][4 + j] * ALPHA + acc[ai][bj][m][1][j]; }
                        *(u32x4*)(out + (size_t)(row0 + ai * 128 + m * 16) * D + col0 + bj * 128) = pk8(a, b); }
            return;
        }
        f32x4 ga[2][2], ba[2][2];
        if constexpr (LNRES) {
#pragma unroll
            for (int bj = 0; bj < 2; ++bj) { ga[bj][0] = *(const f32x4*)(gain + col0 + bj * 128); ga[bj][1] = *(const f32x4*)(gain + col0 + bj * 128 + 4); ba[bj][0] = *(const f32x4*)(bias + col0 + bj * 128); ba[bj][1] = *(const f32x4*)(bias + col0 + bj * 128 + 4); } }
#pragma unroll
        for (int ai = 0; ai < 2; ++ai) {
            h16x8 r8[4][2]; f32x2 st[4];
#pragma unroll
            for (int m = 0; m < 4; ++m) { if constexpr (LNRES) st[m] = *(const f32x2*)(stat + 2 * (row0 + ai * 128 + m * 16));
#pragma unroll
                for (int bj = 0; bj < 2; ++bj) r8[m][bj] = *(const h16x8*)(res + (size_t)(row0 + ai * 128 + m * 16) * D + col0 + bj * 128); }
#pragma unroll
            for (int m = 0; m < 4; ++m)
#pragma unroll
                for (int bj = 0; bj < 2; ++bj) { f32x4 a, b;
#pragma unroll
                    for (int j = 0; j < 4; ++j) { float ra = (float)r8[m][bj][j], rb = (float)r8[m][bj][4 + j];
                        if constexpr (LNRES) { ra = (ra - st[m][0]) * st[m][1] * ga[bj][0][j] + ba[bj][0][j]; rb = (rb - st[m][0]) * st[m][1] * ga[bj][1][j] + ba[bj][1][j]; }
                        a[j] = ra * ALPHA + acc[ai][bj][m][0][j]; b[j] = rb * ALPHA + acc[ai][bj][m][1][j]; }
                    *(u32x4*)(out + (size_t)(row0 + ai * 128 + m * 16) * D + col0 + bj * 128) = pk8(a, b); }
        }
    }
};
using EpiRes = EpiResT<false>;
struct EpiH16 {
    static constexpr bool PERM = true; static constexpr bool ROWPERM = false;
    h16* O; int ldc; int scale_cols; float scale;
    DI size_t a_off(const Unit&) const { return 0; }
    DI void pre(LAS unsigned char*, const Unit&, int, int) const {}
    DI void operator()(AccRef acc, const Unit& u, int ui, int wr, int wc, int fr, int fq) const {
        const int row0 = u.pm * 256 + wr * 64 + fr, col0 = u.pn * 256 + wc * 32 + 8 * fq;
        const float s = (u.pn * 256 < scale_cols) ? scale : 1.0f;
#pragma unroll
        for (int ai = 0; ai < 2; ++ai)
#pragma unroll
            for (int m = 0; m < 4; ++m) { h16* rowp = O + (size_t)(row0 + ai * 128 + m * 16) * ldc + col0;
#pragma unroll
                for (int bj = 0; bj < 2; ++bj) *(u32x4*)(rowp + bj * 128) = pk8(acc[ai][bj][m][0] * s, acc[ai][bj][m][1] * s); }
    }
};
struct EpiRetA {
    static constexpr bool PERM = true; static constexpr bool ROWPERM = false;
    h16 *Q, *Kb, *SG; const float *cosT, *sinT; h16* KT;
    DI size_t a_off(const Unit&) const { return 0; }
    DI void pre(LAS unsigned char*, const Unit&, int, int) const {}
    DI void operator()(AccRef acc, const Unit& u, int ui, int wr, int wc, int fr, int fq) const {
        const int row0 = u.pm * 256 + wr * 64 + fr, cb = wc * 32 + 8 * fq;
        if (u.pn < 16) {
            h16* dst = (u.pn < 8 ? Q : Kb) + (u.pn & 7) * 256 + cb; const float sc = u.pn < 8 ? 1.0f : 0.0625f;
#pragma unroll
            for (int ai = 0; ai < 2; ++ai) {
                f32x4 tc0[4], tc1[4], ts0[4], ts1[4];
#pragma unroll
                for (int m = 0; m < 4; ++m) { const int pos = (row0 + ai * 128 + m * 16) & (SEQ - 1);
                    tc0[m] = *(const f32x4*)(cosT + pos * 128 + cb); tc1[m] = *(const f32x4*)(cosT + pos * 128 + cb + 4); ts0[m] = *(const f32x4*)(sinT + pos * 128 + cb); ts1[m] = *(const f32x4*)(sinT + pos * 128 + cb + 4); }
#pragma unroll
                for (int m = 0; m < 4; ++m) { const int row = row0 + ai * 128 + m * 16, pos = row & (SEQ - 1);
                    const f32x4 c0 = tc0[m], c1 = tc1[m], s0 = ts0[m], s1 = ts1[m];
                    const f32x4 x1a = acc[ai][0][m][0], x1b = acc[ai][0][m][1], x2a = acc[ai][1][m][0], x2b = acc[ai][1][m][1];
                    const f32x4 o1a = (x1a * c0 - x2a * s0) * sc, o1b = (x1b * c1 - x2b * s1) * sc, o2a = (x1a * s0 + x2a * c0) * sc, o2b = (x1b * s1 + x2b * c1) * sc;
                    *(u32x4*)(dst + (size_t)row * D) = pk8(o1a, o1b);
                    *(u32x4*)(dst + (size_t)row * D + 128) = pk8(o2a, o2b);
                    if (u.pn >= 8) {
                        const float f = __builtin_amdgcn_exp2f((float)(127 - (pos & 127)) * log2gamma(u.pn & 7));
                        h16* kt = KT + (size_t)((u.pn & 7) * 256 + cb) * M + row;
#pragma unroll
                        for (int j = 0; j < 4; ++j) { kt[(size_t)j * M] = (h16)(o1a[j] * f); kt[(size_t)(4 + j) * M] = (h16)(o1b[j] * f); kt[(size_t)(128 + j) * M] = (h16)(o2a[j] * f); kt[(size_t)(132 + j) * M] = (h16)(o2b[j] * f); }
                    } }
            }
        } else {
            h16* dst = SG + (u.pn - 16) * 256 + cb;
#pragma unroll
            for (int ai = 0; ai < 2; ++ai)
#pragma unroll
                for (int m = 0; m < 4; ++m) { const int row = row0 + ai * 128 + m * 16;
#pragma unroll
                    for (int bj = 0; bj < 2; ++bj) { f32x4 a = acc[ai][bj][m][0], b = acc[ai][bj][m][1];
#pragma unroll
                        for (int j = 0; j < 4; ++j) { a[j] = a[j] * sigmoidf_(a[j]); b[j] = b[j] * sigmoidf_(b[j]); }
                        *(u32x4*)(dst + (size_t)row * 4096 + bj * 128) = pk8(a, b); } }
        }
    }
};
struct EpiRetB {
    static constexpr bool PERM = true; static constexpr bool ROWPERM = false;
    h16* VT;
    DI size_t a_off(const Unit&) const { return 0; }
    DI void pre(LAS unsigned char*, const Unit&, int, int) const {}
    DI void operator()(AccRef acc, const Unit& u, int ui, int wr, int wc, int fr, int fq) const {
        const int tokb = u.pn * 256 + wc * 32 + 8 * fq;
#pragma unroll
        for (int ai = 0; ai < 2; ++ai)
#pragma unroll
            for (int m = 0; m < 4; ++m) { const int f = u.pm * 256 + ai * 128 + wr * 64 + m * 16 + fr;
#pragma unroll
                for (int bj = 0; bj < 2; ++bj) *(u32x4*)(VT + (size_t)f * M + tokb + bj * 128) = pk8(acc[ai][bj][m][0], acc[ai][bj][m][1]); }
    }
};
struct EpiRw1 {
    static constexpr bool PERM = true; static constexpr bool ROWPERM = false;
    h16 *RKV, *MID;
    DI size_t a_off(const Unit& u) const { return (size_t)(u.pn < 24 ? u.pn >> 3 : u.pn - 21) * ((size_t)M * D * 2); }
    DI void pre(LAS unsigned char*, const Unit&, int, int) const {}
    DI void operator()(AccRef acc, const Unit& u, int ui, int wr, int wc, int fr, int fq) const {
        const int row0 = u.pm * 256 + wr * 64 + fr, cb = wc * 32 + 8 * fq;
        if (u.pn < 24) {
            h16* dst = RKV + (size_t)(u.pn >> 3) * ((size_t)M * D) + (u.pn & 7) * 256 + cb;
#pragma unroll
            for (int ai = 0; ai < 2; ++ai)
#pragma unroll
                for (int m = 0; m < 4; ++m)
#pragma unroll
                    for (int bj = 0; bj < 2; ++bj) *(u32x4*)(dst + (size_t)(row0 + ai * 128 + m * 16) * D + bj * 128) = pk8(acc[ai][bj][m][0], acc[ai][bj][m][1]);
        } else {
            const int t = u.pn - 24; h16* dst = MID + (size_t)t * ((size_t)M * 256) + cb;
#pragma unroll
            for (int ai = 0; ai < 2; ++ai)
#pragma unroll
                for (int m = 0; m < 4; ++m)
#pragma unroll
                    for (int bj = 0; bj < 2; ++bj) { f32x4 a = acc[ai][bj][m][0], b = acc[ai][bj][m][1];
#pragma unroll
                        for (int j = 0; j < 4; ++j) { if (t == 0) { a[j] = 1.0f - 2.0f * __builtin_amdgcn_rcpf(1.0f + __expf(2.0f * a[j])); b[j] = 1.0f - 2.0f * __builtin_amdgcn_rcpf(1.0f + __expf(2.0f * b[j])); }     else if (t == 2) { a[j] = sigmoidf_(a[j]); b[j] = sigmoidf_(b[j]); } }
                        *(u32x4*)(dst + (size_t)(row0 + ai * 128 + m * 16) * 256 + bj * 128) = pkb8(a, b); }
        }
    }
};
DI float decay_of(float z) { return __expf(-0.6065306597126334f * sigmoidf_(z)); }
struct EpiRw2 {
    static constexpr bool PERM = true; static constexpr bool ROWPERM = false;
    h16* WAG; const float *w0, *a0;
    DI size_t a_off(const Unit& u) const { return (size_t)(u.pn >> 3) * ((size_t)M * 256 * 2); }
    DI void pre(LAS unsigned char*, const Unit&, int, int) const {}
    template <int T> DI void body(AccRef acc, h16* dst, const float* bias, int row0) const {
#pragma unroll
        for (int bj = 0; bj < 2; ++bj) { f32x4 ba, bb;
            if (T != 2) { ba = *(const f32x4*)(bias + bj * 128); bb = *(const f32x4*)(bias + bj * 128 + 4); }
#pragma unroll
            for (int ai = 0; ai < 2; ++ai)
#pragma unroll
                for (int m = 0; m < 4; ++m) { f32x4 a = acc[ai][bj][m][0], b = acc[ai][bj][m][1]; if (T != 2) { a = a + ba; b = b + bb; }
#pragma unroll
                    for (int j = 0; j < 4; ++j) { if (T == 0) { a[j] = decay_of(a[j]); b[j] = decay_of(b[j]); } else if (T == 1) { a[j] = sigmoidf_(a[j]); b[j] = sigmoidf_(b[j]); } }
                    *(u32x4*)(dst + (size_t)(row0 + ai * 128 + m * 16) * D + bj * 128) = pk8(a, b); } }
    }
    DI void operator()(AccRef acc, const Unit& u, int ui, int wr, int wc, int fr, int fq) const {
        const int row0 = u.pm * 256 + wr * 64 + fr, t = u.pn >> 3, colb = (u.pn & 7) * 256 + wc * 32 + 8 * fq;
        h16* dst = WAG + (size_t)t * ((size_t)M * D) + colb;
        if (t == 0) body<0>(acc, dst, w0 + colb, row0);
        else if (t == 1) body<1>(acc, dst, a0 + colb, row0);
        else body<2>(acc, dst, w0, row0);
    }
};
struct EpiPle {
    static constexpr bool PERM = true; static constexpr bool ROWPERM = false;
    const h16* x2; const h16* pp; float* outf; h16* xh; h16* xb; const float* stat; const float* gain; const float* bias; LAS unsigned char* lds_;
    DI size_t a_off(const Unit&) const { return 0; }
    DI void pre(LAS unsigned char* lds, const Unit& u, int ui, int wid) const {
        if (wid < 2) { const int lane = lane_id(); const float* src = (wid == 0 ? gain : bias) + u.pn * 256 + lane * 4;
            __builtin_amdgcn_global_load_lds((const unsigned*)src, (LAS unsigned*)(lds + 139264 + (ui & 1) * 4096 + wid * 1024), 16, 0, 0); }
    }
    DI void operator()(AccRef acc, const Unit& u, int ui, int wr, int wc, int fr, int fq) const {
        const int row0 = u.pm * 256 + wr * 64 + fr, col0 = u.pn * 256 + wc * 32 + 8 * fq;
        const LAS float* gl = (const LAS float*)(lds_ + 139264 + (ui & 1) * 4096) + wc * 32 + 8 * fq;
#pragma unroll
        for (int ai = 0; ai < 2; ++ai)
#pragma unroll
            for (int mh = 0; mh < 2; ++mh) {
                h16x8 x8[2][2], p8[2][2]; f32x2 st[2];
#pragma unroll
                for (int mm = 0; mm < 2; ++mm) { const int m = 2 * mh + mm; st[mm] = *(const f32x2*)(stat + 2 * (row0 + ai * 128 + m * 16));
#pragma unroll
                    for (int bj = 0; bj < 2; ++bj) { const size_t o = (size_t)(row0 + ai * 128 + m * 16) * D + col0 + bj * 128; x8[mm][bj] = *(const h16x8*)(x2 + o); p8[mm][bj] = *(const h16x8*)(pp + o); } }
#pragma unroll
                for (int mm = 0; mm < 2; ++mm)
#pragma unroll
                    for (int bj = 0; bj < 2; ++bj) { const int m = 2 * mh + mm; const size_t o = (size_t)(row0 + ai * 128 + m * 16) * D + col0 + bj * 128; f32x4 a, b;
                        const f32x4 g0 = *(const LAS f32x4*)(gl + bj * 128), g1 = *(const LAS f32x4*)(gl + bj * 128 + 4), b0 = *(const LAS f32x4*)(gl + 256 + bj * 128), b1 = *(const LAS f32x4*)(gl + 256 + bj * 128 + 4);
#pragma unroll
                        for (int j = 0; j < 4; ++j) { const float xa = ((float)x8[mm][bj][j] - st[mm][0]) * st[mm][1] * g0[j] + b0[j], xc = ((float)x8[mm][bj][4 + j] - st[mm][0]) * st[mm][1] * g1[j] + b1[j];
                            a[j] = xa + (float)p8[mm][bj][j] * sigmoidf_(acc[ai][bj][m][0][j]); b[j] = xc + (float)p8[mm][bj][4 + j] * sigmoidf_(acc[ai][bj][m][1][j]); }
                        if (xh) { *(u32x4*)(xh + o) = pk8(a, b); if (xb) *(u32x4*)(xb + o) = pkb8(a, b); } else { *(f32x4*)(outf + o) = a; *(f32x4*)(outf + o + 4) = b; } }
            }
    }
};
DI float row_shr1f(float old, float x) { return __builtin_bit_cast(float, __builtin_amdgcn_update_dpp(__builtin_bit_cast(int, old), __builtin_bit_cast(int, x), 0x111, 0xF, 0xF, false)); }
DI f32x4 row_shr1(f32x4 old, f32x4 v) {
    const float o0 = old[0], o1 = old[1], o2 = old[2], o3 = old[3], a0 = v[0], a1 = v[1], a2 = v[2], a3 = v[3];
    return (f32x4){row_shr1f(o0, a0), row_shr1f(o1, a1), row_shr1f(o2, a2), row_shr1f(o3, a3)}; }
constexpr int EU_WOFF = 139264;
template <bool TRIV> struct EpiUpT {
    static constexpr bool PERM = true; static constexpr bool ROWPERM = true;
    h16* ACT; float* HL; const float* cw; const float* cb; LAS float* hl;
    DI size_t a_off(const Unit&) const { return 0; }
    DI void pre(LAS unsigned char* lds, const Unit& u, int ui, int wid) const {
        if (wid < 4) { const int lane = lane_id(); const float* src = (wid < 3 ? cw + (size_t)wid * DFF2 : cb) + u.pn * 128 + (lane < 32 ? lane * 4 : DFF + (lane - 32) * 4);
            __builtin_amdgcn_global_load_lds((const unsigned*)src, (LAS unsigned*)(lds + EU_WOFF + (ui & 1) * 4096 + wid * 1024), 16, 0, 0); }
    }
    DI void operator()(AccRef acc, const Unit& u, int ui, int wr, int wc, int fr, int fq) const {
        const int cbase = wc * 32 + 8 * fq;
        if constexpr (TRIV) {
#pragma unroll
            for (int n = 0; n < 2; ++n) { const int cu = u.pn * 128 + cbase + 4 * n;
#pragma unroll
                for (int ai = 0; ai < 2; ++ai)
#pragma unroll
                    for (int m = 0; m < 4; ++m) *(u32x2*)(ACT + (size_t)(u.pm * 256 + ai * 128 + wr * 64 + m * 16 + fr) * DFF + cu) = pkb4(acc[ai][0][m][n] * acc[ai][1][m][n]); }
            return;
        }
        if (fr == 15) {
#pragma unroll
            for (int ai = 0; ai < 2; ++ai)
#pragma unroll
                for (int bj = 0; bj < 2; ++bj)
#pragma unroll
                    for (int n = 0; n < 2; ++n) { LAS float* hp = hl + ((2 * ai + wr) * 2) * 256 + bj * 128 + cbase + 4 * n; *(LAS f32x4*)hp = acc[ai][bj][2][n]; *(LAS f32x4*)(hp + 256) = acc[ai][bj][3][n]; }
            if (wr == 1) {
#pragma unroll
                for (int bj = 0; bj < 2; ++bj)
#pragma unroll
                    for (int n = 0; n < 2; ++n) { float* gp = HL + (size_t)(u.pm * 4) * DFF2 + u.pn * 256 + bj * 128 + cbase + 4 * n; *(f32x4*)gp = acc[1][bj][2][n]; *(f32x4*)(gp + DFF2) = acc[1][bj][3][n]; }
            }
        }
        if (fr == 0 && wr == 0) {
#pragma unroll
            for (int bj = 0; bj < 2; ++bj)
#pragma unroll
                for (int n = 0; n < 2; ++n) { float* gp = HL + (size_t)(u.pm * 4 + 2) * DFF2 + u.pn * 256 + bj * 128 + cbase + 4 * n; *(f32x4*)gp = acc[0][bj][0][n]; *(f32x4*)(gp + DFF2) = acc[0][bj][1][n]; }
        }
        asm volatile("s_waitcnt lgkmcnt(0)" ::: "memory"); __builtin_amdgcn_s_barrier(); asm volatile("" ::: "memory");
        const LAS unsigned char* lds_ = (const LAS unsigned char*)hl - 131072;
#pragma unroll
        for (int ai = 0; ai < 2; ++ai) {
            const int blk = 2 * ai + wr;
            h16* arow = ACT + (size_t)(u.pm * 256 + ai * 128 + wr * 64 + 4 * fr) * DFF + u.pn * 128 + cbase;
            u32x2 P0[4];
#pragma unroll
            for (int n = 0; n < 2; ++n) {
                const LAS float* wl = (const LAS float*)(lds_ + EU_WOFF + (ui & 1) * 4096) + cbase + 4 * n;
                const LAS float* hp = hl + ((blk - 1) * 2) * 256 + cbase + 4 * n;
                f32x4 hu[4];
                {   const f32x4 w0 = *(const LAS f32x4*)wl, w1 = *(const LAS f32x4*)(wl + 256), w2 = *(const LAS f32x4*)(wl + 512), bb = *(const LAS f32x4*)(wl + 768);
                    f32x4 H1 = zero4(), H2 = zero4();
                    if (blk > 0) { H2 = *(const LAS f32x4*)hp; H1 = *(const LAS f32x4*)(hp + 256); }
                    const f32x4 c0 = acc[ai][0][0][n], c1 = acc[ai][0][1][n], c2 = acc[ai][0][2][n], c3 = acc[ai][0][3][n];
                    const f32x4 S3 = row_shr1(H1, c3), S2 = row_shr1(H2, c2);
                    hu[0] = bb + w2 * c0 + w1 * S3 + w0 * S2; hu[1] = bb + w2 * c1 + w1 * c0 + w0 * S3; hu[2] = bb + w2 * c2 + w1 * c1 + w0 * c0; hu[3] = bb + w2 * c3 + w1 * c2 + w0 * c1; }
                {   const f32x4 w0 = *(const LAS f32x4*)(wl + 128), w1 = *(const LAS f32x4*)(wl + 384), w2 = *(const LAS f32x4*)(wl + 640), bb = *(const LAS f32x4*)(wl + 896);
                    f32x4 H1 = zero4(), H2 = zero4();
                    if (blk > 0) { H2 = *(const LAS f32x4*)(hp + 128); H1 = *(const LAS f32x4*)(hp + 256 + 128); }
                    const f32x4 c0 = acc[ai][1][0][n], c1 = acc[ai][1][1][n], c2 = acc[ai][1][2][n], c3 = acc[ai][1][3][n];
                    const f32x4 S3 = row_shr1(H1, c3), S2 = row_shr1(H2, c2);
                    f32x4 hg[4];
                    hg[0] = bb + w2 * c0 + w1 * S3 + w0 * S2; hg[1] = bb + w2 * c1 + w1 * c0 + w0 * S3; hg[2] = bb + w2 * c2 + w1 * c1 + w0 * c0; hg[3] = bb + w2 * c3 + w1 * c2 + w0 * c1;
#pragma unroll
                    for (int m = 0; m < 4; ++m) { f32x4 o;
#pragma unroll
                        for (int j = 0; j < 4; ++j) o[j] = hg[m][j] * sigmoidf_(hg[m][j]) * hu[m][j];
                        const u32x2 pk_ = pkb4(o); if (n == 0) P0[m] = pk_; else *(u32x4*)(arow + (size_t)m * DFF) = (u32x4){P0[m].x, P0[m].y, pk_.x, pk_.y}; } }
            }
        }
    }
};
using EpiUp = EpiUpT<false>;
DI void ffn_fixup(const float* HL, const float* cw, const float* cb, h16* ACT, int gtid, int NT) {
    for (int i = gtid; i < 64 * 2 * (DFF / 4); i += NT) { const int q = i % (DFF / 4), r = (i / (DFF / 4)) & 1, pm = i / (2 * (DFF / 4));
        if ((pm & 31) == 0) continue;
        const int c = 4 * q, hc = 256 * (c >> 7) + (c & 127);
        const float* cur = HL + (size_t)(pm * 4 + 2 + r) * DFF2 + hc; const float* m1 = r ? HL + (size_t)(pm * 4 + 2) * DFF2 + hc : HL + (size_t)((pm - 1) * 4 + 1) * DFF2 + hc;
        const float* m2 = r ? HL + (size_t)((pm - 1) * 4 + 1) * DFF2 + hc : HL + (size_t)((pm - 1) * 4) * DFF2 + hc;
        const f32x4 hu = *(const f32x4*)(cb + c) + *(const f32x4*)(cw + 2 * DFF2 + c) * *(const f32x4*)cur + *(const f32x4*)(cw + DFF2 + c) * *(const f32x4*)m1 + *(const f32x4*)(cw + c) * *(const f32x4*)m2;
        const int g = DFF + c;
        const f32x4 hg = *(const f32x4*)(cb + g) + *(const f32x4*)(cw + 2 * DFF2 + g) * *(const f32x4*)(cur + 128) + *(const f32x4*)(cw + DFF2 + g) * *(const f32x4*)(m1 + 128) + *(const f32x4*)(cw + g) * *(const f32x4*)(m2 + 128);
        f32x4 o;
#pragma unroll
        for (int j = 0; j < 4; ++j) o[j] = hg[j] * sigmoidf_(hg[j]) * hu[j];
        *(u32x2*)(ACT + (size_t)(pm * 256 + r) * DFF + c) = pkb4(o); }
}

#define XB_TMO      128
#define XB_XCNT(j)  (256  + 64 * (j))
#define XB_XSUB(j)  (1280 + 64 * (j))
#define XB_XGEN(j)  (2304 + 64 * (j))
#define XB_TOP      3328
#define XB_TOPGEN   3392
#define XCD_BAR_WORDS 3456
#define XB_SPIN_CAP (1u << 18)
__device__ __forceinline__ unsigned xb_ld(unsigned* p)              { return __hip_atomic_load(p, __ATOMIC_RELAXED, __HIP_MEMORY_SCOPE_AGENT); }
__device__ __forceinline__ unsigned xb_add(unsigned* p, unsigned v) { return __hip_atomic_fetch_add(p, v, __ATOMIC_RELAXED, __HIP_MEMORY_SCOPE_AGENT); }
__device__ __forceinline__ unsigned xb_xcc_id() { return (unsigned)__builtin_amdgcn_s_getreg((3 << 11) | 20) & 0xFu; }
#define XB_SPIN(cond, bar) do { unsigned _sp = 0; while (cond) { __builtin_amdgcn_s_sleep(1); \
    if ((++_sp & 255u) == 0u) { if (xb_ld(&(bar)[XB_TMO])) break; if (_sp > XB_SPIN_CAP) { atomicAdd(&(bar)[XB_TMO], 1u); break; } } } } while (0)
struct XcdBarrier { unsigned* bar; unsigned x; volatile LAS unsigned* st; };
__device__ __forceinline__ XcdBarrier xcd_barrier_post(unsigned* bar, volatile LAS unsigned* st) {
    XcdBarrier b; b.bar = bar; b.x = xb_xcc_id(); b.st = st;
    if (threadIdx.x == 0) (void)xb_add(&bar[XB_XCNT(b.x)], 1u);
    return b;
}
__device__ __forceinline__ void xcd_barrier_complete(unsigned* bar, unsigned x, unsigned& nloc, unsigned& nx) {
    const unsigned G = gridDim.x * gridDim.y * gridDim.z;
    unsigned sum, cnt, mine, sp = 0u;
    for (;;) {
        sum = 0u; cnt = 0u; mine = 0u;
#pragma unroll
        for (unsigned j = 0; j < 16; ++j) { const unsigned c = xb_ld(&bar[XB_XCNT(j)]); sum += c; cnt += (c > 0u) ? 1u : 0u; mine = (j == x) ? c : mine; }
        if (sum == G) break;
        __builtin_amdgcn_s_sleep(1);
        if ((++sp & 255u) == 0u) { if (xb_ld(&bar[XB_TMO])) break; if (sp > XB_SPIN_CAP) { atomicAdd(&bar[XB_TMO], 1u); break; } }
    }
    nloc = mine > 0u ? mine : 1u; nx = cnt > 0u ? cnt : 1u;
}
__device__ __forceinline__ void xcd_barrier(const XcdBarrier& b, int wave0) {
    asm volatile("s_waitcnt vmcnt(0)" ::: "memory");
    __syncthreads();
    if (wave0 == 0 && lane_id() == 0) {
        unsigned* bar = b.bar;
        __builtin_amdgcn_s_waitcnt(0);
        unsigned nloc = b.st[0], nx = b.st[1];
        if (nloc == 0u) { xcd_barrier_complete(bar, b.x, nloc, nx); b.st[0] = nloc; b.st[1] = nx; }
        const unsigned old = xb_add(&bar[XB_XSUB(b.x)], 1u);
        const unsigned gen = old / nloc;
        if (old + 1u == (gen + 1u) * nloc) {
            __builtin_amdgcn_fence(__ATOMIC_RELEASE, "agent");
            asm volatile("s_waitcnt vmcnt(0)" ::: "memory");
            const unsigned og = xb_add(&bar[XB_TOP], 1u);
            const unsigned tg = og / nx;
            if (og + 1u == (tg + 1u) * nx) xb_add(&bar[XB_TOPGEN], 1u);
            else XB_SPIN(xb_ld(&bar[XB_TOPGEN]) == tg, bar);
            __builtin_amdgcn_fence(__ATOMIC_ACQUIRE, "agent");
            xb_add(&bar[XB_XGEN(b.x)], 1u);
            asm volatile("s_waitcnt vmcnt(0)" ::: "memory");
        } else {
            XB_SPIN(xb_ld(&bar[XB_XGEN(b.x)]) == gen, bar);
            __builtin_amdgcn_fence(__ATOMIC_ACQUIRE, "agent");
            asm volatile("s_waitcnt vmcnt(0)" ::: "memory");
        }
    }
    __syncthreads();
}

__constant__ unsigned char T5_BUCKET[128] = {0, 1, 2, 3, 4, 5, 6, 7, 8, 9, 10, 11, 12, 13, 14, 15, 16, 16, 16, 17, 17, 18, 18, 18, 19, 19, 19, 20, 20, 20, 20, 21, 21, 21, 21, 22, 22, 22, 22, 22, 23, 23, 23, 23, 23, 23, 24, 24, 24, 24, 24, 24, 25, 25, 25, 25, 25, 25, 25, 26, 26, 26, 26, 26, 26, 26, 26, 27, 27, 27, 27, 27, 27, 27, 27, 27, 27, 28, 28, 28, 28, 28, 28, 28, 28, 28, 28, 29, 29, 29, 29, 29, 29, 29, 29, 29, 29, 29, 29, 30, 30, 30, 30, 30, 30, 30, 30, 30, 30, 30, 30, 30, 30, 31, 31, 31, 31, 31, 31, 31, 31, 31, 31, 31, 31, 31, 31, 31};

template <bool UPMAP = false>
DI void cvt_job(const float* W, int ldw, int K, int ncols, int col0, h16* WT, int ldt, int row0, LAS float* scr, int gw, int NGW, int lane) {
    const int nblk = ncols / 32, nitems = (K / 64) * nblk;
    for (int item = gw; item < nitems; item += NGW) {
        const int kb = item / nblk, nb = item % nblk, k0 = 64 * kb, n0 = 32 * nb;
        const int ns = UPMAP ? 32 * (((nb & 7) < 4) ? (nb >> 3) * 4 + (nb & 7) : 172 + (nb >> 3) * 4 + (nb & 7) - 4) : n0;
#pragma unroll 8
        for (int i = 0; i < 32; ++i) { const int kk = 2 * i + (lane >> 5); scr[kk * 33 + (lane & 31)] = W[(size_t)(k0 + kk) * ldw + col0 + ns + (lane & 31)]; }
        asm volatile("s_waitcnt lgkmcnt(0)" ::: "memory");
        const int c = lane & 7;
#pragma unroll
        for (int j = 0; j < 4; ++j) { const int n = (lane >> 3) + 8 * j; const LAS float* s = scr + (8 * c) * 33 + n;
            u32x4 o; o.x = pkb(s[0 * 33], s[1 * 33]); o.y = pkb(s[2 * 33], s[3 * 33]); o.z = pkb(s[4 * 33], s[5 * 33]); o.w = pkb(s[6 * 33], s[7 * 33]);
            *(u32x4*)(WT + (size_t)(row0 + n0 + n) * ldt + k0 + 8 * c) = o; }
        asm volatile("s_waitcnt lgkmcnt(0)" ::: "memory");
    }
}
DI void cvt_small(const float* W, int ldw, int Ksrc, int nrows, h16* WT, int ldt, int row0, int gtid, int NT) {
    for (int i = gtid; i < nrows * ldt; i += NT) { const int n = i / ldt, k = i % ldt; const unsigned pb_ = pkb(k < Ksrc ? W[(size_t)k * ldw + n] : 0.f, 0.f); ((unsigned short*)WT)[(size_t)(row0 + n) * ldt + k] = (unsigned short)pb_; }
}
DI void zero_rows(h16* WT, int ldt, int row0, int nrows, int gtid, int NT) {
    for (int i = gtid; i < nrows * ldt / 8; i += NT) *(u32x4*)(WT + (size_t)row0 * ldt + (size_t)i * 8) = __builtin_bit_cast(u32x4, zero4());
}
DI void cvt_flat(const float* src, h16* dsth, h16* dstb, size_t n, int gtid, int NT) {
    for (size_t i0 = (size_t)gtid * 8; i0 < n; i0 += (size_t)NT * 32) {
        f32x4 a[4], b[4];
#pragma unroll
        for (int u = 0; u < 4; ++u) { const size_t i = i0 + (size_t)u * NT * 8; if (i < n) { a[u] = *(const f32x4*)(src + i); b[u] = *(const f32x4*)(src + i + 4); } }
#pragma unroll
        for (int u = 0; u < 4; ++u) { const size_t i = i0 + (size_t)u * NT * 8; if (i < n) { if (dsth) *(u32x4*)(dsth + i) = pk8(a[u], b[u]); if (dstb) *(u32x4*)(dstb + i) = pkb8(a[u], b[u]); } } }
}
DI float dpp_rowsum16(float v) {
    v += __builtin_bit_cast(float, __builtin_amdgcn_update_dpp(0, __builtin_bit_cast(int, v), 0xB1, 0xF, 0xF, false));
    v += __builtin_bit_cast(float, __builtin_amdgcn_update_dpp(0, __builtin_bit_cast(int, v), 0x4E, 0xF, 0xF, false));
    v += __builtin_bit_cast(float, __builtin_amdgcn_update_dpp(0, __builtin_bit_cast(int, v), 0x141, 0xF, 0xF, false));
    v += __builtin_bit_cast(float, __builtin_amdgcn_update_dpp(0, __builtin_bit_cast(int, v), 0x140, 0xF, 0xF, false));
    return v;
}
DI float wave_sum_dpp(float v) { v = dpp_rowsum16(v); const int b = __builtin_bit_cast(int, v);
    return (__builtin_bit_cast(float, __builtin_amdgcn_readlane(b, 0)) + __builtin_bit_cast(float, __builtin_amdgcn_readlane(b, 16))) + (__builtin_bit_cast(float, __builtin_amdgcn_readlane(b, 32)) + __builtin_bit_cast(float, __builtin_amdgcn_readlane(b, 48))); }
constexpr int LNR = 8;
DI void ln_rows(const h16* src, const float* gain, const float* bias, h16* dsth, float* stat, h16* dstb, int gw, int NGW, int lane) {
    for (int m0 = LNR * gw; m0 < M; m0 += LNR * NGW) {
        h16x8 raw[LNR][4];
#pragma unroll
        for (int r = 0; r < LNR; ++r) { const h16x8* xr = (const h16x8*)(src + (size_t)(m0 + r) * D) + lane;
#pragma unroll
            for (int j = 0; j < 4; ++j) raw[r][j] = xr[64 * j]; }
#pragma unroll
        for (int r = 0; r < LNR; ++r) { float v[4][8]; float sm = 0.f;
#pragma unroll
            for (int j = 0; j < 4; ++j)
#pragma unroll
                for (int e = 0; e < 8; ++e) { v[j][e] = (float)raw[r][j][e]; sm += v[j][e]; }
            const float mean = wave_sum_dpp(sm) * (1.f / D); float s2 = 0.f;
#pragma unroll
            for (int j = 0; j < 4; ++j)
#pragma unroll
                for (int e = 0; e < 8; ++e) { v[j][e] -= mean; s2 += v[j][e] * v[j][e]; }
            const float rstd = 1.0f / sqrtf(wave_sum_dpp(s2) * (1.f / D) + LN_EPS);
            if (stat && lane == 0) *(f32x2*)(stat + 2 * (m0 + r)) = (f32x2){mean, rstd};
#pragma unroll
            for (int j = 0; j < 4; ++j) { const int c = 8 * lane + 512 * j; const f32x4 g0 = *(const f32x4*)(gain + c), g1 = *(const f32x4*)(gain + c + 4), b0 = *(const f32x4*)(bias + c), b1 = *(const f32x4*)(bias + c + 4); f32x4 o0, o1;
#pragma unroll
                for (int e = 0; e < 4; ++e) { o0[e] = v[j][e] * rstd * g0[e] + b0[e]; o1[e] = v[j][4 + e] * rstd * g1[e] + b1[e]; }
                if (dsth) *(u32x4*)(dsth + (size_t)(m0 + r) * D + c) = pk8(o0, o1); *(u32x4*)(dstb + (size_t)(m0 + r) * D + c) = pkb8(o0, o1); }
        }
    }
}

constexpr int RS_SLOT = 24576, RS_NS = 6, RS_D = 5;
DI void ret_scan(LAS unsigned char* lds, const h16* KT, const h16* VT, h16* RALL, int bid, int G, int wave, int lane) {
    for (int task = bid; task < 256; task += G) {
        const int bh = (task & 7) * 2 + (task >> 7), sub = (task >> 3) & 15, dkh = sub >> 3, dve = sub & 7, h = bh & 7, b = bh >> 3, r16 = lane & 15, q4 = lane >> 4;
        const float cd = __builtin_amdgcn_exp2f(128.0f * log2gamma(h));
        const int lrow = lane >> 3, lpc = lane & 7;
        __syncthreads();
#define RS_ISSUE(st_) do { const int step_ = (st_), slot_ = step_ % RS_NS; _Pragma("unroll") for (int ii_ = 0; ii_ < 3; ++ii_) { const int row = 8 * (3 * wave + ii_) + lrow, c = lpc ^ ((row >> 1) & 7); \
            const h16* g_ = (row < 128 ? KT + (size_t)(h * 256 + dkh * 128 + row) * M : VT + (size_t)(h * 512 + dve * 64 + (row - 128)) * M) + (size_t)b * SEQ + step_ * 64 + c * 8; \
            __builtin_amdgcn_global_load_lds((const unsigned*)g_, (LAS unsigned*)(lds + slot_ * RS_SLOT + (3 * wave + ii_) * 1024), 16, 0, 0); } } while (0)
        for (int i = 0; i < RS_D; ++i) RS_ISSUE(i);
        f32x4 acc[4];
#pragma unroll
        for (int c = 0; c < 4; ++c) acc[c] = zero4();
        for (int st = 0; st < 128; ++st) {
            asm volatile("s_waitcnt vmcnt(12)" ::: "memory");
            asm volatile("" ::: "memory"); __builtin_amdgcn_s_barrier(); asm volatile("" ::: "memory");
            RS_ISSUE(st + RS_D < 128 ? st + RS_D : 127);
            if ((st & 1) == 0) { h16* rdst = RALL + (((size_t)bh * 64 + (st >> 1)) * 512 + dve * 64) * 256 + dkh * 128 + wave * 16 + q4 * 4;
#pragma unroll
                for (int nt = 0; nt < 4; ++nt) { *(u32x2*)(rdst + (size_t)(nt * 16 + r16) * 256) = pk4(acc[nt]); acc[nt] = acc[nt] * cd; } }
            const LAS unsigned char* sl = lds + (st % RS_NS) * RS_SLOT;
#pragma unroll
            for (int ks = 0; ks < 2; ++ks) { const int ra = wave * 16 + r16, c = ks * 4 + q4;
                const h16x8 af = *(const LAS h16x8*)(sl + ra * 128 + ((c ^ ((ra >> 1) & 7)) << 4));
#pragma unroll
                for (int nt = 0; nt < 4; ++nt) { const int rb = 128 + nt * 16 + r16; const h16x8 bf = *(const LAS h16x8*)(sl + rb * 128 + ((c ^ ((rb >> 1) & 7)) << 4));
                    acc[nt] = __builtin_amdgcn_mfma_f32_16x16x32_f16(af, bf, acc[nt], 0, 0, 0); } }
        }
        asm volatile("s_waitcnt vmcnt(0)" ::: "memory");
#undef RS_ISSUE
    }
}

constexpr int R2_QP = 528, R2_PP = 272, R2_REG2 = 67584, R2_BCS = 16384, R2_NS = 5, R2_D = 4;
DI void ret_core(LAS unsigned char* lds, const h16* Qg, const h16* Kg, const h16* VT, const h16* RALL, const h16* SG, h16* OG, const float* gn, int bid, int G, int tid, int wave, int  ) {
    LAS float* ST1 = (LAS float*)(lds + R2_REG2); LAS float* ST2 = ST1 + 512;
    for (int unit = bid; unit < 1024; unit += G) {
        int fr, fq, wr, wc;
#define R2_FRESH do { asm volatile("" : "+v"(tid), "+s"(wave)); fr = tid & 15; fq = (tid >> 4) & 3; wr = wave >> 2; wc = wave & 3; } while (0)
        R2_FRESH;
        const int bh = unit >> 6, n = unit & 63, b = bh >> 3, h = bh & 7, tok0 = b * SEQ + n * 128;
        const float l2g = log2gamma(h);
        const h16* rsrc = RALL + ((size_t)bh * 64 + n) * 512 * 256;
#define R2_ISSUE(st_) do { const int step_ = (st_); _Pragma("unroll") for (int ii_ = 0; ii_ < 2; ++ii_) { const int row_ = 16 * (2 * wave + ii_) + ((tid & 63) >> 2), pc_ = (tid & 3) ^ ((row_ >> 2) & 3); \
            const h16* g_ = (step_ < 16) ? rsrc + (size_t)((step_ >> 3) * 256 + row_) * 256 + (step_ & 7) * 32 + pc_ * 8 : VT + (size_t)(h * 512 + ((step_ - 16) >> 2) * 256 + row_) * M + tok0 + ((step_ - 16) & 3) * 32 + pc_ * 8; \
            __builtin_amdgcn_global_load_lds((const unsigned*)g_, (LAS unsigned*)(lds + R2_REG2 + (step_ % R2_NS) * R2_BCS + (2 * wave + ii_) * 1024), 16, 0, 0); } } while (0)
#define R2_STEP(st_, ABASE, APITCH, KOFF, HH) do { \
            asm volatile("s_waitcnt vmcnt(6) lgkmcnt(0)" ::: "memory");                                     \
            asm volatile("" ::: "memory"); __builtin_amdgcn_s_barrier(); asm volatile("" ::: "memory");     \
            R2_FRESH; \
            h16x8 af_[4]; \
            _Pragma("unroll") for (int m = 0; m < 4; ++m) af_[m] = *(const LAS h16x8*)(lds + (ABASE) + (wr * 64 + m * 16 + fr) * (APITCH) + ((KOFF) + fq * 8) * 2); \
            _Pragma("unroll") for (int e = 0; e < 4; ++e) { const int rb_ = wc * 64 + e * 16 + fr; const h16x8 bfr_ = *(const LAS h16x8*)(lds + R2_REG2 + ((st_) % R2_NS) * R2_BCS + rb_ * 64 + ((fq ^ ((rb_ >> 2) & 3)) << 4)); \
                _Pragma("unroll") for (int m = 0; m < 4; ++m) acc[m][(HH) * 4 + e] = __builtin_amdgcn_mfma_f32_16x16x32_f16(bfr_, af_[m], acc[m][(HH) * 4 + e], 0, 0, 0); } } while (0)
        __syncthreads();
        {
            u32x4 tq[8];
#pragma unroll
            for (int it = 0; it < 8; ++it) { const int p = tid + 512 * it, row = p >> 5, c16 = p & 31; tq[it] = *(const u32x4*)(Qg + (size_t)(tok0 + row) * D + h * 256 + c16 * 8); }
#pragma unroll
            for (int it = 0; it < 8; ++it) { const int p = tid + 512 * it, row = p >> 5, c16 = p & 31; *(LAS u32x4*)(lds + row * R2_QP + c16 * 16) = tq[it]; }
        }
        asm volatile("s_waitcnt vmcnt(0) lgkmcnt(0)" ::: "memory");
#pragma unroll
        for (int i = 0; i < R2_D; ++i) R2_ISSUE(i);
        f32x4 acc[4][8];
#pragma unroll
        for (int m = 0; m < 4; ++m)
#pragma unroll
            for (int e = 0; e < 8; ++e) acc[m][e] = zero4();
#pragma unroll
        for (int st = 0; st < 16; ++st) {
            R2_STEP(st, 0, R2_QP, (st & 7) * 32, st >> 3);
            R2_ISSUE(st + R2_D < 16 ? st + R2_D : 15);
            if ((st & 7) == 7) {
#pragma unroll
                for (int m = 0; m < 4; ++m) { const float f = __builtin_amdgcn_exp2f((float)(wr * 64 + m * 16 + fr + 1) * l2g);
#pragma unroll
                    for (int e = 0; e < 4; ++e) acc[m][(st >> 3) * 4 + e] = acc[m][(st >> 3) * 4 + e] * f; }
            }
        }
        asm volatile("s_waitcnt vmcnt(0) lgkmcnt(0)" ::: "memory");
        asm volatile("" ::: "memory"); __builtin_amdgcn_s_barrier(); asm volatile("" ::: "memory");
        R2_FRESH;
        {
            u32x4 tk[8];
#pragma unroll
            for (int it = 0; it < 8; ++it) { const int p = tid + 512 * it, row = p >> 5, c16 = p & 31; tk[it] = *(const u32x4*)(Kg + (size_t)(tok0 + row) * D + h * 256 + c16 * 8); }
#pragma unroll
            for (int it = 0; it < 8; ++it) { const int p = tid + 512 * it, row = p >> 5, c16 = p & 31; *(LAS u32x4*)(lds + R2_REG2 + row * R2_QP + c16 * 16) = tk[it]; }
        }
        __syncthreads();
        R2_FRESH;
        {
            f32x4 sacc[4][2];
#pragma unroll
            for (int m = 0; m < 4; ++m) { sacc[m][0] = zero4(); sacc[m][1] = zero4(); }
#pragma unroll
            for (int ks = 0; ks < 8; ++ks) {
                h16x8 af[4];
#pragma unroll
                for (int m = 0; m < 4; ++m) af[m] = *(const LAS h16x8*)(lds + (wr * 64 + m * 16 + fr) * R2_QP + (ks * 32 + fq * 8) * 2);
#pragma unroll
                for (int n2 = 0; n2 < 2; ++n2) { const h16x8 bfr = *(const LAS h16x8*)(lds + R2_REG2 + (wc * 32 + n2 * 16 + fr) * R2_QP + (ks * 32 + fq * 8) * 2);
#pragma unroll
                    for (int m = 0; m < 4; ++m) sacc[m][n2] = __builtin_amdgcn_mfma_f32_16x16x32_f16(bfr, af[m], sacc[m][n2], 0, 0, 0); }
            }
            __syncthreads();
            R2_FRESH;
#pragma unroll
            for (int i = 0; i < R2_D; ++i) R2_ISSUE(16 + i);
#pragma unroll
            for (int m = 0; m < 4; ++m) { const int i = wr * 64 + m * 16 + fr;
#pragma unroll
                for (int n2 = 0; n2 < 2; ++n2) { const int j0 = wc * 32 + n2 * 16 + fq * 4; f32x4 pv;
#pragma unroll
                    for (int j = 0; j < 4; ++j) { const int dd = i - (j0 + j); pv[j] = dd >= 0 ? sacc[m][n2][j] * __builtin_amdgcn_exp2f((float)dd * l2g) : 0.f; }
                    *(LAS u32x2*)(lds + i * R2_PP + j0 * 2) = pk4(pv); } }
        }
#pragma unroll
        for (int st = 16; st < 24; ++st) {
            R2_STEP(st, 0, R2_PP, ((st - 16) & 3) * 32, (st - 16) >> 2);
            R2_ISSUE(st + R2_D < 24 ? st + R2_D : 23);
        }
        asm volatile("s_waitcnt vmcnt(0)" ::: "memory");
        __syncthreads();
        R2_FRESH;
        float mean[4], rstd[4];
#pragma unroll
        for (int m = 0; m < 4; ++m) { float sm = 0.f;
#pragma unroll
            for (int e = 0; e < 8; ++e) sm += (acc[m][e][0] + acc[m][e][1]) + (acc[m][e][2] + acc[m][e][3]);
            sm += shfl_xor_(sm, 16, tid & 63); sm += shfl_xor_(sm, 32, tid & 63);
            if (fq == 0) ST1[(wr * 64 + m * 16 + fr) * 4 + wc] = sm; }
        __syncthreads();
#pragma unroll
        for (int m = 0; m < 4; ++m) { const f32x4 t = *(const LAS f32x4*)(ST1 + (wr * 64 + m * 16 + fr) * 4); mean[m] = ((t[0] + t[1]) + (t[2] + t[3])) * (1.0f / 512.0f); float q = 0.f;
#pragma unroll
            for (int e = 0; e < 8; ++e) { const f32x4 d = acc[m][e] - mean[m]; q += (d[0] * d[0] + d[1] * d[1]) + (d[2] * d[2] + d[3] * d[3]); }
            q += shfl_xor_(q, 16, tid & 63); q += shfl_xor_(q, 32, tid & 63);
            if (fq == 0) ST2[(wr * 64 + m * 16 + fr) * 4 + wc] = q; }
        __syncthreads();
        R2_FRESH;
#pragma unroll
        for (int m = 0; m < 4; ++m) { const f32x4 t = *(const LAS f32x4*)(ST2 + (wr * 64 + m * 16 + fr) * 4); rstd[m] = 1.0f / sqrtf(((t[0] + t[1]) + (t[2] + t[3])) * (1.0f / 512.0f) + 1e-5f); }
#pragma unroll
        for (int m = 0; m < 4; ++m) { const size_t ro = (size_t)(tok0 + wr * 64 + m * 16 + fr) * 4096 + h * 512;
            f32x4 gg[8]; h16x4 s4[8];
#pragma unroll
            for (int e = 0; e < 8; ++e) { const int col = (e >> 2) * 256 + wc * 64 + (e & 3) * 16 + fq * 4; gg[e] = *(const f32x4*)(gn + h * 512 + col); s4[e] = *(const h16x4*)(SG + ro + col); }
#pragma unroll
            for (int e = 0; e < 8; ++e) { const int col = (e >> 2) * 256 + wc * 64 + (e & 3) * 16 + fq * 4; f32x4 o;
#pragma unroll
                for (int j = 0; j < 4; ++j) o[j] = (acc[m][e][j] - mean[m]) * rstd[m] * gg[e][j] * (float)s4[e][j];
                *(u32x2*)(OG + ro + col) = pkb4(o); } }
    }
#undef R2_FRESH
#undef R2_ISSUE
#undef R2_STEP
}

typedef float f32x16 __attribute__((ext_vector_type(16)));
constexpr int SW_KP = 144, SW_VP = 528, SW_VOFF = 36864, SW_BOFF = 36864 + 33792;
DI void swa_attn(LAS unsigned char* lds, const h16* QKV, const float* sinks, const float* relb, h16* O, int bid, int G, int tid, int wave, int lane) {
    for (int unit = bid; unit < 512; unit += G) {
        const int hkv = unit & 3, n = (unit >> 2) & 63, b = unit >> 8;
        const int tokq = b * SEQ + n * 128, tokk = tokq - 128, tmin = b * SEQ;
        __syncthreads();
#pragma unroll
        for (int it = 0; it < 4; ++it) { const int p = tid + 512 * it, row = p >> 3, c = p & 7; int tk = tokk + row; tk = tk < tmin ? tmin : tk;
            *(LAS u32x4*)(lds + row * SW_KP + c * 16) = *(const u32x4*)(QKV + (size_t)tk * 2560 + 2048 + hkv * 64 + c * 8); }
#pragma unroll
        for (int it = 0; it < 4; ++it) { const int p = tid + 512 * it, key = p & 255, c = p >> 8; int tk = tokk + key; tk = tk < tmin ? tmin : tk;
            const h16x8 v = *(const h16x8*)(QKV + (size_t)tk * 2560 + 2304 + hkv * 64 + c * 8);
#pragma unroll
            for (int j = 0; j < 8; ++j) *(LAS h16*)(lds + SW_VOFF + (c * 8 + j) * SW_VP + key * 2) = v[j]; }
        for (int idx = tid; idx < 1024; idx += NTHR) ((LAS float*)(lds + SW_BOFF))[idx] = relb[(int)T5_BUCKET[idx & 127] * 32 + hkv * 8 + (idx >> 7)];
        __syncthreads();
        const int hq = hkv * 8 + wave, r = lane & 31, h = lane >> 5;
        const float sink = sinks[hq];
        const LAS float* btab = (const LAS float*)(lds + SW_BOFF) + wave * 128;
        for (int qt = 0; qt < 4; ++qt) {
            h16x8 qf[4];
#pragma unroll
            for (int ks = 0; ks < 4; ++ks) qf[ks] = *(const h16x8*)(QKV + (size_t)(tokq + 32 * qt + r) * 2560 + hq * 64 + 16 * ks + 8 * h);
            f32x16 sc[5];
#pragma unroll
            for (int t5 = 0; t5 < 5; ++t5) {
#pragma unroll
                for (int i4 = 0; i4 < 4; ++i4) { const f32x4 z = zero4(); sc[t5][4 * i4] = z[0]; sc[t5][4 * i4 + 1] = z[1]; sc[t5][4 * i4 + 2] = z[2]; sc[t5][4 * i4 + 3] = z[3]; }
#pragma unroll
                for (int ks = 0; ks < 4; ++ks) { const h16x8 kf = *(const LAS h16x8*)(lds + (32 * (qt + t5) + r) * SW_KP + (16 * ks + 8 * h) * 2);
                    sc[t5] = __builtin_amdgcn_mfma_f32_32x32x16_f16(kf, qf[ks], sc[t5], 0, 0, 0); }
            }
            float mx = sink;
#pragma unroll
            for (int t5 = 0; t5 < 5; ++t5)
#pragma unroll
                for (int i = 0; i < 16; ++i) { const int key = 32 * (qt + t5) + (i & 3) + 8 * (i >> 2) + 4 * h, dist = 128 + 32 * qt + r - key;
                    const bool valid = dist >= 0 && dist < 128 && (n > 0 || key >= 128);
                    const float v = valid ? sc[t5][i] + btab[dist & 127] : -1e30f; sc[t5][i] = v; mx = fmaxf(mx, v); }
            mx = fmaxf(mx, shfl_xor_(mx, 32, lane));
            float sum = 0.f;
#pragma unroll
            for (int t5 = 0; t5 < 5; ++t5)
#pragma unroll
                for (int i = 0; i < 16; ++i) { const float pe = __expf(sc[t5][i] - mx); sc[t5][i] = pe; sum += pe; }
            sum += shfl_xor_(sum, 32, lane);
            const float inv = 1.0f / (sum + __expf(sink - mx));
            f32x16 o[2];
#pragma unroll
            for (int i4 = 0; i4 < 4; ++i4) { const f32x4 z = zero4(), y = zero4(); o[0][4 * i4] = z[0]; o[0][4 * i4 + 1] = z[1]; o[0][4 * i4 + 2] = z[2]; o[0][4 * i4 + 3] = z[3]; o[1][4 * i4] = y[0]; o[1][4 * i4 + 1] = y[1]; o[1][4 * i4 + 2] = y[2]; o[1][4 * i4 + 3] = y[3]; }
#pragma unroll
            for (int t5 = 0; t5 < 5; ++t5)
#pragma unroll
                for (int st = 0; st < 2; ++st) {
                    u32x4 pw; pw.x = pkh(sc[t5][8 * st + 0], sc[t5][8 * st + 1]); pw.y = pkh(sc[t5][8 * st + 2], sc[t5][8 * st + 3]); pw.z = pkh(sc[t5][8 * st + 4], sc[t5][8 * st + 5]); pw.w = pkh(sc[t5][8 * st + 6], sc[t5][8 * st + 7]);
                    const h16x8 pb = __builtin_bit_cast(h16x8, pw);
#pragma unroll
                    for (int dt = 0; dt < 2; ++dt) { const LAS unsigned char* vp = lds + SW_VOFF + (32 * dt + r) * SW_VP + (32 * (qt + t5) + 16 * st + 4 * h) * 2;
                        u32x4 vw; const u32x2 lo = *(const LAS u32x2*)vp, hi = *(const LAS u32x2*)(vp + 16); vw.x = lo.x; vw.y = lo.y; vw.z = hi.x; vw.w = hi.y;
                        o[dt] = __builtin_amdgcn_mfma_f32_32x32x16_f16(__builtin_bit_cast(h16x8, vw), pb, o[dt], 0, 0, 0); }
                }
            h16* orow = O + (size_t)(tokq + 32 * qt + r) * D + hq * 64;
#pragma unroll
            for (int dt = 0; dt < 2; ++dt)
#pragma unroll
                for (int g4 = 0; g4 < 4; ++g4) { f32x4 ov = {o[dt][4 * g4] * inv, o[dt][4 * g4 + 1] * inv, o[dt][4 * g4 + 2] * inv, o[dt][4 * g4 + 3] * inv};
                    *(u32x2*)(orow + 32 * dt + 8 * g4 + 4 * h) = pkb4(ov); }
        }
    }
}

DI void rwkv_prep(const h16* __restrict__ X, const float* __restrict__ mix, h16* __restrict__ LX, int gtid, int NT) {
    constexpr int PU = 4;
    for (int i0 = gtid; i0 < M * (D / 8); i0 += PU * NT) {
        h16x8 xh[PU], ph[PU];
#pragma unroll
        for (int u = 0; u < PU; ++u) { const int i = i0 + u * NT; if (i < M * (D / 8)) { const int m = i >> 8, c = (i & 255) * 8; xh[u] = *(const h16x8*)(X + (size_t)m * D + c);
            ph[u] = (h16x8){0, 0, 0, 0, 0, 0, 0, 0}; if ((m & (SEQ - 1)) != 0) ph[u] = *(const h16x8*)(X + (size_t)(m - 1) * D + c); } }
#pragma unroll
        for (int u = 0; u < PU; ++u) { const int i = i0 + u * NT; if (i < M * (D / 8)) { const int m = i >> 8, c = (i & 255) * 8;
            f32x4 x0, x1, d0, d1;
#pragma unroll
            for (int j = 0; j < 4; ++j) { x0[j] = (float)xh[u][j]; x1[j] = (float)xh[u][4 + j]; d0[j] = (float)ph[u][j] - x0[j]; d1[j] = (float)ph[u][4 + j] - x1[j]; }
#pragma unroll
            for (int s = 0; s < 6; ++s) { const int mr = (s == 0) ? 0 : (s == 1) ? 2 : (s == 2) ? 3 : (s == 3) ? 1 : s; const f32x4 m0 = *(const f32x4*)(mix + mr * D + c), m1 = *(const f32x4*)(mix + mr * D + c + 4);
                *(u32x4*)(LX + (size_t)s * M * D + (size_t)m * D + c) = pkb8(x0 + d0 * m0, x1 + d1 * m1); } } }
    }
}
constexpr int CB_ATL = 0, CB_RLL = 2560, CB_TT = 5632, CB_BK = 6144, CB_Q16 = 10240, CB_BYTES = 10496;
DI float dpp_allreduce16(float v) {
    v += __builtin_bit_cast(float, __builtin_amdgcn_update_dpp(0, __builtin_bit_cast(int, v), 0xB1, 0xF, 0xF, false));
    v += __builtin_bit_cast(float, __builtin_amdgcn_update_dpp(0, __builtin_bit_cast(int, v), 0x4E, 0xF, 0xF, false));
    v += __builtin_bit_cast(float, __builtin_amdgcn_update_dpp(0, __builtin_bit_cast(int, v), 0x141, 0xF, 0xF, false));
    v += __builtin_bit_cast(float, __builtin_amdgcn_update_dpp(0, __builtin_bit_cast(int, v), 0x140, 0xF, 0xF, false));
    return v;
}
constexpr int CP_PITCH = 144, CP_WAVE_LDS = 2 * 32 * 144 + 1024;
DI void rwkv_cprep(LAS unsigned char* lds, const h16* __restrict__ RKV, const h16* __restrict__ WAG, const float* __restrict__ k_k, const float* __restrict__ k_a, const float* __restrict__ r_k, unsigned char* __restrict__ CBG, float* __restrict__ BON, int gw, int NGW, int wave, int lane) {
    LAS unsigned char* AR = lds + wave * CP_WAVE_LDS; LAS unsigned char* BKt = AR + 32 * CP_PITCH; LAS float* LAB = (LAS float*)(BKt + 32 * CP_PITCH);
    h16 lr[16], lk[16], lw[16], la[16], lwn[8]; float kkc = 0.f, kac = 0.f, rkc = 0.f;
#define CP_LOADS(u_) do { const int bh_ = (u_) >> 9, c_ = (u_) & 511, col_ = (bh_ & 31) * 64 + lane, m0_ = (bh_ >> 5) * SEQ + c_ * 16; kkc = k_k[col_]; kac = k_a[col_]; rkc = r_k[col_]; \
        _Pragma("unroll") for (int t = 0; t < 16; ++t) { const size_t o = (size_t)(m0_ + t) * D + col_; lr[t] = RKV[o]; lk[t] = RKV[(size_t)M * D + o]; lw[t] = WAG[o]; la[t] = WAG[(size_t)M * D + o]; } \
        _Pragma("unroll") for (int t = 0; t < 8; ++t) lwn[t] = (c_ < 511) ? WAG[(size_t)(m0_ + 16 + t) * D + col_] : (h16)1.0f;     \
    } while (0)
    if (gw < 64 * 512) CP_LOADS(gw);
    for (int unit = gw; unit < 64 * 512; unit += NGW) {
        const int bh = unit >> 9, c = unit & 511, b = bh >> 5, hd = bh & 31, m0 = b * SEQ + c * 16; (void)c;
        float av[16], bv[16], kv[16], rv[16], pv[16]; float p = 1.0f, bonv = 0.f;
#pragma unroll
        for (int t = 0; t < 16; ++t) {
            const float r = (float)lr[t], k = (float)lk[t], w = (float)lw[t], al = (float)la[t];
            const float kkv = k * kkc; const float nrm = sqrtf(wave_sum_dpp(kkv * kkv)); const float kkn = kkv * __builtin_amdgcn_rcpf(fmaxf(nrm, 1e-12f));
            const float kp = k * (1.0f + (al - 1.0f) * kac);
            const float bon = wave_sum_dpp(r * kp * rkc); bonv = (lane == t) ? bon : bonv;
            p *= w; av[t] = -kkn; bv[t] = kkn * al; kv[t] = kp; rv[t] = r; pv[t] = p; }
        if (lane < 16) BON[(size_t)(m0 + lane) * 32 + hd] = bonv;
        float p8n = 1.0f;
#pragma unroll
        for (int t = 0; t < 8; ++t) p8n *= (float)lwn[t];
        if (unit + NGW < 64 * 512) CP_LOADS(unit + NGW);
        const float inv8 = __builtin_amdgcn_rcpf(pv[7]), q16 = pv[15] * inv8 * p8n;
        const int pk_ = 32 * (lane >> 5) + 8 * ((lane >> 2) & 3) + 4 * ((lane >> 4) & 1) + (lane & 3);
        unsigned char* blk = CBG + (size_t)unit * CB_BYTES;
        h16* ATL = (h16*)(blk + CB_ATL); h16* RLL = (h16*)(blk + CB_RLL); h16* TT = (h16*)(blk + CB_TT); h16* BK = (h16*)(blk + CB_BK);
        float kh[16], bh_[16];
#pragma unroll
        for (int t = 0; t < 16; ++t) { const float qm = (t == 0) ? inv8 : pv[t - 1] * inv8, qt = pv[t] * inv8, iq = __builtin_amdgcn_rcpf(qt);
            const float At = av[t] * qm, Bt = bv[t] * iq, Kt = kv[t] * iq, Rt = rv[t] * qt;
            *(LAS h16*)(AR + t * CP_PITCH + pk_ * 2) = (h16)At; *(LAS h16*)(AR + (16 + t) * CP_PITCH + pk_ * 2) = (h16)Rt;
            *(LAS h16*)(BKt + t * CP_PITCH + pk_ * 2) = (h16)Bt; *(LAS h16*)(BKt + (16 + t) * CP_PITCH + pk_ * 2) = (h16)Kt;
            kh[t] = Kt * q16; bh_[t] = Bt * q16; }
#pragma unroll
        for (int i = 0; i < 2; ++i) { const int idx = lane + 64 * i, row = idx >> 3, seg = idx & 7;
            *(u32x4*)(ATL + row * 80 + seg * 8) = *(const LAS u32x4*)(AR + row * CP_PITCH + seg * 16); *(u32x4*)(RLL + row * 96 + seg * 8) = *(const LAS u32x4*)(AR + (16 + row) * CP_PITCH + seg * 16); }
        {
            u32x4 w0, w1, w2, w3;
            w0.x = pkh(kh[0], kh[1]); w0.y = pkh(kh[2], kh[3]); w0.z = pkh(kh[4], kh[5]); w0.w = pkh(kh[6], kh[7]); w1.x = pkh(kh[8], kh[9]); w1.y = pkh(kh[10], kh[11]); w1.z = pkh(kh[12], kh[13]); w1.w = pkh(kh[14], kh[15]);
            w2.x = pkh(bh_[0], bh_[1]); w2.y = pkh(bh_[2], bh_[3]); w2.z = pkh(bh_[4], bh_[5]); w2.w = pkh(bh_[6], bh_[7]); w3.x = pkh(bh_[8], bh_[9]); w3.y = pkh(bh_[10], bh_[11]); w3.z = pkh(bh_[12], bh_[13]); w3.w = pkh(bh_[14], bh_[15]);
            u32x4* br = (u32x4*)(BK + lane * 32);
            br[0] = (u32x4){w2.x, w2.y, w0.x, w0.y}; br[1] = (u32x4){w2.z, w2.w, w0.z, w0.w}; br[2] = (u32x4){w3.x, w3.y, w1.x, w1.y}; br[3] = (u32x4){w3.z, w3.w, w1.z, w1.w};
            ((float*)(blk + CB_Q16))[lane] = q16;
        }
        const int fr = lane & 15, fq = lane >> 4;
        f32x4 lab = zero4(), lak = zero4(), lrb = zero4(), lrk = zero4();
#pragma unroll
        for (int ks = 0; ks < 2; ++ks) {
            const h16x8 fa = *(const LAS h16x8*)(AR + fr * CP_PITCH + (ks * 32 + fq * 8) * 2), fR = *(const LAS h16x8*)(AR + (16 + fr) * CP_PITCH + (ks * 32 + fq * 8) * 2);
            const h16x8 fb = *(const LAS h16x8*)(BKt + fr * CP_PITCH + (ks * 32 + fq * 8) * 2), fk = *(const LAS h16x8*)(BKt + (16 + fr) * CP_PITCH + (ks * 32 + fq * 8) * 2);
            lab = __builtin_amdgcn_mfma_f32_16x16x32_f16(fb, fa, lab, 0, 0, 0); lak = __builtin_amdgcn_mfma_f32_16x16x32_f16(fk, fa, lak, 0, 0, 0);
            lrb = __builtin_amdgcn_mfma_f32_16x16x32_f16(fb, fR, lrb, 0, 0, 0); lrk = __builtin_amdgcn_mfma_f32_16x16x32_f16(fk, fR, lrk, 0, 0, 0);
        }
#pragma unroll
        for (int j = 0; j < 4; ++j) { const int tc = 4 * fq + j; if (tc >= fr) { lab[j] = 0.f; lak[j] = 0.f; } if (tc > fr) { lrb[j] = 0.f; lrk[j] = 0.f; } }
        *(LAS f32x4*)(LAB + fr * 16 + 4 * fq) = lab;
        *(u32x2*)(ATL + fr * 80 + 64 + 4 * fq) = pk4(lak); { const u32x2 pb = pk4(lrb), pk = pk4(lrk); *(u32x4*)(RLL + fr * 96 + 64 + 8 * fq) = (u32x4){pb.x, pb.y, pk.x, pk.y}; }
        {
            const int cc = lane & 15; float tr[16];
#pragma unroll
            for (int t = 0; t < 16; ++t) { float acc = (t == cc) ? 1.0f : 0.0f;
#pragma unroll
                for (int j = 0; j < 16; ++j) if (j < t) acc += LAB[t * 16 + j] * tr[j];
                tr[t] = acc; }
            if (lane < 16) {
#pragma unroll
                for (int t = 0; t < 16; ++t) TT[t * 16 + cc] = (h16)tr[t]; }
        }
    }
#undef CP_LOADS
}
constexpr int CS_NS = 12, CS_D = 10, CS_SLOT = 11264, CS_VR = CS_NS * CS_SLOT;
DI void rwkv_cscan(LAS unsigned char* lds, const unsigned char* CBG, const h16* Vg, float* YS, int bid, int G, int wave, int lane) {
    for (int task = bid; task < 256; task += G) {
        const int bh = (task & 7) * 8 + (task >> 5), vs = (task >> 3) & 3, b = bh >> 5, hd = bh & 31, fr = lane & 15, fq = lane >> 4;
        const unsigned char* src = CBG + (size_t)bh * 512 * CB_BYTES;
        __syncthreads();
        const h16* vsrc = Vg + (size_t)(b * SEQ + ((lane & 31) >> 1)) * D + hd * 64 + vs * 16 + (lane & 1) * 8;
#define CS_ISSUE(n_) do { const unsigned char* g_ = src + (size_t)(n_) * CB_BYTES + lane * 16; LAS unsigned char* l_ = lds + ((n_) % CS_NS) * CS_SLOT; \
            for (int i = wave - 4; i < 11; i += 4) __builtin_amdgcn_global_load_lds((const unsigned*)(g_ + i * 1024), (LAS unsigned*)(l_ + i * 1024), 16, 0, 0); \
            if (wave == 7) __builtin_amdgcn_global_load_lds((const unsigned*)(vsrc + (size_t)(n_) * 16 * D), (LAS unsigned*)(lds + CS_VR + ((n_) % CS_NS) * 1024), 16, 0, 0); } while (0)
        if (wave >= 4) { for (int i = 0; i < CS_D; ++i) CS_ISSUE(i); asm volatile("s_waitcnt vmcnt(21)" ::: "memory"); static_assert(CS_D == 10 && CS_NS == 12, "vmcnt(21) = 3 x (CS_D - 3)"); }
#define CS_BAR do { asm volatile("s_waitcnt lgkmcnt(0)" ::: "memory"); __builtin_amdgcn_s_barrier(); asm volatile("" ::: "memory"); } while (0)
        CS_BAR;
        if (wave >= 4) {
            for (int n = 0; n < 512; n += 2) {
                CS_ISSUE(n + CS_D < 512 ? n + CS_D : 511); CS_ISSUE(n + 1 + CS_D < 512 ? n + 1 + CS_D : 511);
                asm volatile("s_waitcnt vmcnt(21)" ::: "memory");
                CS_BAR;
            }
        } else if (wave == 0) {
            struct Ops { f32x4 qq[4]; h16 vr[4]; h16x8 at[2], rl[2], rbk, bk[4]; h16x4 atv, ttx; };
#define CS_H8(lo_, hi_) __builtin_bit_cast(h16x8, (u32x4){(lo_).x, (lo_).y, (hi_).x, (hi_).y})
#define CS_SCHED __builtin_amdgcn_sched_barrier(0)
#define CS_STEP(S, T, n_) do { const int nn_ = (n_) + 1 < 512 ? (n_) + 1 : 511; const LAS unsigned char* blk = lds + (nn_ % CS_NS) * CS_SLOT; const LAS unsigned char* vimg = lds + CS_VR + (nn_ % CS_NS) * 1024; \
                const h16x4 vt4_ = (h16x4){S.vr[0], S.vr[1], S.vr[2], S.vr[3]}; const u32x2 vt2_ = __builtin_bit_cast(u32x2, vt4_); \
                const h16x8 xa0 = CS_H8(pk4(X[0]), pk4(X[1])), xa1 = CS_H8(pk4(X[2]), pk4(X[3]));                                                     \
                f32x4 wg = zero4();                                                                                                                    \
                wg = __builtin_amdgcn_mfma_f32_16x16x32_f16(S.at[0], xa0, wg, 0, 0, 0); \
                wg = __builtin_amdgcn_mfma_f32_16x16x32_f16(S.at[1], xa1, wg, 0, 0, 0); \
                wg = __builtin_amdgcn_mfma_f32_16x16x16f16(S.atv, vt4_, wg, 0, 0, 0); \
                f32x4 yt = zero4();                                                                                                                    \
                yt = __builtin_amdgcn_mfma_f32_16x16x32_f16(S.rl[0], xa0, yt, 0, 0, 0); \
                yt = __builtin_amdgcn_mfma_f32_16x16x32_f16(S.rl[1], xa1, yt, 0, 0, 0); \
                f32x4 qx[4]; _Pragma("unroll") for (int ct = 0; ct < 4; ++ct) qx[ct] = X[ct] * S.qq[ct]; \
                CS_SCHED; \
                _Pragma("unroll") for (int sx = 0; sx < 2; ++sx) T.at[sx] = *(const LAS h16x8*)(blk + CB_ATL + fr * 160 + (sx * 4 + fq) * 16);            \
                _Pragma("unroll") for (int j = 0; j < 4; ++j) T.vr[j] = *(const LAS h16*)(vimg + (4 * fq + j) * 32 + fr * 2);                          \
                T.atv = *(const LAS h16x4*)(blk + CB_ATL + fr * 160 + 128 + fq * 8); \
                CS_SCHED; \
                f32x4 ut = zero4();                                                                                                                    \
                ut = __builtin_amdgcn_mfma_f32_16x16x16f16(S.ttx, __builtin_bit_cast(h16x4, pk4(wg)), ut, 0, 0, 0); \
                CS_SCHED; \
                _Pragma("unroll") for (int sx = 0; sx < 2; ++sx) T.rl[sx] = *(const LAS h16x8*)(blk + CB_RLL + fr * 192 + (sx * 4 + fq) * 16); \
                _Pragma("unroll") for (int ct = 0; ct < 4; ++ct) T.qq[ct] = *(const LAS f32x4*)(blk + CB_Q16 + (16 * ct + 4 * fq) * 4); \
                T.ttx = *(const LAS h16x4*)(blk + CB_TT + fr * 32 + fq * 8); \
                CS_SCHED; \
                const h16x8 uva = CS_H8(pk4(ut), vt2_); \
                  \
                _Pragma("unroll") for (int ct = 0; ct < 4; ++ct) X[ct] = __builtin_amdgcn_mfma_f32_16x16x32_f16(S.bk[ct], uva, qx[ct], 0, 0, 0); \
                yt = __builtin_amdgcn_mfma_f32_16x16x32_f16(S.rbk, uva, yt, 0, 0, 0); \
                CS_SCHED; \
                _Pragma("unroll") for (int ct = 0; ct < 4; ++ct) T.bk[ct] = *(const LAS h16x8*)(blk + CB_BK + (16 * ct + fr) * 64 + fq * 16); \
                T.rbk = *(const LAS h16x8*)(blk + CB_RLL + fr * 192 + 128 + fq * 16); \
                h16* yp = (h16*)YS + ((size_t)bh * SEQ + (n_) * 16 + 4 * fq) * 64 + vs * 16 + fr;     \
                _Pragma("unroll") for (int j = 0; j < 4; ++j) yp[j * 64] = (h16)yt[j]; } while (0)
            f32x4 X[4]; X[0] = zero4(); X[1] = zero4(); X[2] = zero4(); X[3] = zero4();
            Ops A, B;
            {   const LAS unsigned char* blk = lds; const LAS unsigned char* vimg = lds + CS_VR;
#pragma unroll
                for (int j = 0; j < 4; ++j) A.vr[j] = *(const LAS h16*)(vimg + (4 * fq + j) * 32 + fr * 2);
#pragma unroll
                for (int ct = 0; ct < 4; ++ct) { A.qq[ct] = *(const LAS f32x4*)(blk + CB_Q16 + (16 * ct + 4 * fq) * 4); A.bk[ct] = *(const LAS h16x8*)(blk + CB_BK + (16 * ct + fr) * 64 + fq * 16); }
#pragma unroll
                for (int sx = 0; sx < 2; ++sx) { A.at[sx] = *(const LAS h16x8*)(blk + CB_ATL + fr * 160 + (sx * 4 + fq) * 16); A.rl[sx] = *(const LAS h16x8*)(blk + CB_RLL + fr * 192 + (sx * 4 + fq) * 16); }
                A.atv = *(const LAS h16x4*)(blk + CB_ATL + fr * 160 + 128 + fq * 8); A.ttx = *(const LAS h16x4*)(blk + CB_TT + fr * 32 + fq * 8); A.rbk = *(const LAS h16x8*)(blk + CB_RLL + fr * 192 + 128 + fq * 16); }
            for (int n = 0; n < 512; n += 2) {
                CS_STEP(A, B, n); CS_STEP(B, A, n + 1);
                __builtin_amdgcn_s_barrier(); asm volatile("" ::: "memory");
            }
#undef CS_STEP
#undef CS_SCHED
#undef CS_H8
        } else {
            for (int n = 0; n < 512; n += 2) CS_BAR;
        }
#undef CS_BAR
#undef CS_ISSUE
    }
}
DI void rwkv_post(const float* YS, const h16* Vg, const float* BON, const h16* Gt, const float* gg, const float* gb, h16* O, int gw, int NGW, int lane) {
    constexpr int PU = 4;
    for (int task0 = gw; task0 < M * 8; task0 += PU * NGW) {
        f32x4 y[PU]; h16x4 v4[PU], g4[PU]; float bonus[PU]; f32x4 gn4[PU], gb4[PU];
#pragma unroll
        for (int u = 0; u < PU; ++u) { const int task = task0 + u * NGW; if (task < M * 8) { const int m = task >> 3, hg = task & 7, hd = hg * 4 + (lane >> 4), e0 = (lane & 15) * 4, col = hd * 64 + e0, b = m >> 13, t = m & (SEQ - 1);
            const size_t rb = (size_t)(b * 32 + hd) * SEQ + t;
            y[u] = __builtin_convertvector(*(const h16x4*)((const h16*)YS + rb * 64 + e0), f32x4);
            v4[u] = *(const h16x4*)(Vg + (size_t)m * D + col); g4[u] = *(const h16x4*)(Gt + (size_t)m * D + col); bonus[u] = BON[(size_t)m * 32 + hd];
            gn4[u] = *(const f32x4*)(gg + col); gb4[u] = *(const f32x4*)(gb + col); } }
#pragma unroll
        for (int u = 0; u < PU; ++u) { const int task = task0 + u * NGW; if (task < M * 8) { const int m = task >> 3, hg = task & 7, hd = hg * 4 + (lane >> 4), e0 = (lane & 15) * 4, col = hd * 64 + e0;
            const float mean = dpp_allreduce16((y[u][0] + y[u][1]) + (y[u][2] + y[u][3])) * (1.0f / 64.0f); const f32x4 d = y[u] - mean;
            const float var = dpp_allreduce16((d[0] * d[0] + d[1] * d[1]) + (d[2] * d[2] + d[3] * d[3])) * (1.0f / 64.0f);
            const f32x4 o = (d * (1.0f / sqrtf(var + 64e-5f)) * gn4[u] + gb4[u] + __builtin_convertvector(v4[u], f32x4) * bonus[u]) * __builtin_convertvector(g4[u], f32x4);
            *(u32x2*)(O + (size_t)m * D + col) = pkb4(o); } }
    }
}

struct Args { const float* in[33]; float* out; unsigned char* ws; int ph_lo, ph_hi, variant; };
constexpr int PH_PER_LAYER = 16, N_PHASES = 1 + 4 * PH_PER_LAYER;

#define CAS __attribute__((address_space(4)))
DI const CAS char* kargs() { const CAS char* kp = (const CAS char*)__builtin_amdgcn_kernarg_segment_ptr(); asm volatile("" : "+s"(kp)); return kp; }
DI const float* inp(int i) { return ((const float* const CAS*)kargs())[i]; }
DI unsigned char* wsp(size_t off) { return *(unsigned char* const CAS*)(kargs() + 272) + off; }
DI float* outp() { return *(float* const CAS*)(kargs() + 264); }
static_assert(offsetof(Args, out) == 264 && offsetof(Args, ws) == 272 && offsetof(Args, ph_lo) == 280, "Args layout");

__global__ void __launch_bounds__(NTHR, 2) mega(Args args) {
    extern __shared__ __attribute__((aligned(16))) unsigned char lds_raw[];
    LAS unsigned char* lds = (LAS unsigned char*)lds_raw;
    const int G = gridDim.x, bid = blockIdx.x;
    const int wave0 = __builtin_amdgcn_readfirstlane(threadIdx.x >> 6);
    {
        volatile LAS unsigned* MISC0 = (volatile LAS unsigned*)(lds + MISC_OFF);
        for (int u = threadIdx.x; u < (LDS_BYTES - MISC_OFF) / 4; u += NTHR) MISC0[u] = 0u;
        __syncthreads();
    }
    XcdBarrier bar = xcd_barrier_post((unsigned*)(args.ws + WS_CTL) + 4096, (volatile LAS unsigned*)(lds + MISC_OFF) + 8);
    const int lo = args.ph_lo, hi = args.ph_hi;
#define IN(k) (lo <= (k) && (k) < hi)
#define SEAM(k) do { if (IN(k) && IN((k) + 1)) xcd_barrier(bar, wave0); } while (0)
#define TCOORDS int wave = wave0; asm volatile("" : "+s"(wave)); int lane = lane_id(); int tid = wave * 64 + lane; \
    const int gw = bid * NWAVES + wave, NGW = G * NWAVES, gtid = bid * NTHR + tid, NT = G * NTHR; (void)lane; (void)gw; (void)NGW; (void)gtid; (void)NT;

    if (IN(0)) {
        TCOORDS
        cvt_flat(inp(0), (h16*)wsp(WS_XH0), (h16*)wsp(WS_XBP), (size_t)M * D, gtid, NT);
        float* cosT = (float*)wsp(WS_COS); float* sinT = (float*)wsp(WS_SIN);
        for (int i = gtid; i < SEQ * 128; i += NT) { const int pos = i >> 7, f = i & 127;
            const float pf = (float)pow(10000.0, (double)f / 128.0); const float inv = 1.0f / pf; const float ang = (float)pos * inv;
            const float c = (float)cos((double)ang), sn = (float)sin((double)ang);
            cosT[i] = c; sinT[i] = sn; }
    }

    for (int L = 0; L < 4; ++L) {
        const int kind = L % 3, P0 = 1 + L * PH_PER_LAYER;
        const size_t xhc_off = (L & 1) ? WS_XH1 : WS_XH0, xho_off = (L & 1) ? WS_XH0 : WS_XH1;
        const size_t mixo_off = (kind == 0) ? WS_XF : WS_OV + (kind == 1 ? OV_SWAO : OV_RKV);
        const int kout = (kind == 0) ? 4096 : 2048;

        if (IN(P0 + 0) && !(SKIPMASK & 1)) {
            TCOORDS
            LAS float* scr = (LAS float*)(lds + wave * 16384);
            unsigned char* WMIX = wsp(WS_WMIX); unsigned char* WCOM = wsp(WS_WCOM);
            if (kind == 0) {
                const float* w = inp(4) + (size_t)(L / 3) * D * 12288;
                cvt_job(w, 12288, D, 2048, 0, (h16*)(WMIX + W_RETA), D, 0, scr, gw, NGW, lane);
                cvt_job(w, 12288, D, 2048, 2048, (h16*)(WMIX + W_RETA), D, 2048, scr, gw, NGW, lane);
                cvt_job(w, 12288, D, 4096, 8192, (h16*)(WMIX + W_RETA), D, 4096, scr, gw, NGW, lane);
                cvt_job(w, 12288, D, 4096, 4096, (h16*)(WMIX + W_RETB), D, 0, scr, gw, NGW, lane);
                cvt_job(inp(6) + (size_t)(L / 3) * 4096 * D, D, 4096, D, 0, (h16*)(WMIX + W_OUT), 4096, 0, scr, gw, NGW, lane);
            } else if (kind == 1) {
                cvt_job(inp(7), 2560, D, 2560, 0, (h16*)(WMIX + W_SWAQKV), D, 0, scr, gw, NGW, lane);
                cvt_job(inp(9), D, D, D, 0, (h16*)(WMIX + W_OUT), D, 0, scr, gw, NGW, lane);
            } else {
                h16* w1 = (h16*)(WMIX + W_RW1); h16* w2 = (h16*)(WMIX + W_RW2);
                for (int j = 0; j < 3; ++j) cvt_job(inp(12) + (size_t)j * D * D, D, D, D, 0, w1, D, j * D, scr, gw, NGW, lane);
                cvt_job(inp(14), 96, D, 96, 0, w1, D, 6144, scr, gw, NGW, lane); zero_rows(w1, D, 6144 + 96, 160, gtid, NT);
                cvt_job(inp(17), 96, D, 96, 0, w1, D, 6400, scr, gw, NGW, lane); zero_rows(w1, D, 6400 + 96, 160, gtid, NT);
                cvt_job(inp(19), 256, D, 256, 0, w1, D, 6656, scr, gw, NGW, lane);
                cvt_small(inp(15), D, 96, D, w2, 256, 0, gtid, NT);
                cvt_small(inp(18), D, 96, D, w2, 256, 2048, gtid, NT);
                cvt_job(inp(20), D, 256, D, 0, w2, 256, 4096, scr, gw, NGW, lane);
                cvt_job(inp(26), D, D, D, 0, (h16*)(WMIX + W_OUT), D, 0, scr, gw, NGW, lane);
            }
            cvt_job<true>(inp(27) + (size_t)L * D * DFF2, DFF2, D, DFF2, 0, (h16*)(WCOM + W_UP), D, 0, scr, gw, NGW, lane);
            cvt_job(inp(30) + (size_t)L * DFF * D, D, DFF, D, 0, (h16*)(WCOM + W_DOWN), DFF, 0, scr, gw, NGW, lane);
            cvt_job(inp(31) + (size_t)L * 256 * D, D, 256, D, 0, (h16*)(WCOM + W_PP), 256, 0, scr, gw, NGW, lane);
            cvt_job(inp(32) + (size_t)L * D * D, D, D, D, 0, (h16*)(WCOM + W_GATE), D, 0, scr, gw, NGW, lane);
            cvt_flat(inp(1) + (size_t)L * M * 256, (h16*)nullptr, (h16*)wsp(WS_PH), (size_t)M * 256, gtid, NT);
        }
        if (kind != 2) SEAM(P0 + 0);

        if (kind == 0) {
            if (IN(P0 + 1) && !(SKIPMASK & 2)) {
                { unsigned char* OV = wsp(WS_OV);
                  Gemm g{(const h16*)wsp(WS_XBP), (const h16*)wsp(WS_WMIX + W_RETA), M, 8192, D, D, D}; StaticOrder S; S.init(M, 8192, G, bid);
                  EpiRetA E{(h16*)(OV + OV_Q), (h16*)(OV + OV_K), (h16*)(OV + OV_SG), (const float*)wsp(WS_COS), (const float*)wsp(WS_SIN), (h16*)(OV + OV_KT)};
                  gemm_phase<EpiRetA>(lds, g, S, E, wave0); }
                { unsigned char* OV = wsp(WS_OV);
                  Gemm g{(const h16*)wsp(WS_WMIX + W_RETB), (const h16*)wsp(WS_XBP), 4096, M, D, D, D}; StaticOrder S; S.init(4096, M, G, bid);
                  EpiRetB E{(h16*)(OV + OV_VT)};
                  gemm_phase<EpiRetB>(lds, g, S, E, wave0); }
            }
            SEAM(P0 + 1);
            if (IN(P0 + 2) && !(SKIPMASK & 4)) { TCOORDS unsigned char* OV = wsp(WS_OV);
                ret_scan(lds, (const h16*)(OV + OV_KT), (const h16*)(OV + OV_VT), (h16*)(OV + OV_RALL), bid, G, wave, lane); }
            SEAM(P0 + 2);
            if (IN(P0 + 3) && !(SKIPMASK & 8)) { TCOORDS unsigned char* OV = wsp(WS_OV);
                ret_core(lds, (const h16*)(OV + OV_Q), (const h16*)(OV + OV_K), (const h16*)(OV + OV_VT), (const h16*)(OV + OV_RALL), (const h16*)(OV + OV_SG), (h16*)wsp(mixo_off), inp(5) + (size_t)(L / 3) * 4096, bid, G, tid, wave, lane); }
            SEAM(P0 + 3);
        } else if (kind == 1) {
            if (IN(P0 + 1)) { Gemm g{(const h16*)wsp(WS_XBP), (const h16*)wsp(WS_WMIX + W_SWAQKV), M, 2560, D, D, D}; StaticOrder S; S.init(M, 2560, G, bid);
                EpiH16 E{(h16*)wsp(WS_OV + OV_QKV), 2560, 2048, 0.125f}; gemm_phase<EpiH16>(lds, g, S, E, wave0); }
            SEAM(P0 + 1);
            if (IN(P0 + 2) && !(SKIPMASK & 16)) { TCOORDS swa_attn(lds, (const h16*)wsp(WS_OV + OV_QKV), inp(8), inp(10), (h16*)wsp(mixo_off), bid, G, tid, wave, lane); }
            SEAM(P0 + 2);
        } else {
            if (IN(P0 + 1) && !(SKIPMASK & 128)) { TCOORDS rwkv_prep((const h16*)wsp(xhc_off), inp(11), (h16*)wsp(WS_OV + OV_LX), gtid, NT); }
            SEAM(P0 + 1);
            if (IN(P0 + 2)) { Gemm g{(const h16*)wsp(WS_OV + OV_LX), (const h16*)wsp(WS_WMIX + W_RW1), M, 6912, D, D, D}; StaticOrder S; S.init(M, 6912, G, bid);
                EpiRw1 E{(h16*)wsp(WS_OV + OV_RKV), (h16*)wsp(WS_OV + OV_MID)}; gemm_phase<EpiRw1>(lds, g, S, E, wave0); }
            SEAM(P0 + 2);
            if (IN(P0 + 3)) { Gemm g{(const h16*)wsp(WS_OV + OV_MID), (const h16*)wsp(WS_WMIX + W_RW2), M, 6144, 256, 256, 256}; StaticOrder S; S.init(M, 6144, G, bid);
                EpiRw2 E{(h16*)wsp(WS_OV + OV_WAG), inp(13), inp(16)}; gemm_phase<EpiRw2>(lds, g, S, E, wave0); }
            SEAM(P0 + 3);
            if (IN(P0 + 4)) { TCOORDS rwkv_cprep(lds, (const h16*)wsp(WS_OV + OV_RKV), (const h16*)wsp(WS_OV + OV_WAG), inp(21), inp(22), inp(23), wsp(WS_OV + OV_LX), (float*)wsp(WS_OV + OV_MID), gw, NGW, wave, lane); }
            SEAM(P0 + 4);
            if (IN(P0 + 5) && !(SKIPMASK & 32)) { TCOORDS rwkv_cscan(lds, wsp(WS_OV + OV_LX), (const h16*)wsp(WS_OV + OV_RKV) + (size_t)2 * M * D, (float*)wsp(WS_OV + OV_WAG), bid, G, wave, lane); }
            SEAM(P0 + 5);
            if (IN(P0 + 6)) { TCOORDS rwkv_post((const float*)wsp(WS_OV + OV_WAG), (const h16*)wsp(WS_OV + OV_RKV) + (size_t)2 * M * D, (const float*)wsp(WS_OV + OV_MID), (const h16*)wsp(WS_OV + OV_WAG) + (size_t)2 * M * D, inp(24), inp(25), (h16*)wsp(mixo_off), gw, NGW, lane); }
            SEAM(P0 + 6);
        }

        if (IN(P0 + 8)) { Gemm g{(const h16*)wsp(mixo_off), (const h16*)wsp(WS_WMIX + W_OUT), M, D, kout, kout, kout}; StaticOrder S; S.init(M, D, G, bid);
            EpiRes E{(const h16*)wsp(xhc_off), (h16*)wsp(WS_YF), nullptr, nullptr, nullptr}; gemm_phase<EpiRes>(lds, g, S, E, wave0); }
        SEAM(P0 + 8);
        if (IN(P0 + 9)) { TCOORDS ln_rows((const h16*)wsp(WS_YF), inp(2) + (size_t)(L * 2 + 0) * D, inp(3) + (size_t)(L * 2 + 0) * D, (h16*)nullptr, (float*)wsp(WS_STAT), (h16*)wsp(WS_XBQ), gw, NGW, lane); }
        SEAM(P0 + 9);
        if (IN(P0 + 10)) { Gemm g{(const h16*)wsp(WS_XBQ), (const h16*)wsp(WS_WCOM + W_UP), M, DFF2, D, D, D}; StaticOrder S; S.init(M, DFF2, G, bid);
#if ONE_LAUNCH
            { EpiUp E{(h16*)wsp(WS_OV + OV_ACT), (float*)wsp(WS_OV + OV_HALO), inp(28) + (size_t)L * 3 * DFF2, inp(29) + (size_t)L * DFF2, (LAS float*)(lds + 131072)}; gemm_phase<EpiUp>(lds, g, S, E, wave0); } }
#else
            if (*(const int CAS*)(kargs() + 288)) { EpiUpT<true> E{(h16*)wsp(WS_OV + OV_ACT), (float*)wsp(WS_OV + OV_HALO), inp(28) + (size_t)L * 3 * DFF2, inp(29) + (size_t)L * DFF2, (LAS float*)(lds + 131072)}; gemm_phase<EpiUpT<true>>(lds, g, S, E, wave0); }
            else { EpiUp E{(h16*)wsp(WS_OV + OV_ACT), (float*)wsp(WS_OV + OV_HALO), inp(28) + (size_t)L * 3 * DFF2, inp(29) + (size_t)L * DFF2, (LAS float*)(lds + 131072)}; gemm_phase<EpiUp>(lds, g, S, E, wave0); } }
#endif
        if (IN(P0 + 10)) { Gemm g{(const h16*)wsp(WS_PH), (const h16*)wsp(WS_WCOM + W_PP), M, D, 256, 256, 256}; PPOrder S; S.init((M / 256) * (DFF2 / 256), G, bid);
            EpiH16 E{(h16*)wsp(WS_OV + OV_PP), D, 0, 1.0f}; gemm_phase<EpiH16, true, PPOrder>(lds, g, S, E, wave0); }
        SEAM(P0 + 10);
        if (IN(P0 + 11)) {
            { TCOORDS ffn_fixup((const float*)wsp(WS_OV + OV_HALO), inp(28) + (size_t)L * 3 * DFF2, inp(29) + (size_t)L * DFF2, (h16*)wsp(WS_OV + OV_ACT), gtid, NT); }
        }
        SEAM(P0 + 11);
        if (IN(P0 + 12)) { Gemm g{(const h16*)wsp(WS_OV + OV_ACT), (const h16*)wsp(WS_WCOM + W_DOWN), M, D, DFF, DFF, DFF}; StaticOrder S; S.init(M, D, G, bid);
            EpiResT<true> E{(const h16*)wsp(WS_YF), (h16*)wsp(WS_YF), (const float*)wsp(WS_STAT), inp(2) + (size_t)(L * 2 + 0) * D, inp(3) + (size_t)(L * 2 + 0) * D}; gemm_phase<EpiResT<true>>(lds, g, S, E, wave0); }
        SEAM(P0 + 12);
        if (IN(P0 + 13)) { TCOORDS ln_rows((const h16*)wsp(WS_YF), inp(2) + (size_t)(L * 2 + 1) * D, inp(3) + (size_t)(L * 2 + 1) * D, (h16*)nullptr, (float*)wsp(WS_STAT) + 2 * M, (h16*)wsp(WS_XBQ), gw, NGW, lane); }
        SEAM(P0 + 13);
        if (IN(P0 + 14)) { Gemm g{(const h16*)wsp(WS_XBQ), (const h16*)wsp(WS_WCOM + W_GATE), M, D, D, D, D}; StaticOrder S; S.init(M, D, G, bid);
            EpiPle E{(const h16*)wsp(WS_YF), (const h16*)wsp(WS_OV + OV_PP), outp(), (L == 3) ? (h16*)nullptr : (h16*)wsp(xho_off), ((L + 1) % 3 == 2) ? (h16*)nullptr : (h16*)wsp(WS_XBP), (const float*)wsp(WS_STAT) + 2 * M, inp(2) + (size_t)(L * 2 + 1) * D, inp(3) + (size_t)(L * 2 + 1) * D, lds}; gemm_phase<EpiPle>(lds, g, S, E, wave0); }
        if (L < 3) SEAM(P0 + 14);
    }
#undef IN
#undef SEAM
#undef TCOORDS
}

static bool phase_exists(int ph) {
    if (ph == 0) return true;
    const int L = (ph - 1) / PH_PER_LAYER, p = (ph - 1) % PH_PER_LAYER, kind = L % 3;
    if (p == 0 || (p >= 8 && p <= 14)) return true;
    if (kind == 0) return p >= 1 && p <= 3;
    if (kind == 1) return p >= 1 && p <= 2;
    return p >= 1 && p <= 6;
}
extern "C" void kernel_launch(void* const* d_in, const int* in_sizes, int n_in, void* d_out, int out_size, void* d_ws, size_t ws_size, hipStream_t stream) {
    static int grid = 0;
    if (grid == 0) {
        if (n_in != 33 || in_sizes[0] != M * D || out_size != M * D || ws_size < WS_END) { fprintf(stderr, "kernel_launch: unexpected shapes (n_in %d, in0 %d, out %d, ws %zu < %zu)\n", n_in, n_in > 0 ? in_sizes[0] : -1, out_size, ws_size, (size_t)WS_END); grid = -1; return; }
        int dev = 0, cus = 0, per_cu = 0;
        if (hipGetDevice(&dev) != hipSuccess || hipDeviceGetAttribute(&cus, hipDeviceAttributeMultiprocessorCount, dev) != hipSuccess) { grid = -1; return; }
        if (hipFuncSetAttribute((const void*)mega, hipFuncAttributeMaxDynamicSharedMemorySize, LDS_BYTES) != hipSuccess) { fprintf(stderr, "kernel_launch: hipFuncSetAttribute failed\n"); grid = -1; return; }
        if (hipOccupancyMaxActiveBlocksPerMultiprocessor(&per_cu, (const void*)mega, NTHR, LDS_BYTES) != hipSuccess || per_cu < 1) fprintf(stderr, "kernel_launch: occupancy query says %d\n", per_cu);
        (void)hipGetLastError();
        grid = cus;
    }
    if (grid < 0) return;
    (void)hipMemsetAsync((char*)d_ws + WS_CTL, 0, CTL_ZERO_BYTES, stream);
    Args a{};
    for (int i = 0; i < 33; ++i) a.in[i] = (const float*)d_in[i];
    a.out = (float*)d_out; a.ws = (unsigned char*)d_ws;
#if ONE_LAUNCH
    a.ph_lo = 0; a.ph_hi = N_PHASES;
    hipLaunchKernelGGL(mega, dim3(grid), dim3(NTHR), LDS_BYTES, stream, a);
#else
    for (int ph = 0; ph < N_PHASES; ++ph) { if (!phase_exists(ph)) continue; a.ph_lo = ph; a.ph_hi = ph + 1;
        if (ph == PROBE_PH) { a.variant = PROBE_VAR; for (int r = 0; r < PROBE_N; ++r) hipLaunchKernelGGL(mega, dim3(grid), dim3(NTHR), LDS_BYTES, stream, a); }
        a.variant = 0;
        hipLaunchKernelGGL(mega, dim3(grid), dim3(NTHR), LDS_BYTES, stream, a); }
#endif
}
```
